# Optimizing an MI355X kernel written in HIP

```python
import jax, jax.numpy as jnp
from jax import lax
import numpy as np

D_MODEL = 4096
BATCH = 4
SEQ = 2048
DEPTH = 1

A_HEAD_DIM = 128
A_WIDTH = D_MODEL // 2
A_HEADS = A_WIDTH // A_HEAD_DIM
MOBA_BLOCK = 256
MOBA_TOPK = 3
MOBA_Q_CHUNK = 16
B_HEAD_DIM = 64
B_WIDTH = D_MODEL // 2
B_Q_HEADS = B_WIDTH // B_HEAD_DIM
B_GROUP = 8
B_KV_HEADS = B_Q_HEADS // B_GROUP
B_KV_WIDTH = B_KV_HEADS * B_HEAD_DIM
WINDOW = 128
D_FF = 4 * D_MODEL
PLE_DIM = 256
ROPE_THETA = 10000.0
LN_EPS = 1e-5
DEEPNORM_ALPHA = (2.0 * DEPTH) ** 0.25
DEEPNORM_BETA = (8.0 * DEPTH) ** -0.25
IN_SIZES = (A_WIDTH, A_WIDTH, A_WIDTH, B_WIDTH, B_KV_WIDTH, B_KV_WIDTH, D_MODEL, D_MODEL)
IN_SPLITS = tuple(int(s) for s in np.cumsum(IN_SIZES)[:-1])
IN_TOTAL = int(sum(IN_SIZES))

kernel_name = 'hybrid_moba_swa_sink_gated_deepnorm'


def rope(x, pos):
    half = x.shape[-1] // 2
    inv_freq = ROPE_THETA ** (-jnp.arange(half, dtype=jnp.float32) / half)
    ang = pos.astype(jnp.float32)[:, None] * inv_freq[None, :]
    cos = jnp.cos(ang).astype(x.dtype)
    sin = jnp.sin(ang).astype(x.dtype)
    x1, x2 = x[..., :half], x[..., half:]
    return jnp.concatenate([x1 * cos - x2 * sin, x1 * sin + x2 * cos], axis=-1)


def layer_norm(x, g, b):
    xf = x.astype(jnp.float32)
    mu = jnp.mean(xf, axis=-1, keepdims=True)
    var = jnp.mean(jnp.square(xf - mu), axis=-1, keepdims=True)
    y = (xf - mu) * lax.rsqrt(var + LN_EPS) * g.astype(jnp.float32) + b.astype(jnp.float32)
    return y.astype(x.dtype)


def moba_attention(q, k, v):
    bsz, n_heads, seq, hd = q.shape
    n_blocks = -(-seq // MOBA_BLOCK)
    pad = n_blocks * MOBA_BLOCK - seq
    k_blocks = jnp.pad(k, ((0, 0), (0, 0), (0, pad), (0, 0))).reshape(bsz, n_heads, n_blocks, MOBA_BLOCK, hd)
    v_blocks = jnp.pad(v, ((0, 0), (0, 0), (0, pad), (0, 0))).reshape(bsz, n_heads, n_blocks, MOBA_BLOCK, hd)
    k_mean = jnp.mean(k_blocks.astype(jnp.float32), axis=3)
    top_k = min(MOBA_TOPK, max(n_blocks - 1, 1))
    scale = hd ** -0.5
    b_idx = jnp.arange(bsz)[:, None, None]
    h_idx = jnp.arange(n_heads)[None, :, None]
    blk_ids = jnp.arange(n_blocks)
    key_offsets = jnp.arange(MOBA_BLOCK)

    def attend_chunk(c):
        q0 = c * MOBA_Q_CHUNK
        qc = lax.dynamic_slice_in_dim(q, q0, MOBA_Q_CHUNK, axis=2)
        blk = q0 // MOBA_BLOCK
        q_pos = q0 + jnp.arange(MOBA_Q_CHUNK)
        gate = jnp.einsum('bhqd,bhnd->bhqn', qc.astype(jnp.float32), k_mean)
        gate = jnp.where(blk_ids < blk, gate, -jnp.inf)
        _, sel = lax.top_k(gate, top_k)
        valid = sel < blk
        flat = sel.reshape(bsz, n_heads, MOBA_Q_CHUNK * top_k)
        k_sel = k_blocks[b_idx, h_idx, flat].reshape(bsz, n_heads, MOBA_Q_CHUNK, top_k, MOBA_BLOCK, hd)
        v_sel = v_blocks[b_idx, h_idx, flat].reshape(bsz, n_heads, MOBA_Q_CHUNK, top_k, MOBA_BLOCK, hd)
        s_sel = jnp.einsum('bhqd,bhqkjd->bhqkj', qc, k_sel, preferred_element_type=jnp.float32) * scale
        s_sel = jnp.where(valid[..., None], s_sel, -jnp.inf)
        k_own = lax.dynamic_index_in_dim(k_blocks, blk, axis=2, keepdims=False)
        v_own = lax.dynamic_index_in_dim(v_blocks, blk, axis=2, keepdims=False)
        s_own = jnp.einsum('bhqd,bhjd->bhqj', qc, k_own, preferred_element_type=jnp.float32) * scale
        k_pos = blk * MOBA_BLOCK + key_offsets
        s_own = jnp.where(k_pos[None, :] <= q_pos[:, None], s_own, -jnp.inf)
        s = jnp.concatenate([s_sel.reshape(bsz, n_heads, MOBA_Q_CHUNK, top_k * MOBA_BLOCK), s_own], axis=-1)
        prob = jax.nn.softmax(s, axis=-1)
        p_sel = prob[..., :top_k * MOBA_BLOCK].reshape(bsz, n_heads, MOBA_Q_CHUNK, top_k, MOBA_BLOCK).astype(v.dtype)
        p_own = prob[..., top_k * MOBA_BLOCK:].astype(v.dtype)
        return (jnp.einsum('bhqkj,bhqkjd->bhqd', p_sel, v_sel)
                + jnp.einsum('bhqj,bhjd->bhqd', p_own, v_own))

    out = lax.map(attend_chunk, jnp.arange(seq // MOBA_Q_CHUNK))
    return out.transpose(1, 2, 0, 3, 4).reshape(bsz, n_heads, seq, hd)


def swa_sink_attention(q, k, v, sinks):
    bsz, n_kv, grp, seq, hd = q.shape
    n_qb = seq // WINDOW
    qb = q.reshape(bsz, n_kv, grp, n_qb, WINDOW, hd)

    def band(t):
        tp = jnp.pad(t, ((0, 0), (0, 0), (WINDOW, 0), (0, 0)))
        prev = tp[:, :, :seq].reshape(bsz, n_kv, n_qb, WINDOW, hd)
        cur = tp[:, :, WINDOW:].reshape(bsz, n_kv, n_qb, WINDOW, hd)
        return jnp.concatenate([prev, cur], axis=3)

    k_band, v_band = band(k), band(v)
    s = jnp.einsum('bkgnqd,bknjd->bkgnqj', qb, k_band, preferred_element_type=jnp.float32) * (hd ** -0.5)
    n = jnp.arange(n_qb)[:, None, None]
    q_abs = n * WINDOW + jnp.arange(WINDOW)[None, :, None]
    k_abs = n * WINDOW + jnp.arange(2 * WINDOW)[None, None, :] - WINDOW
    mask = (k_abs >= 0) & (k_abs <= q_abs) & (q_abs - k_abs < WINDOW)
    s = jnp.where(mask, s, -jnp.inf)
    sink_col = jnp.broadcast_to(sinks.astype(jnp.float32)[None, :, :, None, None, None], s.shape[:-1] + (1,))
    prob = jax.nn.softmax(jnp.concatenate([s, sink_col], axis=-1), axis=-1)[..., :-1]
    out = jnp.einsum('bkgnqj,bknjd->bkgnqd', prob.astype(v.dtype), v_band)
    return out.reshape(bsz, n_kv, grp, seq, hd)


def setup_inputs(seed: int = 0) -> dict:
    key = jax.random.key(seed)
    ks = jax.random.split(key, 16)
    f32 = jnp.float32
    nrm = lambda k, shape, s: jax.random.normal(k, shape, f32) * s
    col_scale = jnp.concatenate([
        jnp.ones((2 * A_WIDTH,), f32), jnp.full((A_WIDTH,), DEEPNORM_BETA, f32),
        jnp.ones((B_WIDTH + B_KV_WIDTH,), f32), jnp.full((B_KV_WIDTH,), DEEPNORM_BETA, f32),
        jnp.ones((2 * D_MODEL,), f32)])
    return {
        'x': nrm(ks[0], (BATCH, SEQ, D_MODEL), 1.0),
        'p': nrm(ks[1], (DEPTH, BATCH, SEQ, PLE_DIM), 1.0),
        'w_in': nrm(ks[2], (DEPTH, D_MODEL, IN_TOTAL), D_MODEL ** -0.5) * col_scale,
        'b_gate': nrm(ks[3], (DEPTH, 2, D_MODEL), 0.02),
        'sinks': nrm(ks[4], (DEPTH, B_Q_HEADS), 0.5),
        'w_up_a': nrm(ks[5], (DEPTH, A_WIDTH, D_MODEL), DEEPNORM_BETA * A_WIDTH ** -0.5),
        'w_up_b': nrm(ks[6], (DEPTH, B_WIDTH, D_MODEL), DEEPNORM_BETA * B_WIDTH ** -0.5),
        'w_o': nrm(ks[7], (DEPTH, D_MODEL, D_MODEL), DEEPNORM_BETA * D_MODEL ** -0.5),
        'ln1_g': 1.0 + nrm(ks[8], (DEPTH, D_MODEL), 0.02),
        'ln1_b': nrm(ks[9], (DEPTH, D_MODEL), 0.02),
        'w_ff_up': nrm(ks[10], (DEPTH, D_MODEL, D_FF), D_MODEL ** -0.5),
        'w_ff_down': nrm(ks[11], (DEPTH, D_FF, D_MODEL), DEEPNORM_BETA * D_FF ** -0.5),
        'ln2_g': 1.0 + nrm(ks[12], (DEPTH, D_MODEL), 0.02),
        'ln2_b': nrm(ks[13], (DEPTH, D_MODEL), 0.02),
        'w_ple': nrm(ks[14], (DEPTH, PLE_DIM, D_MODEL), PLE_DIM ** -0.5),
        'w_ple_gate': nrm(ks[15], (DEPTH, D_MODEL, D_MODEL), D_MODEL ** -0.5),
    }


def reference(x, p, w_in, b_gate, sinks, w_up_a, w_up_b, w_o, ln1_g, ln1_b,
              w_ff_up, w_ff_down, ln2_g, ln2_b, w_ple, w_ple_gate):
    bsz, seq, _ = x.shape
    pos = jnp.arange(seq)
    h = x
    for i in range(DEPTH):
        z = jnp.einsum('bsd,df->bsf', h, w_in[i])
        qa, ka, va, qb, kb, vb, ga, gb = jnp.split(z, IN_SPLITS, axis=-1)
        to_heads_a = lambda t: t.reshape(bsz, seq, A_HEADS, A_HEAD_DIM).transpose(0, 2, 1, 3)
        qa_h, ka_h, va_h = rope(to_heads_a(qa), pos), rope(to_heads_a(ka), pos), to_heads_a(va)
        ya = moba_attention(qa_h, ka_h, va_h).transpose(0, 2, 1, 3).reshape(bsz, seq, A_WIDTH)
        qb_h = rope(qb.reshape(bsz, seq, B_KV_HEADS, B_GROUP, B_HEAD_DIM).transpose(0, 2, 3, 1, 4), pos)
        to_heads_b = lambda t: t.reshape(bsz, seq, B_KV_HEADS, B_HEAD_DIM).transpose(0, 2, 1, 3)
        kb_h, vb_h = rope(to_heads_b(kb), pos), to_heads_b(vb)
        yb = swa_sink_attention(qb_h, kb_h, vb_h, sinks[i].reshape(B_KV_HEADS, B_GROUP))
        yb = yb.transpose(0, 3, 1, 2, 4).reshape(bsz, seq, B_WIDTH)
        gate_a = jax.nn.sigmoid(ga + b_gate[i, 0])
        gate_b = jax.nn.sigmoid(gb + b_gate[i, 1])
        merged = (gate_a * jnp.einsum('bsc,cd->bsd', ya, w_up_a[i])
                  + gate_b * jnp.einsum('bsc,cd->bsd', yb, w_up_b[i]))
        mix = jnp.einsum('bsd,de->bse', merged, w_o[i])
        h = layer_norm(DEEPNORM_ALPHA * h + mix, ln1_g[i], ln1_b[i])
        u = jnp.square(jax.nn.relu(jnp.einsum('bsd,df->bsf', h, w_ff_up[i])))
        ff = jnp.einsum('bsf,fd->bsd', u, w_ff_down[i])
        h = layer_norm(DEEPNORM_ALPHA * h + ff, ln2_g[i], ln2_b[i])
        ple = jnp.einsum('bsp,pd->bsd', p[i], w_ple[i])
        h = h + jax.nn.sigmoid(jnp.einsum('bsd,de->bse', h, w_ple_gate[i])) * ple
    return h
```

```cpp
#include <hip/hip_runtime.h>
#include <cstdio>
#include <cstdint>
#include <cmath>
namespace pg8 {
#define PG8_LAS __attribute__((address_space(3)))
typedef unsigned short bf16_t;
typedef short bf16x8 __attribute__((ext_vector_type(8)));
typedef float f32x4 __attribute__((ext_vector_type(4)));
typedef unsigned u32x4 __attribute__((ext_vector_type(4)));
constexpr int BM = 256, BK = 64, HALF = 128, HTB = HALF * BK * 2  , STAGE_BYTES = 8 * HTB, NXCD = 8, WGM = 8;

__host__ __device__ __forceinline__ int lds_byte(int r, int c) { const int st = (r >> 4) * 2 + (c >> 5), rr = r & 15, cc = c & 31, ob = rr * 64 + cc * 2; return st * 1024 + (ob ^ (((ob >> 9) & 1) << 5)); }
__host__ __device__ __forceinline__ void stage_rc(int b, int& R, int& C) { const int st = b / 1024, sb = b % 1024, swz = sb ^ (((sb >> 9) & 1) << 5); R = (st >> 1) * 16 + swz / 64; C = (st & 1) * 32 + (swz % 64) / 2; }
__host__ __device__ __forceinline__ int perm32(int rho) { const int n = rho >> 4, i = rho & 15; return 8 * (i >> 2) + 4 * n + (i & 3); }

struct Unit { int pm, pn; };
struct Gemm { const bf16_t* A; const bf16_t* Bt; int M, N, K; float oscale; };
typedef int i32x8 __attribute__((ext_vector_type(8)));
typedef int i32x4v __attribute__((ext_vector_type(4)));
__device__ __forceinline__ i32x8 cat16(bf16x8 lo, bf16x8 hi) { const i32x4v a = __builtin_bit_cast(i32x4v, lo), b = __builtin_bit_cast(i32x4v, hi); return __builtin_shufflevector(a, b, 0, 1, 2, 3, 4, 5, 6, 7); }

struct StaticOrder {
    int nM, nN, nwg, G, c;
    __host__ __device__ void init(int M, int N, int G_, int c_) { nM = M / BM; nN = N / BM; nwg = nM * nN; G = G_; c = c_; }
    __host__ __device__ bool next(int i, Unit& u) const {
        const long L = (long)i * G + c; if (L >= nwg) return false;
        int wgid = (int)L; { const int q = nwg / NXCD, r = nwg % NXCD, xcd = wgid % NXCD, off = wgid / NXCD; wgid = (xcd < r ? xcd * (q + 1) : r * (q + 1) + (xcd - r) * q) + off; }
        const int nig = WGM * nN, gid = wgid / nig, fm = gid * WGM, gsz = (nM - fm) < WGM ? (nM - fm) : WGM;
        u.pm = fm + ((wgid % nig) % gsz); u.pn = (wgid % nig) / gsz; return true;
    }
    __device__ __forceinline__ void a_ready(const Unit&) const {}
    __device__ __forceinline__ void done(const Unit&) const {}
};

__device__ __forceinline__ unsigned cvt_pk_bf16(float lo, float hi) { unsigned r; asm volatile("v_cvt_pk_bf16_f32 %0, %1, %2" : "=v"(r) : "v"(lo), "v"(hi)); return r; }
typedef float f32x2 __attribute__((ext_vector_type(2)));
__device__ __forceinline__ f32x2 gelu_pk(f32x2 v) {
    const f32x2 av = __builtin_elementwise_abs(v), d = av * 0.2316418882f + 1.0f;
    f32x2 t; t.x = __builtin_amdgcn_rcpf(d.x); t.y = __builtin_amdgcn_rcpf(d.y);
    f32x2 q = t * 0.5307027145f + (-0.7265760135f); q = q * t + 0.7107068705f; q = q * t + (-0.142248368f); q = q * t + 0.127414796f; q = q * t;
    const f32x2 s = (v * v) * (-0.72134752044f);
    f32x2 e; e.x = __builtin_amdgcn_exp2f(s.x); e.y = __builtin_amdgcn_exp2f(s.y);
    const f32x2 m = v * (q * e), r = v - m;
    f32x2 o; o.x = v.x < 0.f ? m.x : r.x; o.y = v.y < 0.f ? m.y : r.y; return o;
}

template <int ACT  > struct EpiBf16 {
    static constexpr bool PERM = true, AFTER_DRAIN = false; static_assert(ACT == 0 || ACT == 1, "EpiBf16: ACT is 0 (none) or 1 (gelu_pk)");
    bf16_t* O; int ldc; const float* bias; int split_cols; size_t split_stride; float scale0;
    __device__ __forceinline__ void operator()(const f32x4 (&acc)[2][2][4][2], const Unit& u, int wr, int wc, int fr, int fq) const {
        const int row0 = u.pm * BM + wr * 64 + fr; int colt = u.pn * BM; bf16_t* base = O;
        float sc = 1.f; if (split_cols) { const int t = colt / split_cols; base += (size_t)t * split_stride; colt -= t * split_cols; if (t == 0) sc = scale0; }
        const int col0 = colt + wc * 32 + 8 * fq, bcol0 = u.pn * BM + wc * 32 + 8 * fq;
        f32x4 bv[2][2];
#pragma unroll
        for (int bj = 0; bj < 2; ++bj)
#pragma unroll
            for (int n = 0; n < 2; ++n) bv[bj][n] = bias ? *(const f32x4*)(bias + bcol0 + bj * HALF + 4 * n) : (f32x4){0.f, 0.f, 0.f, 0.f};
#pragma unroll
        for (int ai = 0; ai < 2; ++ai)
#pragma unroll
            for (int m = 0; m < 4; ++m) { bf16_t* rowp = base + (size_t)(row0 + ai * HALF + m * 16) * ldc + col0;
#pragma unroll
                for (int bj = 0; bj < 2; ++bj) { f32x4 v0 = acc[ai][bj][m][0] + bv[bj][0], v1 = acc[ai][bj][m][1] + bv[bj][1];
                    if (ACT == 1) { f32x2 a = gelu_pk((f32x2){v0[0], v0[1]}), b = gelu_pk((f32x2){v0[2], v0[3]}), c = gelu_pk((f32x2){v1[0], v1[1]}), d = gelu_pk((f32x2){v1[2], v1[3]});
                        v0 = (f32x4){a.x, a.y, b.x, b.y}; v1 = (f32x4){c.x, c.y, d.x, d.y}; }
                    v0 = v0 * sc; v1 = v1 * sc; u32x4 w; w.x = cvt_pk_bf16(v0[0], v0[1]); w.y = cvt_pk_bf16(v0[2], v0[3]); w.z = cvt_pk_bf16(v1[0], v1[1]); w.w = cvt_pk_bf16(v1[2], v1[3]);
                    *(u32x4*)(rowp + bj * HALF) = w; } }
    }
};
template <class Epi, class Sched, bool ALIGN_EPI = false, bool SP2 = false, int QM = 0>
__device__ __forceinline__ void gemm_phase(PG8_LAS unsigned char* lds, const Gemm g, const Sched& S, const Epi& E) {
    int tid_ = threadIdx.x; asm volatile("" : "+v"(tid_));
    const int tid = tid_, wid = __builtin_amdgcn_readfirstlane(tid >> 6), lane = tid & 63, wr = wid >> 2, wc = wid & 3, fr = lane & 15, fq = lane >> 4;
    constexpr bool F8 = (QM == 1), I8 = (QM == 2), F4 = (QM == 3);
    const int K = g.K, nt = K / BK;
    unsigned voffA[2], voffB[2];
#pragma unroll
    for (int i = 0; i < 2; ++i) { int R, C; stage_rc(tid * 16 + i * 8192, R, C); const int Rb = Epi::PERM ? ((R & ~31) + perm32(R & 31)) : R;
        voffA[i] = (unsigned)(R * K + C) * 2u; voffB[i] = (unsigned)(Rb * K + C) * 2u; }
    const size_t kstep = (size_t)(BK * 2);
    const size_t hstep = (size_t)HALF * K * 2;
    const size_t tstep = 2 * hstep;
    const unsigned ldsw = (unsigned)wid * 1024u;
    const int aoff = lds_byte(wr * 64 + fr, fq * 8), boff = lds_byte(wc * 32 + fr, fq * 8);
#define PG8_SA(b, h) (((b) * 2 + (h)) * HTB)
#define PG8_SB(b, h) ((4 + (b) * 2 + (h)) * HTB)
#define PG8_STAGE(bufoff, gbase, voff) do { _Pragma("unroll") for (int _i = 0; _i < 2; ++_i) \
        __builtin_amdgcn_global_load_lds((const unsigned*)((const char*)(gbase) + (voff)[_i]), (PG8_LAS unsigned*)(lds + (bufoff) + ldsw + _i * 8192), 16, 0, 0); } while (0)
#define PG8_LDA(dst, b, h) do { _Pragma("unroll") for (int m = 0; m < 4; ++m) { if constexpr (F8) dst##8[m] = cat16(*(const PG8_LAS bf16x8*)(lds + PG8_SA(b, h) + aoff + m * 2048), *(const PG8_LAS bf16x8*)(lds + PG8_SA(b, h) + aoff + m * 2048 + 1024)); \
        else { _Pragma("unroll") for (int k = 0; k < 2; ++k) dst[m][k] = *(const PG8_LAS bf16x8*)(lds + PG8_SA(b, h) + aoff + m * 2048 + k * 1024); } } } while (0)
#define PG8_LDB(dst, b, h) do { _Pragma("unroll") for (int n = 0; n < 2; ++n) { if constexpr (F8) dst##8[n] = cat16(*(const PG8_LAS bf16x8*)(lds + PG8_SB(b, h) + boff + n * 2048), *(const PG8_LAS bf16x8*)(lds + PG8_SB(b, h) + boff + n * 2048 + 1024)); \
        else { _Pragma("unroll") for (int k = 0; k < 2; ++k) dst[n][k] = *(const PG8_LAS bf16x8*)(lds + PG8_SB(b, h) + boff + n * 2048 + k * 1024); } } } while (0)
#define PG8_MMA(ai, bj, At, Bt) do { __builtin_amdgcn_s_setprio(1); _Pragma("unroll") for (int m = 0; m < 4; ++m) _Pragma("unroll") for (int n = 0; n < 2; ++n) { \
        if constexpr (F8) asm volatile("v_mfma_f32_16x16x128_f8f6f4 %0, %1, %2, %0" : "+v"(acc[ai][bj][m][n]) : "v"(Bt##8[n]), "v"(At##8[m]));     \
        else if constexpr (I8) { _Pragma("unroll") for (int k = 0; k < 2; ++k) asm volatile("v_mfma_i32_16x16x64_i8 %0, %1, %2, %0" : "+v"(acc[ai][bj][m][n]) : "v"(Bt[n][k]), "v"(At[m][k])); } \
        else if constexpr (F4) { _Pragma("unroll") for (int k = 0; k < 2; ++k) asm volatile("v_mfma_f32_16x16x128_f8f6f4 %0, %1, %2, %0 cbsz:4 blgp:4" : "+v"(acc[ai][bj][m][n]) : "v"(Bt[n][k]), "v"(At[m][k])); } \
        else { _Pragma("unroll") for (int k = 0; k < 2; ++k) acc[ai][bj][m][n] = __builtin_amdgcn_mfma_f32_16x16x32_bf16(Bt[n][k], At[m][k], acc[ai][bj][m][n], 0, 0, 0); } } \
        __builtin_amdgcn_s_setprio(0); } while (0)
#define PG8_WAIT_V(n) asm volatile("s_waitcnt vmcnt(" #n ")" ::: "memory")
#define PG8_WAIT_L(n) asm volatile("s_waitcnt lgkmcnt(" #n ")" ::: "memory")
#define PG8_BAR __builtin_amdgcn_s_barrier()
#define PG8_SCHED __builtin_amdgcn_sched_barrier(0)
    Unit cur, nxt; int ui = 0;
    if (!S.next(0, cur)) return;
    f32x4 acc[2][2][4][2];
#pragma unroll
    for (int a = 0; a < 2; ++a)
#pragma unroll
        for (int b = 0; b < 2; ++b)
#pragma unroll
            for (int m = 0; m < 4; ++m)
#pragma unroll
                for (int n = 0; n < 2; ++n) acc[a][b][m][n] = (f32x4){0.f, 0.f, 0.f, 0.f};
    bf16x8 At[4][2], B0[2][2], B1[2][2];
    i32x8 At8[4], B08[2], B18[2];
    const char* cA = (const char*)g.A + (size_t)cur.pm * tstep; const char* cB = (const char*)g.Bt + (size_t)cur.pn * tstep;
    S.a_ready(cur);
    if constexpr (SP2) {
        PG8_STAGE(PG8_SB(0, 0), cB, voffB); PG8_STAGE(PG8_SB(0, 1), cB + hstep, voffB); PG8_STAGE(PG8_SA(0, 0), cA, voffA); PG8_STAGE(PG8_SA(0, 1), cA + hstep, voffA);
        if (wr == 1) PG8_BAR;
        PG8_WAIT_V(2); PG8_BAR;
        PG8_STAGE(PG8_SB(1, 0), cB + kstep, voffB); PG8_STAGE(PG8_SA(1, 0), cA + kstep, voffA); PG8_STAGE(PG8_SB(1, 1), cB + hstep + kstep, voffB);
        PG8_WAIT_V(6); PG8_BAR;
    } else {
        PG8_STAGE(PG8_SB(0, 0), cB, voffB); PG8_STAGE(PG8_SA(0, 0), cA, voffA); PG8_STAGE(PG8_SB(0, 1), cB + hstep, voffB); PG8_STAGE(PG8_SA(0, 1), cA + hstep, voffA);
        if (wr == 1) PG8_BAR;
        PG8_WAIT_V(4); PG8_BAR;
        PG8_STAGE(PG8_SB(1, 0), cB + kstep, voffB); PG8_STAGE(PG8_SA(1, 0), cA + kstep, voffA); PG8_STAGE(PG8_SB(1, 1), cB + hstep + kstep, voffB);
        PG8_WAIT_V(6); PG8_BAR;
    }
    for (;;) {
        const bool has_next = S.next(ui + 1, nxt);
        const char* nA = has_next ? (const char*)g.A + (size_t)nxt.pm * tstep : cA; const char* nB = has_next ? (const char*)g.Bt + (size_t)nxt.pn * tstep : cB;
        for (int t = 0; t < nt; t += 2) {
            const bool last = (t == nt - 2);
            const char* a1 = cA + (size_t)(t + 1) * kstep;
            const char* a2 = last ? nA : cA + (size_t)(t + 2) * kstep; const char* b2 = last ? nB : cB + (size_t)(t + 2) * kstep;
            const char* a3 = a2 + kstep; const char* b3 = b2 + kstep;
            if (last && has_next) S.a_ready(nxt);
            if constexpr (SP2) {
            PG8_LDB(B0, 0, 0); PG8_LDB(B1, 0, 1); PG8_SCHED; PG8_LDA(At, 0, 0); PG8_STAGE(PG8_SA(1, 1), a1 + hstep, voffA);
            PG8_WAIT_V(8); PG8_WAIT_L(0); PG8_BAR; PG8_MMA(0, 0, At, B0); PG8_MMA(0, 1, At, B1); PG8_BAR; PG8_SCHED;
            PG8_LDA(At, 0, 1); PG8_STAGE(PG8_SB(0, 0), b2, voffB); PG8_STAGE(PG8_SB(0, 1), b2 + hstep, voffB); PG8_STAGE(PG8_SA(0, 0), a2, voffA);
            PG8_WAIT_V(8); PG8_WAIT_L(0); PG8_BAR; PG8_MMA(1, 0, At, B0); PG8_MMA(1, 1, At, B1); PG8_BAR; PG8_SCHED;
            PG8_LDB(B0, 1, 0); PG8_LDB(B1, 1, 1); PG8_SCHED; PG8_LDA(At, 1, 0); PG8_STAGE(PG8_SA(0, 1), a2 + hstep, voffA);
            PG8_WAIT_V(8); PG8_WAIT_L(0); PG8_BAR; PG8_MMA(0, 0, At, B0); PG8_MMA(0, 1, At, B1); PG8_BAR; PG8_SCHED;
            PG8_LDA(At, 1, 1); PG8_STAGE(PG8_SB(1, 0), b3, voffB); PG8_STAGE(PG8_SB(1, 1), b3 + hstep, voffB); PG8_STAGE(PG8_SA(1, 0), a3, voffA);
            PG8_WAIT_V(8); PG8_WAIT_L(0); PG8_BAR; PG8_MMA(1, 0, At, B0); PG8_MMA(1, 1, At, B1); PG8_BAR; PG8_SCHED;
            } else {
            PG8_LDB(B0, 0, 0); PG8_SCHED; PG8_LDA(At, 0, 0); PG8_STAGE(PG8_SA(1, 1), a1 + hstep, voffA);
            PG8_WAIT_L(8); PG8_BAR; PG8_WAIT_L(0); PG8_MMA(0, 0, At, B0); PG8_BAR; PG8_SCHED;
            PG8_LDB(B1, 0, 1); PG8_STAGE(PG8_SB(0, 0), b2, voffB);
            PG8_BAR; PG8_WAIT_L(0); PG8_MMA(0, 1, At, B1); PG8_BAR;
            PG8_LDA(At, 0, 1); PG8_STAGE(PG8_SA(0, 0), a2, voffA);
            PG8_BAR; PG8_WAIT_L(0); PG8_MMA(1, 0, At, B0); PG8_BAR; PG8_SCHED;
            PG8_STAGE(PG8_SB(0, 1), b2 + hstep, voffB);
            PG8_WAIT_V(6); PG8_BAR; PG8_MMA(1, 1, At, B1); PG8_BAR;
            PG8_LDB(B0, 1, 0); PG8_SCHED; PG8_LDA(At, 1, 0); PG8_STAGE(PG8_SA(0, 1), a2 + hstep, voffA);
            PG8_WAIT_L(8); PG8_BAR; PG8_WAIT_L(0); PG8_MMA(0, 0, At, B0); PG8_BAR; PG8_SCHED;
            PG8_LDB(B1, 1, 1); PG8_STAGE(PG8_SB(1, 0), b3, voffB);
            PG8_BAR; PG8_WAIT_L(0); PG8_MMA(0, 1, At, B1); PG8_BAR;
            PG8_LDA(At, 1, 1); PG8_STAGE(PG8_SA(1, 0), a3, voffA);
            PG8_BAR; PG8_WAIT_L(0); PG8_MMA(1, 0, At, B0); PG8_BAR; PG8_SCHED;
            PG8_STAGE(PG8_SB(1, 1), b3 + hstep, voffB);
            PG8_WAIT_V(6); PG8_BAR; PG8_MMA(1, 1, At, B1); PG8_BAR;
            }
        }
        if constexpr (ALIGN_EPI) { if (wr == 0) PG8_BAR; }
        if constexpr (F8 || F4) { asm volatile("s_nop 15\n\ts_nop 15" ::: "memory");
            const float os_ = g.oscale;
#pragma unroll
            for (int a = 0; a < 2; ++a)
#pragma unroll
                for (int b = 0; b < 2; ++b)
#pragma unroll
                    for (int m = 0; m < 4; ++m)
#pragma unroll
                        for (int n = 0; n < 2; ++n) acc[a][b][m][n] = acc[a][b][m][n] * os_; }
        if constexpr (I8) { asm volatile("s_nop 15\n\ts_nop 15" ::: "memory"); const float os_ = g.oscale;
#pragma unroll
            for (int a = 0; a < 2; ++a)
#pragma unroll
                for (int b = 0; b < 2; ++b)
#pragma unroll
                    for (int m = 0; m < 4; ++m)
#pragma unroll
                        for (int n = 0; n < 2; ++n) { const i32x4v iv = __builtin_bit_cast(i32x4v, acc[a][b][m][n]); acc[a][b][m][n] = (f32x4){(float)iv[0], (float)iv[1], (float)iv[2], (float)iv[3]} * os_; } }
        if constexpr (!Epi::AFTER_DRAIN) { E(acc, cur, wr, wc, fr, fq); S.done(cur); }
        if (!has_next) break;
#pragma unroll
        for (int a = 0; a < 2; ++a)
#pragma unroll
            for (int b = 0; b < 2; ++b)
#pragma unroll
                for (int m = 0; m < 4; ++m)
#pragma unroll
                    for (int n = 0; n < 2; ++n) acc[a][b][m][n] = (f32x4){0.f, 0.f, 0.f, 0.f};
        cur = nxt; cA = nA; cB = nB; ++ui;
        if constexpr (ALIGN_EPI) { if (wr == 1) PG8_BAR; }
    }
    PG8_WAIT_V(0);
    if constexpr (!ALIGN_EPI) { if (wr == 0) PG8_BAR; }
    PG8_BAR;
    if constexpr (Epi::AFTER_DRAIN) { E.fused(acc, cur, wr, wc, fr, fq, lds, wid, lane); S.done(cur); }
#undef PG8_SA
#undef PG8_SB
#undef PG8_STAGE
#undef PG8_LDA
#undef PG8_LDB
#undef PG8_MMA
#undef PG8_WAIT_V
#undef PG8_WAIT_L
#undef PG8_BAR
#undef PG8_SCHED
}
}

constexpr int NWAVES = 8;
constexpr int BATCH = 4, SEQ = 2048, DM = 4096, M = BATCH * SEQ;
constexpr int AW = 2048, AHEADS = 16, AD = 128;
constexpr int BQH = 32, BKVH = 4, BD = 64, BKVW = 256, WIN = 128;
constexpr int NIN = 16896, DFF = 16384, PLE = 256;
constexpr int MBLK = 256, NBLK = SEQ / MBLK, TOPK = 3;
constexpr float LN_EPS = 1e-5f;
constexpr float ALPHA = 1.189207115002721f;
constexpr float LOG2E = 1.4426950408889634f;
constexpr float QSCALE_A = 0.08838834764831845f * LOG2E;
constexpr float QSCALE_B = 0.125f * LOG2E;
constexpr int NPH = 10;

constexpr size_t MiB = 1u << 20;
constexpr size_t WS_CTL = 0, CTL_ZERO_BYTES = 832 * 1024;
constexpr size_t WS_TABA = 1 * MiB;
constexpr size_t WS_TABB = 2 * MiB;
constexpr size_t WS_KMP  = 3 * MiB;
constexpr size_t WS_WIN  = 4 * MiB;
constexpr size_t WS_TA   = WS_WIN;
constexpr size_t WS_WUPA = 136 * MiB, WS_WUPB = 152 * MiB, WS_WO = 168 * MiB, WS_WPLE = 200 * MiB, WS_WPLEG = 202 * MiB;
constexpr size_t WS_WFFUP = 234 * MiB;
constexpr size_t WS_PLE  = 72 * MiB;
constexpr size_t WS_WFFDN = 362 * MiB;
constexpr size_t WS_XB   = 490 * MiB;
constexpr size_t WS_H1B  = WS_XB;
constexpr size_t WS_PB   = 554 * MiB;
constexpr size_t WS_QA = 558 * MiB, WS_KA = 590 * MiB, WS_VA = 622 * MiB, WS_QB = 654 * MiB, WS_KB = 686 * MiB, WS_VB = 690 * MiB, WS_GA = 694 * MiB, WS_GB = 758 * MiB;
constexpr size_t WS_MG   = WS_QA;
constexpr size_t WS_U    = WS_QA;
constexpr size_t WS_YA = 822 * MiB, WS_YB = 854 * MiB;
constexpr size_t WS_H2B  = WS_YA;
constexpr size_t WS_XB4  = 888 * MiB;
constexpr size_t WS_WG4  = 904 * MiB;
constexpr size_t WS_END  = 940 * MiB;
constexpr int CW_BAR = 4096;
constexpr size_t CB_ST1 = 256 * 1024, CB_ST2 = 384 * 1024, CB_C1F = 512 * 1024, CB_C2F = 640 * 1024, CB_C1G = 768 * 1024, CB_C2G = 800 * 1024;
constexpr size_t WS_CF32 = 3 * MiB + 512 * 1024;
constexpr float FXS = 4294967296.0f;
__device__ __forceinline__ void fx_add(long long* p, float v) { atomicAdd((unsigned long long*)p, (unsigned long long)(long long)(v * FXS)); }

constexpr int RING_OFF = 0, RING_BYTES = 131072;
constexpr int CV_CH = 1056, CV_SLOT = 8 * CV_CH, CV_WAVE = 2 * CV_SLOT;
constexpr int LDSCTL_OFF = 8 * CV_WAVE, MISC_OFF = LDSCTL_OFF + 320;
static_assert(LDSCTL_OFF >= RING_BYTES && LDSCTL_OFF % 16 == 0, "LDS map");
constexpr int LDS_BYTES = 147456;

#define GAS __attribute__((address_space(1)))
#define LAS __attribute__((address_space(3)))
typedef unsigned short bf16;
typedef float f32x4 __attribute__((ext_vector_type(4)));
typedef float f32x2 __attribute__((ext_vector_type(2)));
typedef unsigned u32x4 __attribute__((ext_vector_type(4)));
typedef unsigned u32x2 __attribute__((ext_vector_type(2)));
typedef unsigned char f8;
constexpr float F8S_X = 4.f, F8S_WIN = 512.f, F8S_Y = 64.f, F8S_WUP = 512.f, F8S_MG = 64.f, F8S_WO = 512.f;
constexpr float F4S_X = 2.f, F4S_WG = 128.f;
__device__ __forceinline__ unsigned pk8f4(float a, float b, float c, float d, float e, float f, float g, float h) {
    unsigned w = 0u; w = __builtin_amdgcn_cvt_scalef32_pk_fp4_f32(w, a, b, 1.0f, 0); w = __builtin_amdgcn_cvt_scalef32_pk_fp4_f32(w, c, d, 1.0f, 1);
    w = __builtin_amdgcn_cvt_scalef32_pk_fp4_f32(w, e, f, 1.0f, 2); w = __builtin_amdgcn_cvt_scalef32_pk_fp4_f32(w, g, h, 1.0f, 3); return w;
}
constexpr float I8S_T2 = 20.f, I8S_WG = 1800.f;
__device__ __forceinline__ unsigned pk4i8(float a, float b, float c, float d) {
    const int ia = (int)__builtin_rintf(__builtin_amdgcn_fmed3f(a, -127.f, 127.f)), ib = (int)__builtin_rintf(__builtin_amdgcn_fmed3f(b, -127.f, 127.f)), ic = (int)__builtin_rintf(__builtin_amdgcn_fmed3f(c, -127.f, 127.f)), id = (int)__builtin_rintf(__builtin_amdgcn_fmed3f(d, -127.f, 127.f));
    return ((unsigned)ia & 0xffu) | (((unsigned)ib & 0xffu) << 8) | (((unsigned)ic & 0xffu) << 16) | ((unsigned)id << 24);
}
__device__ __forceinline__ unsigned pk4f8(float a, float b, float c, float d) {
    a = __builtin_amdgcn_fmed3f(a, -448.f, 448.f); b = __builtin_amdgcn_fmed3f(b, -448.f, 448.f); c = __builtin_amdgcn_fmed3f(c, -448.f, 448.f); d = __builtin_amdgcn_fmed3f(d, -448.f, 448.f);
    unsigned w = 0u; w = __builtin_amdgcn_cvt_pk_fp8_f32(a, b, w, false); w = __builtin_amdgcn_cvt_pk_fp8_f32(c, d, w, true); return w;
}
#define LDS_WAIT() asm volatile("s_waitcnt lgkmcnt(0)" ::: "memory")
#define VM_WAIT() asm volatile("s_waitcnt vmcnt(0)" ::: "memory")

typedef __bf16 bf16x2_t __attribute__((ext_vector_type(2)));
__device__ __forceinline__ unsigned pk2(float lo, float hi) { const f32x2 v = {lo, hi}; const bf16x2_t b = __builtin_convertvector(v, bf16x2_t); return __builtin_bit_cast(unsigned, b); }
__device__ __forceinline__ float bflo(unsigned u) { return __uint_as_float(u << 16); }
__device__ __forceinline__ float bfhi(unsigned u) { return __uint_as_float(u & 0xffff0000u); }
__device__ __forceinline__ float sigmoidf_(float x) { return __builtin_amdgcn_rcpf(1.0f + __expf(-x)); }
__device__ __forceinline__ float wave_sum(float v) {
#pragma unroll
    for (int o = 1; o < 64; o <<= 1) v += __shfl_xor(v, o);
    return v;
}
__device__ __forceinline__ float wave_max(float v) {
#pragma unroll
    for (int o = 1; o < 64; o <<= 1) v = fmaxf(v, __shfl_xor(v, o));
    return v;
}

#define XB_TMO      128
#define XB_XCNT(j)  (256  + 64 * (j))
#define XB_XSUB(j)  (1280 + 64 * (j))
#define XB_XGEN(j)  (2304 + 64 * (j))
#define XB_TOP      3328
#define XB_TOPGEN   3392
#define XCD_BAR_WORDS 3456
#define XB_SPIN_CAP (1u << 18)

__device__ __forceinline__ unsigned xb_ld(unsigned* p)              { return __hip_atomic_load(p, __ATOMIC_RELAXED, __HIP_MEMORY_SCOPE_AGENT); }
__device__ __forceinline__ unsigned xb_add(unsigned* p, unsigned v) { return __hip_atomic_fetch_add(p, v, __ATOMIC_RELAXED, __HIP_MEMORY_SCOPE_AGENT); }
__device__ __forceinline__ unsigned xb_xcc_id() { return (unsigned)__builtin_amdgcn_s_getreg((3 << 11) | 20) & 0xFu; }
#define XB_SPIN(cond, bar) do { unsigned _sp = 0; while (cond) { __builtin_amdgcn_s_sleep(1); \
    if ((++_sp & 255u) == 0u) { if (xb_ld(&(bar)[XB_TMO])) break; if (_sp > XB_SPIN_CAP) { atomicAdd(&(bar)[XB_TMO], 1u); break; } } } } while (0)

struct XcdBarrier {
    unsigned* bar; unsigned x;
    volatile LAS unsigned* st;
};

__device__ __forceinline__ XcdBarrier xcd_barrier_post(unsigned* bar, volatile LAS unsigned* st) {
    XcdBarrier b; b.bar = bar; b.x = xb_xcc_id(); b.st = st;
    if (threadIdx.x == 0) (void)xb_add(&bar[XB_XCNT(b.x)], 1u);
    return b;
}
__device__ __forceinline__ void xcd_barrier_complete(unsigned* bar, unsigned x, unsigned& nloc, unsigned& nx) {
    const unsigned G = gridDim.x * gridDim.y * gridDim.z;
    unsigned sum, cnt, mine, sp = 0u;
    for (;;) {
        sum = 0u; cnt = 0u; mine = 0u;
#pragma unroll
        for (unsigned j = 0; j < 16; ++j) { const unsigned c = xb_ld(&bar[XB_XCNT(j)]); sum += c; cnt += (c > 0u) ? 1u : 0u; mine = (j == x) ? c : mine; }
        if (sum == G) break;
        __builtin_amdgcn_s_sleep(1);
        if ((++sp & 255u) == 0u) { if (xb_ld(&bar[XB_TMO])) break; if (sp > XB_SPIN_CAP) { atomicAdd(&bar[XB_TMO], 1u); break; } }
    }
    nloc = mine > 0u ? mine : 1u; nx = cnt > 0u ? cnt : 1u;
}

__device__ __forceinline__ void xcd_barrier(const XcdBarrier& b) {
    asm volatile("s_waitcnt vmcnt(0)" ::: "memory");
    __syncthreads();
    if (threadIdx.x == 0) {
        unsigned* bar = b.bar;
        __builtin_amdgcn_s_waitcnt(0);
        unsigned nloc = b.st[0], nx = b.st[1];
        if (nloc == 0u) { xcd_barrier_complete(bar, b.x, nloc, nx); b.st[0] = nloc; b.st[1] = nx; }
        const unsigned old = xb_add(&bar[XB_XSUB(b.x)], 1u);
        const unsigned gen = old / nloc;
        if (old + 1u == (gen + 1u) * nloc) {
            __builtin_amdgcn_fence(__ATOMIC_RELEASE, "agent");
            asm volatile("s_waitcnt vmcnt(0)" ::: "memory");
            const unsigned og = xb_add(&bar[XB_TOP], 1u);
            const unsigned tg = og / nx;
            if (og + 1u == (tg + 1u) * nx) xb_add(&bar[XB_TOPGEN], 1u);
            else XB_SPIN(xb_ld(&bar[XB_TOPGEN]) == tg, bar);
            __builtin_amdgcn_fence(__ATOMIC_ACQUIRE, "agent");
            xb_add(&bar[XB_XGEN(b.x)], 1u);
            asm volatile("s_waitcnt vmcnt(0)" ::: "memory");
        } else {
            XB_SPIN(xb_ld(&bar[XB_XGEN(b.x)]) == gen, bar);
            __builtin_amdgcn_fence(__ATOMIC_ACQUIRE, "agent");
            asm volatile("s_waitcnt vmcnt(0)" ::: "memory");
        }
    }
    __syncthreads();
}


using pg8::Unit;
template <int MODE> struct EpiZ {
    static constexpr bool PERM = true, AFTER_DRAIN = false;
    bf16* O; bf16* O2; int ldc; float sc; const float* tab; const float* bias; float* kmp;
    __device__ __forceinline__ void plain(const f32x4 (&acc)[2][2][4][2], bf16* Op, int row0, int col0) const {
#pragma unroll
        for (int ai = 0; ai < 2; ++ai)
#pragma unroll
            for (int m = 0; m < 4; ++m) { bf16* rowp = Op + (size_t)(row0 + ai * 128 + m * 16) * ldc + col0;
#pragma unroll
                for (int bj = 0; bj < 2; ++bj) { const f32x4 v0 = acc[ai][bj][m][0], v1 = acc[ai][bj][m][1];
                    u32x4 w; w.x = pk2(v0[0], v0[1]); w.y = pk2(v0[2], v0[3]); w.z = pk2(v1[0], v1[1]); w.w = pk2(v1[2], v1[3]);
                    *(u32x4*)(rowp + bj * 128) = w; } }
    }
    template <bool ISA> __device__ __forceinline__ void rope(const f32x4 (&acc)[2][2][4][2], bf16* Op, int row0, int col0, int wc, int fq) const {
        constexpr int tstride = ISA ? 128 : 64;
        const int i0 = ISA ? (16 * wc + 4 * fq) : (16 * (wc & 1) + 4 * fq);
#pragma unroll
        for (int ai = 0; ai < 2; ++ai)
#pragma unroll
            for (int m = 0; m < 4; ++m) { const int row = row0 + ai * 128 + m * 16, pos = row & (SEQ - 1);
                const f32x4 t0 = *(const f32x4*)(tab + (size_t)pos * tstride + 2 * i0), t1 = *(const f32x4*)(tab + (size_t)pos * tstride + 2 * i0 + 4);
                bf16* rowp = Op + (size_t)row * ldc + col0;
#pragma unroll
                for (int bj = 0; bj < 2; ++bj) { const f32x4 v0 = acc[ai][bj][m][0], v1 = acc[ai][bj][m][1];
                    f32x4 o0, o1;
                    o0[0] = v0[0] * t0[0] - v0[1] * t0[1]; o0[1] = v0[0] * t0[1] + v0[1] * t0[0];
                    o0[2] = v0[2] * t0[2] - v0[3] * t0[3]; o0[3] = v0[2] * t0[3] + v0[3] * t0[2];
                    o1[0] = v1[0] * t1[0] - v1[1] * t1[1]; o1[1] = v1[0] * t1[1] + v1[1] * t1[0];
                    o1[2] = v1[2] * t1[2] - v1[3] * t1[3]; o1[3] = v1[2] * t1[3] + v1[3] * t1[2];
                    o0 = o0 * sc; o1 = o1 * sc;
                    u32x4 w; w.x = pk2(o0[0], o0[1]); w.y = pk2(o0[2], o0[3]); w.z = pk2(o1[0], o1[1]); w.w = pk2(o1[2], o1[3]);
                    *(u32x4*)(rowp + bj * 128) = w; }
                asm volatile("" ::: "memory"); }
    }
    __device__ __forceinline__ void operator()(const f32x4 (&acc)[2][2][4][2], const Unit& u, int wr, int wc, int fr, int fq) const {
        const int row0 = u.pm * 256 + wr * 64 + fr, col0 = u.pn * 256 + wc * 32 + 8 * fq;
        if constexpr (MODE == 0) plain(acc, O, row0, col0);
        else if constexpr (MODE == 1) rope<true>(acc, O, row0, col0, wc, fq);
        else if constexpr (MODE == 3) rope<false>(acc, O, row0, col0, wc, fq);
        else if constexpr (MODE == 5) { if (u.pn == 0) rope<false>(acc, O, row0, col0, wc, fq); else plain(acc, O2, row0, col0 - 256); }
        else if constexpr (MODE == 4) {
            f32x4 bv[2][2];
#pragma unroll
            for (int bj = 0; bj < 2; ++bj)
#pragma unroll
                for (int n = 0; n < 2; ++n) bv[bj][n] = *(const f32x4*)(bias + col0 + bj * 128 + 4 * n);
#pragma unroll
            for (int ai = 0; ai < 2; ++ai)
#pragma unroll
                for (int m = 0; m < 4; ++m) { bf16* rowp = O + (size_t)(row0 + ai * 128 + m * 16) * ldc + col0;
#pragma unroll
                    for (int bj = 0; bj < 2; ++bj) { const f32x4 v0 = acc[ai][bj][m][0] + bv[bj][0], v1 = acc[ai][bj][m][1] + bv[bj][1];
                        u32x4 w; w.x = pk2(sigmoidf_(v0[0]), sigmoidf_(v0[1])); w.y = pk2(sigmoidf_(v0[2]), sigmoidf_(v0[3]));
                        w.z = pk2(sigmoidf_(v1[0]), sigmoidf_(v1[1])); w.w = pk2(sigmoidf_(v1[2]), sigmoidf_(v1[3]));
                        *(u32x4*)(rowp + bj * 128) = w; } }
        } else {
            rope<true>(acc, O, row0, col0, wc, fq);
            const int i0 = 16 * wc + 4 * fq;
            float* kp = kmp + (size_t)(u.pm * 2 + wr) * AW + col0;
#pragma unroll
            for (int bj = 0; bj < 2; ++bj) { f32x4 c0 = (f32x4){0.f, 0.f, 0.f, 0.f}, c1 = (f32x4){0.f, 0.f, 0.f, 0.f};
#pragma unroll
                for (int ai = 0; ai < 2; ++ai)
#pragma unroll
                    for (int m = 0; m < 4; ++m) { const int pos = (row0 + ai * 128 + m * 16) & (SEQ - 1);
                        const f32x4 t0 = *(const f32x4*)(tab + (size_t)pos * 128 + 2 * i0), t1 = *(const f32x4*)(tab + (size_t)pos * 128 + 2 * i0 + 4);
                        const f32x4 v0 = acc[ai][bj][m][0], v1 = acc[ai][bj][m][1];
                        c0[0] += v0[0] * t0[0] - v0[1] * t0[1]; c0[1] += v0[0] * t0[1] + v0[1] * t0[0];
                        c0[2] += v0[2] * t0[2] - v0[3] * t0[3]; c0[3] += v0[2] * t0[3] + v0[3] * t0[2];
                        c1[0] += v1[0] * t1[0] - v1[1] * t1[1]; c1[1] += v1[0] * t1[1] + v1[1] * t1[0];
                        c1[2] += v1[2] * t1[2] - v1[3] * t1[3]; c1[3] += v1[2] * t1[3] + v1[3] * t1[2]; }
#pragma unroll
                for (int o = 1; o < 16; o <<= 1) {
#pragma unroll
                    for (int j = 0; j < 4; ++j) { c0[j] += __shfl_xor(c0[j], o); c1[j] += __shfl_xor(c1[j], o); } }
                if (fr == 0) { *(f32x4*)(kp + bj * 128) = c0; *(f32x4*)(kp + bj * 128 + 4) = c1; }
                asm volatile("" ::: "memory"); }
        }
    }
};
struct EpiTA {
    static constexpr bool PERM = true, AFTER_DRAIN = false;
    bf16* TA; const bf16* Gt;
    __device__ __forceinline__ void operator()(const f32x4 (&acc)[2][2][4][2], const Unit& u, int wr, int wc, int fr, int fq) const {
        const int row0 = u.pm * 256 + wr * 64 + fr, col0 = u.pn * 256 + wc * 32 + 8 * fq;
#pragma unroll
        for (int ai = 0; ai < 2; ++ai)
#pragma unroll
            for (int m = 0; m < 4; ++m) { const size_t off = (size_t)(row0 + ai * 128 + m * 16) * DM + col0;
#pragma unroll
                for (int bj = 0; bj < 2; ++bj) { const u32x4 g = *(const u32x4*)(Gt + off + bj * 128);
                    const f32x4 g0 = {bflo(g.x), bfhi(g.x), bflo(g.y), bfhi(g.y)}, g1 = {bflo(g.z), bfhi(g.z), bflo(g.w), bfhi(g.w)};
                    const f32x4 v0 = acc[ai][bj][m][0] * g0, v1 = acc[ai][bj][m][1] * g1;
                    u32x4 w; w.x = pk2(v0[0], v0[1]); w.y = pk2(v0[2], v0[3]); w.z = pk2(v1[0], v1[1]); w.w = pk2(v1[2], v1[3]);
                    *(u32x4*)(TA + off + bj * 128) = w; } }
    }
};
struct EpiMG {
    static constexpr bool PERM = true, AFTER_DRAIN = false;
    const bf16* TA; const bf16* Gt; f8* MG;
    __device__ __forceinline__ void operator()(const f32x4 (&acc)[2][2][4][2], const Unit& u, int wr, int wc, int fr, int fq) const {
        const int row0 = u.pm * 256 + wr * 64 + fr, col0 = u.pn * 256 + wc * 32 + 8 * fq;
#pragma unroll
        for (int ai = 0; ai < 2; ++ai)
#pragma unroll
            for (int m = 0; m < 4; ++m) { const size_t off = (size_t)(row0 + ai * 128 + m * 16) * DM + col0;
#pragma unroll
                for (int bj = 0; bj < 2; ++bj) { const u32x4 g = *(const u32x4*)(Gt + off + bj * 128), t = *(const u32x4*)(TA + off + bj * 128);
                    const f32x4 g0 = {bflo(g.x), bfhi(g.x), bflo(g.y), bfhi(g.y)}, g1 = {bflo(g.z), bfhi(g.z), bflo(g.w), bfhi(g.w)};
                    const f32x4 t0 = {bflo(t.x), bfhi(t.x), bflo(t.y), bfhi(t.y)}, t1 = {bflo(t.z), bfhi(t.z), bflo(t.w), bfhi(t.w)};
                    const f32x4 v0 = t0 + acc[ai][bj][m][0] * g0, v1 = t1 + acc[ai][bj][m][1] * g1;
                    u32x2 w; w.x = pk4f8(v0[0] * F8S_MG, v0[1] * F8S_MG, v0[2] * F8S_MG, v0[3] * F8S_MG); w.y = pk4f8(v1[0] * F8S_MG, v1[1] * F8S_MG, v1[2] * F8S_MG, v1[3] * F8S_MG);
                    *(u32x2*)(MG + off + bj * 128) = w; } }
    }
};
__device__ __forceinline__ f32x2 ln_stats(const long long* st, int row) {
    const double s1 = (double)st[2 * row] * (1.0 / 4294967296.0 / DM), s2 = (double)st[2 * row + 1] * (1.0 / 4294967296.0 / DM);
    const float mean = (float)s1, var = fmaxf((float)(s2 - s1 * s1), 0.f);
    return (f32x2){mean, __builtin_amdgcn_rsqf(var + LN_EPS)};
}
template <bool LN> struct EpiRes {
    static constexpr bool PERM = false, AFTER_DRAIN = false;
    const float* base; float* out; bf16* outb; const long long* st; const float* g; const float* b; long long* stn;
    __device__ __forceinline__ void operator()(const f32x4 (&acc)[2][2][4][2], const Unit& u, int wr, int wc, int fr, int fq) const {
        const int row0 = u.pm * 256 + wr * 64 + fr, col0 = u.pn * 256 + wc * 32 + 4 * fq;
#pragma unroll
        for (int ai = 0; ai < 2; ++ai)
#pragma unroll
            for (int m = 0; m < 4; ++m) { const int row = row0 + ai * 128 + m * 16; const size_t off = (size_t)row * DM + col0;
                f32x2 sr = {0.f, 0.f}; if (LN) sr = ln_stats(st, row);
                float s1 = 0.f, s2 = 0.f;
#pragma unroll
                for (int bj = 0; bj < 2; ++bj)
#pragma unroll
                    for (int n = 0; n < 2; ++n) { const int co = bj * 128 + n * 16; f32x4 t = *(const f32x4*)(base + off + co);
                        if (LN) { const f32x4 gg = *(const f32x4*)(g + col0 + co), bb = *(const f32x4*)(b + col0 + co); t = ((t - sr[0]) * sr[1] * gg + bb) * ALPHA + acc[ai][bj][m][n]; }
                        else t = t * ALPHA + acc[ai][bj][m][n];
                        *(f32x4*)(out + off + co) = t;
                        if (LN) *(unsigned*)((unsigned char*)outb + off + co) = pk4i8(t[0] * I8S_T2, t[1] * I8S_T2, t[2] * I8S_T2, t[3] * I8S_T2);
                        else { u32x2 w; w.x = pk2(t[0], t[1]); w.y = pk2(t[2], t[3]); *(u32x2*)(outb + off + co) = w; }
                        s1 += (t[0] + t[1]) + (t[2] + t[3]); s2 += (t[0] * t[0] + t[1] * t[1]) + (t[2] * t[2] + t[3] * t[3]); }
                s1 += __shfl_xor(s1, 16); s2 += __shfl_xor(s2, 16); s1 += __shfl_xor(s1, 32); s2 += __shfl_xor(s2, 32);
                if (fq == 0) { fx_add(stn + 2 * row, s1); fx_add(stn + 2 * row + 1, s2); }
                asm volatile("" ::: "memory"); }
    }
};
struct EpiU {
    static constexpr bool PERM = true, AFTER_DRAIN = false;
    bf16* U; const long long* st; const float* c1; const float* c2;
    __device__ __forceinline__ void operator()(const f32x4 (&acc)[2][2][4][2], const Unit& u, int wr, int wc, int fr, int fq) const {
        const int row0 = u.pm * 256 + wr * 64 + fr, col0 = u.pn * 256 + wc * 32 + 8 * fq;
        f32x2 sr[2][4];
#pragma unroll
        for (int ai = 0; ai < 2; ++ai)
#pragma unroll
            for (int m = 0; m < 4; ++m) sr[ai][m] = ln_stats(st, row0 + ai * 128 + m * 16);
#pragma unroll
        for (int bj = 0; bj < 2; ++bj) { const f32x4 c10 = *(const f32x4*)(c1 + col0 + bj * 128), c11 = *(const f32x4*)(c1 + col0 + bj * 128 + 4), c20 = *(const f32x4*)(c2 + col0 + bj * 128), c21 = *(const f32x4*)(c2 + col0 + bj * 128 + 4);
#pragma unroll
            for (int ai = 0; ai < 2; ++ai)
#pragma unroll
                for (int m = 0; m < 4; ++m) { const int row = row0 + ai * 128 + m * 16;
                    f32x4 v0 = (acc[ai][bj][m][0] - c10 * sr[ai][m][0]) * sr[ai][m][1] + c20, v1 = (acc[ai][bj][m][1] - c11 * sr[ai][m][0]) * sr[ai][m][1] + c21;
#pragma unroll
                    for (int j = 0; j < 4; ++j) { const float a = fmaxf(v0[j], 0.f), b = fmaxf(v1[j], 0.f); v0[j] = a * a; v1[j] = b * b; }
                    u32x4 w; w.x = pk2(v0[0], v0[1]); w.y = pk2(v0[2], v0[3]); w.z = pk2(v1[0], v1[1]); w.w = pk2(v1[2], v1[3]);
                    *(u32x4*)(U + (size_t)row * DFF + col0 + bj * 128) = w; }
            asm volatile("" ::: "memory"); }
    }
};
struct EpiPle {
    static constexpr bool PERM = false, AFTER_DRAIN = false;
    bf16* C;
    __device__ __forceinline__ void operator()(const f32x4 (&acc)[2][2][4][2], const Unit& u, int wr, int wc, int fr, int fq) const {
        const int row0 = u.pm * 256 + wr * 64 + fr, col0 = u.pn * 256 + wc * 32 + 4 * fq;
#pragma unroll
        for (int ai = 0; ai < 2; ++ai)
#pragma unroll
            for (int m = 0; m < 4; ++m) { bf16* rowp = C + (size_t)(row0 + ai * 128 + m * 16) * DM + col0;
#pragma unroll
                for (int bj = 0; bj < 2; ++bj)
#pragma unroll
                    for (int n = 0; n < 2; ++n) { const f32x4 v = acc[ai][bj][m][n]; u32x2 w; w.x = pk2(v[0], v[1]); w.y = pk2(v[2], v[3]); *(u32x2*)(rowp + bj * 128 + n * 16) = w; } }
    }
};
struct EpiFinal {
    static constexpr bool PERM = false, AFTER_DRAIN = false;
    const bf16* PLEp; float* out; const long long* st; const float* g; const float* b; const float* c1; const float* c2;
    __device__ __forceinline__ void operator()(const f32x4 (&acc)[2][2][4][2], const Unit& u, int wr, int wc, int fr, int fq) const {
        const int row0 = u.pm * 256 + wr * 64 + fr, col0 = u.pn * 256 + wc * 32 + 4 * fq;
#pragma unroll
        for (int ai = 0; ai < 2; ++ai)
#pragma unroll
            for (int m = 0; m < 4; ++m) { const int row = row0 + ai * 128 + m * 16; const f32x2 sr = ln_stats(st, row);
#pragma unroll
                for (int bj = 0; bj < 2; ++bj)
#pragma unroll
                    for (int n = 0; n < 2; ++n) { const int co = col0 + bj * 128 + n * 16; const size_t off = (size_t)row * DM + co;
                        const f32x4 gg = *(const f32x4*)(g + co), bb = *(const f32x4*)(b + co), cc1 = *(const f32x4*)(c1 + co), cc2 = *(const f32x4*)(c2 + co);
                        const f32x4 h = (*(const f32x4*)(out + off) - sr[0]) * sr[1] * gg + bb, a = (acc[ai][bj][m][n] - cc1 * sr[0]) * sr[1] + cc2;
                        const u32x2 pw = *(const u32x2*)(PLEp + off); const f32x4 pl = {bflo(pw.x), bfhi(pw.x), bflo(pw.y), bfhi(pw.y)};
                        f32x4 o; o[0] = h[0] + sigmoidf_(a[0]) * pl[0]; o[1] = h[1] + sigmoidf_(a[1]) * pl[1]; o[2] = h[2] + sigmoidf_(a[2]) * pl[2]; o[3] = h[3] + sigmoidf_(a[3]) * pl[3];
                        *(f32x4*)(out + off) = o; }
                asm volatile("" ::: "memory"); }
    }
};

template <bool FOLD> __device__ __forceinline__ void p0_transpose_item(const float* W, int K, int N, bf16* WT, int kb, int nb, int mode, int lane, const float* gf = nullptr, const float* bfv = nullptr, long long* c1 = nullptr, long long* c2 = nullptr) {
    int lane_ = lane; asm volatile("" : "+v"(lane_));
    const int kg = lane_ & 7, nq = lane_ >> 3, k0 = 64 * kb + 8 * kg, ns = 32 * nb + 4 * nq;
    const float* src = W + (size_t)k0 * N + ns;
    f32x4 v[8];
#pragma unroll
    for (int j = 0; j < 8; ++j) v[j] = __builtin_nontemporal_load((const f32x4*)(src + (size_t)j * N));
    f32x4 a1 = {0.f, 0.f, 0.f, 0.f}, a2 = {0.f, 0.f, 0.f, 0.f};
    if (FOLD) {
#pragma unroll
        for (int j = 0; j < 8; ++j) { const float gk = gf[k0 + j], bk = bfv[k0 + j]; a2 += v[j] * bk; v[j] = v[j] * gk; } }
    int drow = ns, dstep = 1;
    if (mode != 0) { const int HW = (mode == 1) ? 128 : 64, half = HW >> 1, hbase = ns & ~(HW - 1), d = ns & (HW - 1), t = d >= half ? 1 : 0, i = d - half * t; drow = hbase + 2 * i + t; dstep = 2; }
#pragma unroll
    for (int c = 0; c < 4; ++c) { u32x4 o; o.x = pk2(v[0][c], v[1][c]); o.y = pk2(v[2][c], v[3][c]); o.z = pk2(v[4][c], v[5][c]); o.w = pk2(v[6][c], v[7][c]);
        if (FOLD) a1[c] = ((bflo(o.x) + bfhi(o.x)) + (bflo(o.y) + bfhi(o.y))) + ((bflo(o.z) + bfhi(o.z)) + (bflo(o.w) + bfhi(o.w)));
        __builtin_nontemporal_store(o, (u32x4*)(WT + (size_t)(drow + c * dstep) * K + k0)); }
    if (FOLD) {
#pragma unroll
        for (int o = 1; o < 8; o <<= 1) {
#pragma unroll
            for (int c = 0; c < 4; ++c) { a1[c] += __shfl_xor(a1[c], o); a2[c] += __shfl_xor(a2[c], o); } }
        if (kg == 0) {
#pragma unroll
            for (int c = 0; c < 4; ++c) { fx_add(c1 + ns + c, a1[c]); fx_add(c2 + ns + c, a2[c]); } }
    }
}
__device__ __forceinline__ void p0_transpose_item_f8(const float* W, int K, int N, f8* WT, int kb, int nb, int mode, float scale, int lane) {
    const int kg = lane & 7, nq = lane >> 3, k0 = 128 * kb + 16 * kg, ns = 32 * nb + 4 * nq;
    const float* src = W + (size_t)k0 * N + ns;
    f32x4 v[16];
#pragma unroll
    for (int j = 0; j < 16; ++j) v[j] = __builtin_nontemporal_load((const f32x4*)(src + (size_t)j * N)) * scale;
    int drow = ns, dstep = 1;
    if (mode != 0) { const int HW = (mode == 1) ? 128 : 64, half = HW >> 1, hbase = ns & ~(HW - 1), d = ns & (HW - 1), t = d >= half ? 1 : 0, i = d - half * t; drow = hbase + 2 * i + t; dstep = 2; }
#pragma unroll
    for (int c = 0; c < 4; ++c) { u32x4 o; o.x = pk4f8(v[0][c], v[1][c], v[2][c], v[3][c]); o.y = pk4f8(v[4][c], v[5][c], v[6][c], v[7][c]); o.z = pk4f8(v[8][c], v[9][c], v[10][c], v[11][c]); o.w = pk4f8(v[12][c], v[13][c], v[14][c], v[15][c]);
        __builtin_nontemporal_store(o, (u32x4*)(WT + (size_t)(drow + c * dstep) * K + k0)); }
}
struct CvDesc { const float* W; unsigned char* WT; int K, N, kb, nb, kind  , mode; float scale; const float* gf; const float* bfv; long long* c1; long long* c2; };
__device__ __forceinline__ void cv_issue(const CvDesc& d, LAS unsigned char* slot, int lane) {
    const float* src = d.W + (size_t)(64 * d.kb + (lane >> 3)) * d.N + 32 * d.nb + 4 * (lane & 7);
#pragma unroll
    for (int j = 0; j < 8; ++j) __builtin_amdgcn_global_load_lds((const unsigned*)(src + (size_t)(8 * j) * d.N), (LAS unsigned*)(slot + j * CV_CH), 16, 0, 2);
}
__device__ __forceinline__ void cv_finish(const CvDesc& d, const LAS unsigned char* slot, int lane) {
    const int kg = lane & 7, nq = lane >> 3, k0 = 64 * d.kb + 8 * kg, ns = 32 * d.nb + 4 * nq;
    f32x4 v[8];
#pragma unroll
    for (int j = 0; j < 8; ++j) v[j] = *(const LAS f32x4*)(slot + kg * CV_CH + j * 128 + nq * 16);
    int drow = ns, dstep = 1;
    if (d.mode != 0) { const int HW = (d.mode == 1) ? 128 : 64, half = HW >> 1, hbase = ns & ~(HW - 1), dd = ns & (HW - 1), t = dd >= half ? 1 : 0, i = dd - half * t; drow = hbase + 2 * i + t; dstep = 2; }
    if (d.kind == 4) {
        const float sc = d.scale; unsigned char* wt = d.WT;
#pragma unroll
        for (int c = 0; c < 4; ++c) __builtin_nontemporal_store(pk8f4(v[0][c] * sc, v[1][c] * sc, v[2][c] * sc, v[3][c] * sc, v[4][c] * sc, v[5][c] * sc, v[6][c] * sc, v[7][c] * sc), (unsigned*)(wt + ((size_t)(drow + c * dstep) * d.K + k0) / 2));
    } else if (d.kind == 3) {
        const float sc = d.scale, isc = 1.0f / d.scale; unsigned char* wt = d.WT; f32x4 a1 = {0.f, 0.f, 0.f, 0.f}, a2 = {0.f, 0.f, 0.f, 0.f};
#pragma unroll
        for (int j = 0; j < 8; ++j) { const float gk = d.gf[k0 + j], bk = d.bfv[k0 + j]; a2 += v[j] * bk; v[j] = v[j] * (gk * sc);
#pragma unroll
            for (int c = 0; c < 4; ++c) { v[j][c] = __builtin_rintf(__builtin_amdgcn_fmed3f(v[j][c], -127.f, 127.f)); a1[c] += v[j][c]; } }
#pragma unroll
        for (int c = 0; c < 4; ++c) { u32x2 o; o.x = pk4i8(v[0][c], v[1][c], v[2][c], v[3][c]); o.y = pk4i8(v[4][c], v[5][c], v[6][c], v[7][c]);
            __builtin_nontemporal_store(o, (u32x2*)(wt + (size_t)(drow + c * dstep) * d.K + k0)); }
#pragma unroll
        for (int o = 1; o < 8; o <<= 1) {
#pragma unroll
            for (int c = 0; c < 4; ++c) { a1[c] += __shfl_xor(a1[c], o); a2[c] += __shfl_xor(a2[c], o); } }
        if (kg == 0) {
#pragma unroll
            for (int c = 0; c < 4; ++c) { fx_add(d.c1 + ns + c, a1[c] * isc); fx_add(d.c2 + ns + c, a2[c]); } }
    } else if (d.kind == 2) {
        const float sc = d.scale; f8* wt = (f8*)d.WT;
#pragma unroll
        for (int c = 0; c < 4; ++c) { u32x2 o; o.x = pk4f8(v[0][c] * sc, v[1][c] * sc, v[2][c] * sc, v[3][c] * sc); o.y = pk4f8(v[4][c] * sc, v[5][c] * sc, v[6][c] * sc, v[7][c] * sc);
            __builtin_nontemporal_store(o, (u32x2*)(wt + (size_t)(drow + c * dstep) * d.K + k0)); }
    } else {
        bf16* wt = (bf16*)d.WT; f32x4 a1 = {0.f, 0.f, 0.f, 0.f}, a2 = {0.f, 0.f, 0.f, 0.f};
        if (d.kind == 1) {
#pragma unroll
            for (int j = 0; j < 8; ++j) { const float gk = d.gf[k0 + j], bk = d.bfv[k0 + j]; a2 += v[j] * bk; v[j] = v[j] * gk; } }
#pragma unroll
        for (int c = 0; c < 4; ++c) { u32x4 o; o.x = pk2(v[0][c], v[1][c]); o.y = pk2(v[2][c], v[3][c]); o.z = pk2(v[4][c], v[5][c]); o.w = pk2(v[6][c], v[7][c]);
            if (d.kind == 1) a1[c] = ((bflo(o.x) + bfhi(o.x)) + (bflo(o.y) + bfhi(o.y))) + ((bflo(o.z) + bfhi(o.z)) + (bflo(o.w) + bfhi(o.w)));
            __builtin_nontemporal_store(o, (u32x4*)(wt + (size_t)(drow + c * dstep) * d.K + k0)); }
        if (d.kind == 1) {
#pragma unroll
            for (int o = 1; o < 8; o <<= 1) {
#pragma unroll
                for (int c = 0; c < 4; ++c) { a1[c] += __shfl_xor(a1[c], o); a2[c] += __shfl_xor(a2[c], o); } }
            if (kg == 0) {
#pragma unroll
                for (int c = 0; c < 4; ++c) { fx_add(d.c1 + ns + c, a1[c]); fx_add(d.c2 + ns + c, a2[c]); } } }
    }
}
#define CV_RUN(lo_, hi_, cw_, ncw_, DECODE) do { LAS unsigned char* ring_ = L + RING_OFF + wave * CV_WAVE; int it_ = (lo_) + (cw_); \
    if (it_ < (hi_)) { CvDesc dc_ = DECODE(it_); cv_issue(dc_, ring_, lane); int sl_ = 0; \
        for (;;) { const int itn_ = it_ + (ncw_); const bool hn_ = itn_ < (hi_); CvDesc dn_ = dc_; \
            if (hn_) { dn_ = DECODE(itn_); cv_issue(dn_, ring_ + (sl_ ^ 1) * CV_SLOT, lane); asm volatile("s_waitcnt vmcnt(8)" ::: "memory"); } else asm volatile("s_waitcnt vmcnt(0)" ::: "memory"); \
            cv_finish(dc_, ring_ + sl_ * CV_SLOT, lane); asm volatile("s_waitcnt lgkmcnt(0)" ::: "memory"); \
            if (!hn_) break; dc_ = dn_; it_ = itn_; sl_ ^= 1; } } } while (0)
__device__ __forceinline__ void sincos_acc(float a, float& s, float& c) {
    const double x = (double)a, kd = rint(x * 0.63661977236758134308);
    double r = fma(-kd, 1.57079632679489655800e+00, x); r = fma(-kd, 6.12323399573676603587e-17, r);
    const double r2 = r * r;
    const double sp = r * (1.0 + r2 * (-1.0 / 6 + r2 * (1.0 / 120 + r2 * (-1.0 / 5040 + r2 * (1.0 / 362880 + r2 * (-1.0 / 39916800 + r2 * (1.0 / 6227020800.0)))))));
    const double cp = 1.0 + r2 * (-0.5 + r2 * (1.0 / 24 + r2 * (-1.0 / 720 + r2 * (1.0 / 40320 + r2 * (-1.0 / 3628800 + r2 * (1.0 / 479001600 + r2 * (-1.0 / 87178291200.0)))))));
    const int q = (int)kd & 3;
    const double sv = (q == 0) ? sp : (q == 1) ? cp : (q == 2) ? -sp : -cp, cv = (q == 0) ? cp : (q == 1) ? -sp : (q == 2) ? -cp : sp;
    s = (float)sv; c = (float)cv;
}

typedef short bf16x8 __attribute__((ext_vector_type(8)));
typedef short s16x4 __attribute__((ext_vector_type(4)));
typedef float f32x16 __attribute__((ext_vector_type(16)));
#define MFMA32(a, b, c) __builtin_amdgcn_mfma_f32_32x32x16_bf16((a), (b), (c), 0, 0, 0)
__device__ __forceinline__ bf16x8 pack8(const f32x16& p, int o) {
    u32x4 w; w.x = pk2(p[o], p[o + 1]); w.y = pk2(p[o + 2], p[o + 3]); w.z = pk2(p[o + 4], p[o + 5]); w.w = pk2(p[o + 6], p[o + 7]); return __builtin_bit_cast(bf16x8, w);
}
__device__ __forceinline__ bf16x8 cat44(s16x4 lo, s16x4 hi) { return (bf16x8){lo[0], lo[1], lo[2], lo[3], hi[0], hi[1], hi[2], hi[3]}; }
__device__ __forceinline__ float max16(const f32x16& p) {
    float a = fmaxf(fmaxf(p[0], p[1]), fmaxf(p[2], p[3])), b = fmaxf(fmaxf(p[4], p[5]), fmaxf(p[6], p[7])), c = fmaxf(fmaxf(p[8], p[9]), fmaxf(p[10], p[11])), d = fmaxf(fmaxf(p[12], p[13]), fmaxf(p[14], p[15]));
    return fmaxf(fmaxf(a, b), fmaxf(c, d));
}
constexpr int A_KP = 272, A_VP = 136;
constexpr int A_KT = 64 * A_KP, A_VT = 128 * A_VP;
constexpr int A_KM = 2 * (A_KT + A_VT);
__device__ __forceinline__ void moba_unit(int b, int h, int blk, const bf16* QA, const bf16* KA, const bf16* VA, const float* kmp, f8* YA, LAS unsigned char* lds, int tid) {
    const int lane = tid & 63, w = __builtin_amdgcn_readfirstlane(tid >> 6), r32 = lane & 31, hi = lane >> 5;
    const size_t rowb = (size_t)b * SEQ;
    const int qrel = 32 * w + r32;
    __syncthreads();
    LAS float* km = (LAS float*)(lds + A_KM);
    for (int i = tid; i < blk * AD; i += 512) { const int n = i >> 7, d = i & 127; const float* k0p = kmp + (size_t)((b * NBLK + n) * 2) * AW + h * AD + d; km[i] = (k0p[0] + k0p[AW]) * (1.0f / MBLK); }
    bf16x8 qf[8];
    { const bf16* qp = QA + (rowb + blk * MBLK + qrel) * AW + h * AD + 8 * hi;
#pragma unroll
      for (int st = 0; st < 8; ++st) qf[st] = *(const bf16x8*)(qp + 16 * st); }
    const int kkey = tid >> 4, kc = tid & 15;
    const bf16* kgp = KA + (rowb + kkey) * AW + h * AD + 8 * kc;
    const bf16* vgp = VA + (rowb + 2 * kkey) * AW + h * AD + 8 * kc;
    const int kls = kkey * A_KP + kc * 16, vls = (8 * kc) * A_VP + kkey * 4;
    u32x4 kr0, kr1, vr0, vr1;
#define A_LOAD(kbase) do { kr0 = *(const u32x4*)(kgp + (size_t)(kbase) * AW); kr1 = *(const u32x4*)(kgp + (size_t)((kbase) + 32) * AW); \
        vr0 = *(const u32x4*)(vgp + (size_t)(kbase) * AW); vr1 = *(const u32x4*)(vgp + (size_t)((kbase) + 1) * AW); } while (0)
#define A_STORE(buf) do { LAS unsigned char* kb_ = lds + (buf) * (A_KT + A_VT); LAS unsigned char* vb_ = kb_ + A_KT; \
        *(LAS u32x4*)(kb_ + kls) = kr0; *(LAS u32x4*)(kb_ + kls + 32 * A_KP) = kr1; \
        _Pragma("unroll") for (int e_ = 0; e_ < 4; ++e_) { const unsigned a_ = vr0[e_], b_ = vr1[e_]; \
            *(LAS unsigned*)(vb_ + vls + (2 * e_) * A_VP) = (a_ & 0xffffu) | (b_ << 16); *(LAS unsigned*)(vb_ + vls + (2 * e_ + 1) * A_VP) = (a_ >> 16) | (b_ & 0xffff0000u); } } while (0)
    A_LOAD(blk * MBLK); A_STORE(0);
    __syncthreads();
    unsigned sel = (blk <= TOPK) ? ((1u << blk) - 1u) : 0u;
    if (blk > TOPK) {
        float gt[NBLK];
#pragma unroll
        for (int n = 0; n < NBLK; ++n) { float part = 0.f;
            if (n < blk) {
#pragma unroll
                for (int st = 0; st < 8; ++st) { const f32x4 k0 = *(const LAS f32x4*)(km + n * AD + 16 * st + 8 * hi), k1 = *(const LAS f32x4*)(km + n * AD + 16 * st + 8 * hi + 4);
                    const u32x4 qw = __builtin_bit_cast(u32x4, qf[st]);
                    part += bflo(qw.x) * k0[0] + bfhi(qw.x) * k0[1] + bflo(qw.y) * k0[2] + bfhi(qw.y) * k0[3] + bflo(qw.z) * k1[0] + bfhi(qw.z) * k1[1] + bflo(qw.w) * k1[2] + bfhi(qw.w) * k1[3]; } }
            part += __shfl_xor(part, 32);
            gt[n] = (n < blk) ? part : -INFINITY; }
#pragma unroll
        for (int t = 0; t < TOPK; ++t) { float best = -INFINITY; int bi = -1;
#pragma unroll
            for (int n = 0; n < NBLK; ++n) if (gt[n] > best) { best = gt[n]; bi = n; }
            if (bi >= 0) sel |= 1u << bi;
#pragma unroll
            for (int n = 0; n < NBLK; ++n) if (n == bi) gt[n] = -INFINITY; }
    }
    f32x16 o[4];
#pragma unroll
    for (int db = 0; db < 4; ++db) o[db] = (f32x16){0.f, 0.f, 0.f, 0.f, 0.f, 0.f, 0.f, 0.f, 0.f, 0.f, 0.f, 0.f, 0.f, 0.f, 0.f, 0.f};
    float m = -INFINITY, l = 0.f;
    const int NT = 4 * (blk + 1);
    for (int ti = 0; ti < NT; ++ti) {
        const int n = (ti < 4) ? blk : ((ti - 4) >> 2), t = (ti < 4) ? ti : ((ti - 4) & 3);
        const bool more = ti + 1 < NT;
        if (more) { const int n1 = (ti + 1 < 4) ? blk : ((ti - 3) >> 2), t1 = (ti + 1 < 4) ? (ti + 1) : ((ti - 3) & 3); A_LOAD(n1 * MBLK + 64 * t1); }
        const bool own = (n == blk), mine = ((sel >> n) & 1u) != 0u;
        const bool active = own ? (t <= (w >> 1)) : (__any(mine) != 0);
        if (active) {
            const LAS unsigned char* kb = lds + (ti & 1) * (A_KT + A_VT); const LAS unsigned char* vb = kb + A_KT;
            f32x16 s0 = (f32x16){0.f, 0.f, 0.f, 0.f, 0.f, 0.f, 0.f, 0.f, 0.f, 0.f, 0.f, 0.f, 0.f, 0.f, 0.f, 0.f}, s1 = s0;
#pragma unroll
            for (int st = 0; st < 8; ++st) { const bf16x8 a0 = *(const LAS bf16x8*)(kb + r32 * A_KP + (16 * st + 8 * hi) * 2), a1 = *(const LAS bf16x8*)(kb + (32 + r32) * A_KP + (16 * st + 8 * hi) * 2);
                s0 = MFMA32(a0, qf[st], s0); s1 = MFMA32(a1, qf[st], s1); }
            if (own) { if (t == (w >> 1)) {
#pragma unroll
                    for (int r = 0; r < 16; ++r) { const int kr = 64 * t + (r & 3) + 8 * (r >> 2) + 4 * hi; if (kr > qrel) s0[r] = -INFINITY; if (kr + 32 > qrel) s1[r] = -INFINITY; } } }
            else if (!mine) {
#pragma unroll
                for (int r = 0; r < 16; ++r) { s0[r] = -INFINITY; s1[r] = -INFINITY; } }
            float tm = fmaxf(max16(s0), max16(s1)); tm = fmaxf(tm, __shfl_xor(tm, 32));
            const float mn = fmaxf(m, tm), al = __builtin_amdgcn_exp2f(m - mn); m = mn;
            float ls = 0.f;
#pragma unroll
            for (int r = 0; r < 16; ++r) { s0[r] = __builtin_amdgcn_exp2f(s0[r] - mn); s1[r] = __builtin_amdgcn_exp2f(s1[r] - mn); ls += s0[r] + s1[r]; }
            l = l * al + ls;
#pragma unroll
            for (int db = 0; db < 4; ++db) o[db] = o[db] * al;
#pragma unroll
            for (int u = 0; u < 2; ++u)
#pragma unroll
                for (int ks = 0; ks < 2; ++ks) { const bf16x8 pf = pack8(u ? s1 : s0, 8 * ks);
#pragma unroll
                    for (int db = 0; db < 4; ++db) { const LAS unsigned char* vp = vb + (32 * db + r32) * A_VP + (32 * u + 16 * ks + 4 * hi) * 2;
                        o[db] = MFMA32(cat44(*(const LAS s16x4*)vp, *(const LAS s16x4*)(vp + 16)), pf, o[db]); } }
        }
        if (more) A_STORE((ti + 1) & 1);
        __syncthreads();
    }
    l += __shfl_xor(l, 32);
    const float inv = F8S_Y / l;
    f8* yp = YA + (rowb + blk * MBLK + qrel) * AW + h * AD + 4 * hi;
#pragma unroll
    for (int db = 0; db < 4; ++db)
#pragma unroll
        for (int g = 0; g < 4; ++g) *(unsigned*)(yp + 32 * db + 8 * g) = pk4f8(o[db][4 * g] * inv, o[db][4 * g + 1] * inv, o[db][4 * g + 2] * inv, o[db][4 * g + 3] * inv);
#undef A_LOAD
#undef A_STORE
}
constexpr int B_KP = 144, B_VP = 520;
constexpr int B_KT = 256 * B_KP, B_VT = 64 * B_VP;
__device__ __forceinline__ void swa_unit(int b, int kvh, int qb, const bf16* QB, const bf16* KB, const bf16* VB, const float* sinks, f8* YB, LAS unsigned char* lds, int tid) {
    const int lane = tid & 63, w = __builtin_amdgcn_readfirstlane(tid >> 6), r32 = lane & 31, hi = lane >> 5;
    const size_t rowb = (size_t)b * SEQ; const int band0 = qb * WIN - WIN, hq = kvh * 8 + w;
    __syncthreads();
    LAS unsigned char* ks_ = lds; LAS unsigned char* vs_ = lds + B_KT;
#pragma unroll
    for (int i = 0; i < 4; ++i) { const int p = tid + 512 * i, key = p >> 3, c = p & 7, pos = band0 + key;
        if (pos >= 0) *(LAS u32x4*)(ks_ + key * B_KP + c * 16) = *(const u32x4*)(KB + (rowb + pos) * BKVW + kvh * BD + 8 * c); }
#pragma unroll
    for (int i = 0; i < 2; ++i) { const int p = tid + 512 * i, kp = p >> 3, c = p & 7, pos = band0 + 2 * kp;
        if (pos >= 0) { const u32x4 v0 = *(const u32x4*)(VB + (rowb + pos) * BKVW + kvh * BD + 8 * c), v1 = *(const u32x4*)(VB + (rowb + pos + 1) * BKVW + kvh * BD + 8 * c);
#pragma unroll
            for (int e = 0; e < 4; ++e) { const unsigned a_ = v0[e], b_ = v1[e];
                *(LAS unsigned*)(vs_ + (8 * c + 2 * e) * B_VP + kp * 4) = (a_ & 0xffffu) | (b_ << 16); *(LAS unsigned*)(vs_ + (8 * c + 2 * e + 1) * B_VP + kp * 4) = (a_ >> 16) | (b_ & 0xffff0000u); } } }
    __syncthreads();
    const float sk = sinks[hq] * LOG2E;
    for (int sub = 0; sub < 4; ++sub) {
        const int qrow = qb * WIN + 32 * sub + r32;
        bf16x8 qf[4];
        { const bf16* qp = QB + (rowb + qrow) * 2048 + hq * BD + 8 * hi;
#pragma unroll
          for (int st = 0; st < 4; ++st) qf[st] = *(const bf16x8*)(qp + 16 * st); }
        f32x16 o[2];
        o[0] = (f32x16){0.f, 0.f, 0.f, 0.f, 0.f, 0.f, 0.f, 0.f, 0.f, 0.f, 0.f, 0.f, 0.f, 0.f, 0.f, 0.f}; o[1] = o[0];
        float m = sk, l = (hi == 0) ? 1.0f : 0.0f;
        const int qi = WIN + 32 * sub + r32;
        for (int tt = 0; tt < 5; ++tt) { const int tile = sub + tt;
            if (band0 + 32 * tile < 0) continue;
            f32x16 s = (f32x16){0.f, 0.f, 0.f, 0.f, 0.f, 0.f, 0.f, 0.f, 0.f, 0.f, 0.f, 0.f, 0.f, 0.f, 0.f, 0.f};
#pragma unroll
            for (int st = 0; st < 4; ++st) s = MFMA32(*(const LAS bf16x8*)(ks_ + (32 * tile + r32) * B_KP + (16 * st + 8 * hi) * 2), qf[st], s);
            if (tt == 0 || tt == 4) {
#pragma unroll
                for (int r = 0; r < 16; ++r) { const int ki = 32 * tile + (r & 3) + 8 * (r >> 2) + 4 * hi; if (!(ki <= qi && qi - ki < WIN)) s[r] = -INFINITY; } }
            float tm = max16(s); tm = fmaxf(tm, __shfl_xor(tm, 32));
            const float mn = fmaxf(m, tm), al = __builtin_amdgcn_exp2f(m - mn); m = mn;
            float ls = 0.f;
#pragma unroll
            for (int r = 0; r < 16; ++r) { s[r] = __builtin_amdgcn_exp2f(s[r] - mn); ls += s[r]; }
            l = l * al + ls; o[0] = o[0] * al; o[1] = o[1] * al;
#pragma unroll
            for (int ks = 0; ks < 2; ++ks) { const bf16x8 pf = pack8(s, 8 * ks);
#pragma unroll
                for (int db = 0; db < 2; ++db) { const LAS unsigned char* vp = vs_ + (32 * db + r32) * B_VP + (32 * tile + 16 * ks + 4 * hi) * 2;
                    o[db] = MFMA32(cat44(*(const LAS s16x4*)vp, *(const LAS s16x4*)(vp + 16)), pf, o[db]); } }
        }
        l += __shfl_xor(l, 32);
        const float inv = F8S_Y / l;
        f8* yp = YB + (rowb + qrow) * 2048 + hq * BD + 4 * hi;
#pragma unroll
        for (int db = 0; db < 2; ++db)
#pragma unroll
            for (int g = 0; g < 4; ++g) *(unsigned*)(yp + 32 * db + 8 * g) = pk4f8(o[db][4 * g] * inv, o[db][4 * g + 1] * inv, o[db][4 * g + 2] * inv, o[db][4 * g + 3] * inv);
    }
}

struct Args { const float* in[16]; float* out; unsigned char* ws; float invf[64]; int ph_lo, ph_hi; };
__global__ void __launch_bounds__(NWAVES * 64, 2) mk_fwd(Args args) {
    extern __shared__ __attribute__((aligned(16))) unsigned char lds[];
    LAS unsigned char* L = (LAS unsigned char*)lds;
    volatile LAS unsigned* MISC = (volatile LAS unsigned*)(L + MISC_OFF);
    const int tid = threadIdx.x, lane = tid & 63, wave = __builtin_amdgcn_readfirstlane(tid >> 6);
    const int G = gridDim.x, bx = blockIdx.x;
    const int gw = bx * NWAVES + wave, NGW = G * NWAVES;
    unsigned char* ws = args.ws;
    const int lo = args.ph_lo, hi = args.ph_hi;
    for (int u = tid; u < (LDS_BYTES - LDSCTL_OFF) / 4; u += NWAVES * 64) ((LAS unsigned*)(L + LDSCTL_OFF))[u] = 0u;
    __syncthreads();
    XcdBarrier bar; bar.bar = (unsigned*)(ws + WS_CTL) + CW_BAR; bar.x = 0; bar.st = nullptr;
    if (hi - lo > 1) bar = xcd_barrier_post((unsigned*)(ws + WS_CTL) + CW_BAR, MISC + 8);
#ifndef MK_PHASE_MASK
#define MK_PHASE_MASK 0x3ff
#endif
#define IN(k) (((MK_PHASE_MASK >> (k)) & 1) && lo <= (k) && (k) < hi)
#define SEAM(k) do { if (IN(k) && IN((k) + 1)) xcd_barrier(bar); } while (0)
    const float* x = args.in[0];
    bf16* XB = (bf16*)(ws + WS_XB); bf16* PB = (bf16*)(ws + WS_PB);

    if (IN(0)) {
        for (int t = bx * (NWAVES * 64) + tid; t < SEQ * 64; t += G * NWAVES * 64) { const int pos = t >> 6, i = t & 63;
            const float ang = (float)pos * args.invf[i]; float s, c; sincos_acc(ang, s, c);
            ((f32x2*)(ws + WS_TABA))[t] = (f32x2){c, s};
            if ((i & 1) == 0) ((f32x2*)(ws + WS_TABB))[pos * 32 + (i >> 1)] = (f32x2){c, s}; }
        constexpr int I_IN = (DM / 64) * (NIN / 32), I_PL0 = (PLE / 64) * (DM / 32);
        auto dec0 = [&](int it) { CvDesc d{}; d.scale = 1.f;
            if (it < I_IN) { const int nblk = NIN / 32, n0 = 32 * (it % nblk); d.W = args.in[2]; d.WT = ws + WS_WIN; d.K = DM; d.N = NIN; d.kb = it / nblk; d.nb = it % nblk; d.kind = 2; d.scale = F8S_WIN;
                if (n0 < 2 * AW || (n0 >= 3 * AW && n0 < 3 * AW + 2048) || n0 >= 8704) { d.kind = 4; d.scale = F4S_WG; d.WT = ws + WS_WG4; }
                d.mode = (n0 < 2 * AW) ? 1 : (n0 < 3 * AW) ? 0 : (n0 < 3 * AW + 2048 + BKVW) ? 2 : 0; }
            else { const int r = it - I_IN; d.W = args.in[14]; d.WT = ws + WS_WPLE; d.K = PLE; d.N = DM; d.kb = r / (DM / 32); d.nb = r % (DM / 32); d.kind = 0; d.mode = 0; }
            return d; };
        CV_RUN(0, I_IN + I_PL0, gw, NGW, dec0);
        { const size_t nthr = (size_t)G * NWAVES * 64, t0 = (size_t)bx * (NWAVES * 64) + tid;
#define CVT_ROWS(SRC, DST, NCH) for (size_t c = t0; c < (size_t)(NCH); c += 4 * nthr) { f32x4 a_[4], b_[4]; \
              _Pragma("unroll") for (int q = 0; q < 4; ++q) { const size_t cc = c + q * nthr; if (cc < (size_t)(NCH)) { a_[q] = __builtin_nontemporal_load((const f32x4*)(SRC) + 2 * cc); b_[q] = __builtin_nontemporal_load((const f32x4*)(SRC) + 2 * cc + 1); } } \
              _Pragma("unroll") for (int q = 0; q < 4; ++q) { const size_t cc = c + q * nthr; if (cc < (size_t)(NCH)) { u32x4 w; w.x = pk2(a_[q][0], a_[q][1]); w.y = pk2(a_[q][2], a_[q][3]); w.z = pk2(b_[q][0], b_[q][1]); w.w = pk2(b_[q][2], b_[q][3]); ((u32x4*)(DST))[cc] = w; } } }
          for (size_t c = t0; c < (size_t)M * DM / 16; c += nthr) { const f32x4* xp = (const f32x4*)x + 4 * c; f32x4 a_[4];
#pragma unroll
              for (int q = 0; q < 4; ++q) a_[q] = __builtin_nontemporal_load(xp + q) * F8S_X;
              u32x4 w; w.x = pk4f8(a_[0][0], a_[0][1], a_[0][2], a_[0][3]); w.y = pk4f8(a_[1][0], a_[1][1], a_[1][2], a_[1][3]); w.z = pk4f8(a_[2][0], a_[2][1], a_[2][2], a_[2][3]); w.w = pk4f8(a_[3][0], a_[3][1], a_[3][2], a_[3][3]);
              ((u32x4*)XB)[c] = w;
              const float r4 = F4S_X / F8S_X; u32x2 w4;
              w4.x = pk8f4(a_[0][0] * r4, a_[0][1] * r4, a_[0][2] * r4, a_[0][3] * r4, a_[1][0] * r4, a_[1][1] * r4, a_[1][2] * r4, a_[1][3] * r4);
              w4.y = pk8f4(a_[2][0] * r4, a_[2][1] * r4, a_[2][2] * r4, a_[2][3] * r4, a_[3][0] * r4, a_[3][1] * r4, a_[3][2] * r4, a_[3][3] * r4);
              ((u32x2*)(ws + WS_XB4))[c] = w4; }
          CVT_ROWS(args.in[1], PB, (size_t)M * PLE / 8);
#undef CVT_ROWS
        }
        VM_WAIT(); __syncthreads();
    }
    SEAM(0);
    if (IN(1)) {
        const bf16* WIN = (const bf16*)(ws + WS_WIN); const float* tabA = (const float*)(ws + WS_TABA); const float* tabB = (const float*)(ws + WS_TABB);
#define P1_CALL(MODE, nrow0, ncols, ...) do { pg8::Gemm g{XB, WIN + (size_t)(nrow0) * (DM / 2), M, (ncols), DM / 2, 1.0f / (F8S_X * F8S_WIN)}; pg8::StaticOrder S; S.init(M, (ncols), G, bx); \
            EpiZ<MODE> E{__VA_ARGS__}; pg8::gemm_phase<EpiZ<MODE>, pg8::StaticOrder, true, true, true>(L + RING_OFF, g, S, E); } while (0)
#define P1_CALL4(MODE, nrow0, ncols, ...) do { pg8::Gemm g{(const bf16*)(ws + WS_XB4), (const bf16*)(ws + WS_WG4) + (size_t)(nrow0) * (DM / 4), M, (ncols), DM / 4, 1.0f / (F4S_X * F4S_WG)}; pg8::StaticOrder S; S.init(M, (ncols), G, bx); \
            EpiZ<MODE> E{__VA_ARGS__}; pg8::gemm_phase<EpiZ<MODE>, pg8::StaticOrder, true, true, 3>(L + RING_OFF, g, S, E); } while (0)
        P1_CALL4(1, 0,    2048, (bf16*)(ws + WS_QA), nullptr, AW, QSCALE_A, tabA, nullptr, nullptr);
        P1_CALL4(2, 2048, 2048, (bf16*)(ws + WS_KA), nullptr, AW, 1.0f, tabA, nullptr, (float*)(ws + WS_KMP));
        P1_CALL(0, 4096, 2048, (bf16*)(ws + WS_VA), nullptr, AW, 1.0f, nullptr, nullptr, nullptr);
        P1_CALL4(3, 6144, 2048, (bf16*)(ws + WS_QB), nullptr, 2048, QSCALE_B, tabB, nullptr, nullptr);
        P1_CALL4(4, 8704, 4096, (bf16*)(ws + WS_GA), nullptr, DM, 1.0f, nullptr, args.in[3], nullptr);
        P1_CALL4(4, 12800, 4096, (bf16*)(ws + WS_GB), nullptr, DM, 1.0f, nullptr, args.in[3] + DM, nullptr);
#undef P1_CALL4
        constexpr int TAILW = (M / 256) * (512 / 256);
        if (bx < TAILW || G <= TAILW) { P1_CALL(5, 8192, 512, (bf16*)(ws + WS_KB), (bf16*)(ws + WS_VB), BKVW, 1.0f, tabB, nullptr, nullptr);
            pg8::Gemm g{PB, (const bf16*)(ws + WS_WPLE), M, DM, PLE}; pg8::StaticOrder S; S.init(M, DM, (G <= TAILW) ? G : TAILW, bx);
            EpiPle E{(bf16*)(ws + WS_PLE)};
            pg8::gemm_phase<EpiPle, pg8::StaticOrder, true, true>(L + RING_OFF, g, S, E); }
#undef P1_CALL
        if (bx >= TAILW || G <= TAILW) {
            constexpr int I_UP = (AW / 64) * (DM / 32), I_O = (DM / 64) * (DM / 32), I_FU = (DM / 64) * (DFF / 32), I_FD = (DFF / 64) * (DM / 32);
            constexpr int NREST = 2 * I_UP + I_O + I_FU + I_FD + I_O;
            const int gw2 = (G <= TAILW) ? gw : (bx - TAILW) * NWAVES + wave, NGW2 = (G <= TAILW) ? NGW : (G - TAILW) * NWAVES;
            auto decr = [&](int it) { CvDesc d{}; d.scale = 1.f; d.mode = 0; int r = it;
                if (r < I_UP) { d.W = args.in[5]; d.WT = ws + WS_WUPA; d.K = AW; d.N = DM; d.kb = r / (DM / 32); d.nb = r % (DM / 32); d.kind = 2; d.scale = F8S_WUP; return d; } r -= I_UP;
                if (r < I_UP) { d.W = args.in[6]; d.WT = ws + WS_WUPB; d.K = AW; d.N = DM; d.kb = r / (DM / 32); d.nb = r % (DM / 32); d.kind = 2; d.scale = F8S_WUP; return d; } r -= I_UP;
                if (r < I_O)  { d.W = args.in[7]; d.WT = ws + WS_WO; d.K = DM; d.N = DM; d.kb = r / (DM / 32); d.nb = r % (DM / 32); d.kind = 2; d.scale = F8S_WO; return d; } r -= I_O;
                if (r < I_FU) { d.W = args.in[10]; d.WT = ws + WS_WFFUP; d.K = DM; d.N = DFF; d.kb = r / (DFF / 32); d.nb = r % (DFF / 32); d.kind = 1; d.gf = args.in[8]; d.bfv = args.in[9]; d.c1 = (long long*)(ws + CB_C1F); d.c2 = (long long*)(ws + CB_C2F); return d; } r -= I_FU;
                if (r < I_FD) { d.W = args.in[11]; d.WT = ws + WS_WFFDN; d.K = DFF; d.N = DM; d.kb = r / (DM / 32); d.nb = r % (DM / 32); d.kind = 0; return d; } r -= I_FD;
                d.W = args.in[15]; d.WT = ws + WS_WPLEG; d.K = DM; d.N = DM; d.kb = r / (DM / 32); d.nb = r % (DM / 32); d.kind = 3; d.scale = I8S_WG; d.gf = args.in[12]; d.bfv = args.in[13]; d.c1 = (long long*)(ws + CB_C1G); d.c2 = (long long*)(ws + CB_C2G); return d; };
            CV_RUN(0, NREST, gw2, NGW2, decr);
            VM_WAIT(); __syncthreads();
        }
    }
    SEAM(1);
    if (IN(2)) {
        { float* cf = (float*)(ws + WS_CF32); const int t = bx * (NWAVES * 64) + tid, T = G * NWAVES * 64;
          for (int i = t; i < 2 * DFF + 2 * DM; i += T) { const long long* srcp = (i < DFF) ? (const long long*)(ws + CB_C1F) + i : (i < 2 * DFF) ? (const long long*)(ws + CB_C2F) + (i - DFF)
                  : (i < 2 * DFF + DM) ? (const long long*)(ws + CB_C1G) + (i - 2 * DFF) : (const long long*)(ws + CB_C2G) + (i - 2 * DFF - DM);
              cf[i] = (float)((double)*srcp * (1.0 / 4294967296.0)); } }
        const int vcu = (G % 8 == 0) ? (bx % 8) * (G / 8) + bx / 8 : bx;
        for (int it = vcu; it < BATCH * AHEADS * 4; it += G) { const int bh = it >> 2, sidx = it & 3;
#pragma unroll 1
            for (int k = 0; k < 2; ++k) moba_unit(bh >> 4, bh & 15, k ? sidx : 7 - sidx, (const bf16*)(ws + WS_QA), (const bf16*)(ws + WS_KA), (const bf16*)(ws + WS_VA), (const float*)(ws + WS_KMP), (f8*)(ws + WS_YA), L + RING_OFF, tid); }
#pragma unroll 1
        for (int it = vcu; it < BATCH * BKVH * (SEQ / WIN); it += G) swa_unit(it >> 6, (it >> 4) & 3, it & 15, (const bf16*)(ws + WS_QB), (const bf16*)(ws + WS_KB), (const bf16*)(ws + WS_VB), args.in[4], (f8*)(ws + WS_YB), L + RING_OFF, tid);
        VM_WAIT(); __syncthreads();
    }
    SEAM(2);
    if (IN(3)) {
        { pg8::Gemm g{(const bf16*)(ws + WS_YA), (const bf16*)(ws + WS_WUPA), M, DM, AW / 2, 1.0f / (F8S_Y * F8S_WUP)}; pg8::StaticOrder S; S.init(M, DM, G, bx);
          EpiTA E{(bf16*)(ws + WS_TA), (const bf16*)(ws + WS_GA)};
          pg8::gemm_phase<EpiTA, pg8::StaticOrder, true, true, true>(L + RING_OFF, g, S, E); }
        VM_WAIT(); __syncthreads();
        { pg8::Gemm g{(const bf16*)(ws + WS_YB), (const bf16*)(ws + WS_WUPB), M, DM, AW / 2, 1.0f / (F8S_Y * F8S_WUP)}; pg8::StaticOrder S; S.init(M, DM, G, bx);
          EpiMG E{(const bf16*)(ws + WS_TA), (const bf16*)(ws + WS_GB), (f8*)(ws + WS_MG)};
          pg8::gemm_phase<EpiMG, pg8::StaticOrder, true, true, true>(L + RING_OFF, g, S, E); }
    }
    SEAM(3);
    if (IN(4)) {
        pg8::Gemm g{(const bf16*)(ws + WS_MG), (const bf16*)(ws + WS_WO), M, DM, DM / 2, 1.0f / (F8S_MG * F8S_WO)}; pg8::StaticOrder S; S.init(M, DM, G, bx);
        EpiRes<false> E{x, args.out, (bf16*)(ws + WS_H1B), nullptr, nullptr, nullptr, (long long*)(ws + CB_ST1)};
        pg8::gemm_phase<EpiRes<false>, pg8::StaticOrder, true, true, true>(L + RING_OFF, g, S, E);
    }
    do { if (IN(4) && IN(6)) xcd_barrier(bar); } while (0);
    if (IN(6)) {
        pg8::Gemm g{(const bf16*)(ws + WS_H1B), (const bf16*)(ws + WS_WFFUP), M, DFF, DM}; pg8::StaticOrder S; S.init(M, DFF, G, bx);
        EpiU E{(bf16*)(ws + WS_U), (const long long*)(ws + CB_ST1), (const float*)(ws + WS_CF32), (const float*)(ws + WS_CF32) + DFF};
        pg8::gemm_phase<EpiU, pg8::StaticOrder, true, true>(L + RING_OFF, g, S, E);
    }
    SEAM(6);
    if (IN(7)) {
        pg8::Gemm g{(const bf16*)(ws + WS_U), (const bf16*)(ws + WS_WFFDN), M, DM, DFF}; pg8::StaticOrder S; S.init(M, DM, G, bx);
        EpiRes<true> E{args.out, args.out, (bf16*)(ws + WS_H2B), (const long long*)(ws + CB_ST1), args.in[8], args.in[9], (long long*)(ws + CB_ST2)};
        pg8::gemm_phase<EpiRes<true>, pg8::StaticOrder, true, true>(L + RING_OFF, g, S, E);
    }
    do { if (IN(7) && IN(9)) xcd_barrier(bar); } while (0);
    if (IN(9)) {
        { pg8::Gemm g{(const bf16*)(ws + WS_H2B), (const bf16*)(ws + WS_WPLEG), M, DM, DM / 2, 1.0f / (I8S_T2 * I8S_WG)}; pg8::StaticOrder S; S.init(M, DM, G, bx);
          EpiFinal E{(const bf16*)(ws + WS_PLE), args.out, (const long long*)(ws + CB_ST2), args.in[12], args.in[13], (const float*)(ws + WS_CF32) + 2 * DFF, (const float*)(ws + WS_CF32) + 2 * DFF + DM};
          pg8::gemm_phase<EpiFinal, pg8::StaticOrder, true, true, 2>(L + RING_OFF, g, S, E); }
    }
#undef IN
#undef SEAM
}

#ifndef MK_PER_PHASE
#define MK_PER_PHASE 0
#endif
extern "C" void kernel_launch(void* const* d_in, const int* in_sizes, int n_in, void* d_out, int out_size, void* d_ws, size_t ws_size, hipStream_t stream) {
    static int grid = 0;
    if (grid == 0) {
        if (n_in != 16 || in_sizes[0] != M * DM || out_size != M * DM || ws_size < WS_END) { fprintf(stderr, "kernel_launch: unexpected shapes (n_in %d, in0 %d, out %d, ws %zu < %zu); nothing launched\n", n_in, n_in > 0 ? in_sizes[0] : -1, out_size, ws_size, (size_t)WS_END); grid = -1; return; }
        int dev = 0, cus = 0, per_cu = 0;
        if (hipGetDevice(&dev) != hipSuccess || hipDeviceGetAttribute(&cus, hipDeviceAttributeMultiprocessorCount, dev) != hipSuccess) { grid = -1; return; }
        if (hipFuncSetAttribute((const void*)mk_fwd, hipFuncAttributeMaxDynamicSharedMemorySize, LDS_BYTES) != hipSuccess) { fprintf(stderr, "kernel_launch: hipFuncSetAttribute failed\n"); grid = -1; return; }
        if (hipOccupancyMaxActiveBlocksPerMultiprocessor(&per_cu, (const void*)mk_fwd, NWAVES * 64, LDS_BYTES) != hipSuccess || per_cu < 1) fprintf(stderr, "kernel_launch: occupancy query reports %d workgroups per CU\n", per_cu);
        (void)hipGetLastError();
        grid = cus;
    }
    if (grid < 0) return;
    if (hipMemsetAsync((char*)d_ws + WS_CTL, 0, CTL_ZERO_BYTES, stream) != hipSuccess) return;
    Args a{};
    for (int i = 0; i < 16; ++i) a.in[i] = (const float*)d_in[i];
    a.out = (float*)d_out; a.ws = (unsigned char*)d_ws;
    for (int i = 0; i < 64; ++i) a.invf[i] = (float)pow(10000.0, -(double)i / 64.0);
#if MK_PER_PHASE
#ifndef MK_DUP_MASK
#define MK_DUP_MASK 0
#endif
#ifndef MK_DUP_REPS
#define MK_DUP_REPS 2
#endif
    for (int ph = 0; ph < NPH; ++ph) { a.ph_lo = ph; a.ph_hi = ph + 1; const int reps = ((MK_DUP_MASK >> ph) & 1) ? MK_DUP_REPS : 1;
        for (int r = 0; r < reps; ++r) hipLaunchKernelGGL(mk_fwd, dim3(grid), dim3(NWAVES * 64), LDS_BYTES, stream, a); }
#else
    a.ph_lo = 0; a.ph_hi = NPH; hipLaunchKernelGGL(mk_fwd, dim3(grid), dim3(NWAVES * 64), LDS_BYTES, stream, a);
#endif
    const hipError_t le = hipPeekAtLastError();
    if (le != hipSuccess) fprintf(stderr, "kernel_launch: launch failed: %s\n", hipGetErrorName(le));
}
```

```cpp
#include <hip/hip_runtime.h>
#ifndef NST_ALL
#define NST_ALL 16
#endif
#include <cstdio>
#include <cstdint>
#include <cmath>
namespace pg8 {
#define PG8_LAS __attribute__((address_space(3)))
typedef unsigned short bf16_t;
typedef short bf16x8 __attribute__((ext_vector_type(8)));
typedef float f32x4 __attribute__((ext_vector_type(4)));
typedef unsigned u32x4 __attribute__((ext_vector_type(4)));
constexpr int BM = 256, BK = 64, HALF = 128, HTB = HALF * BK * 2  , STAGE_BYTES = 8 * HTB, NXCD = 8, WGM = 8;

__host__ __device__ __forceinline__ int lds_byte(int r, int c) { const int st = (r >> 4) * 2 + (c >> 5), rr = r & 15, cc = c & 31, ob = rr * 64 + cc * 2; return st * 1024 + (ob ^ (((ob >> 9) & 1) << 5)); }
__host__ __device__ __forceinline__ void stage_rc(int b, int& R, int& C) { const int st = b / 1024, sb = b % 1024, swz = sb ^ (((sb >> 9) & 1) << 5); R = (st >> 1) * 16 + swz / 64; C = (st & 1) * 32 + (swz % 64) / 2; }
__host__ __device__ __forceinline__ int perm32(int rho) { const int n = rho >> 4, i = rho & 15; return 8 * (i >> 2) + 4 * n + (i & 3); }

struct Unit { int pm, pn; };
struct Gemm { const bf16_t* A; const bf16_t* Bt; int M, N, K; float oscale; const bf16_t* A2; const bf16_t* Bt2; };
typedef int i32x8 __attribute__((ext_vector_type(8)));
typedef int i32x4v __attribute__((ext_vector_type(4)));
__device__ __forceinline__ i32x8 cat16(bf16x8 lo, bf16x8 hi) { const i32x4v a = __builtin_bit_cast(i32x4v, lo), b = __builtin_bit_cast(i32x4v, hi); return __builtin_shufflevector(a, b, 0, 1, 2, 3, 4, 5, 6, 7); }

struct StaticOrder {
    int nM, nN, nwg, G, c;
    __host__ __device__ void init(int M, int N, int G_, int c_) { nM = M / BM; nN = N / BM; nwg = nM * nN; G = G_; c = c_; }
    __host__ __device__ bool next(int i, Unit& u) const {
        const long L = (long)i * G + c; if (L >= nwg) return false;
        int wgid = (int)L; { const int q = nwg / NXCD, r = nwg % NXCD, xcd = wgid % NXCD, off = wgid / NXCD; wgid = (xcd < r ? xcd * (q + 1) : r * (q + 1) + (xcd - r) * q) + off; }
        const int nig = WGM * nN, gid = wgid / nig, fm = gid * WGM, gsz = (nM - fm) < WGM ? (nM - fm) : WGM;
        u.pm = fm + ((wgid % nig) % gsz); u.pn = (wgid % nig) / gsz; return true;
    }
    __device__ __forceinline__ void a_ready(const Unit&) const {}
    __device__ __forceinline__ void done(const Unit&) const {}
};

__device__ __forceinline__ unsigned cvt_pk_bf16(float lo, float hi) { unsigned r; asm volatile("v_cvt_pk_bf16_f32 %0, %1, %2" : "=v"(r) : "v"(lo), "v"(hi)); return r; }
typedef float f32x2 __attribute__((ext_vector_type(2)));
__device__ __forceinline__ f32x2 gelu_pk(f32x2 v) {
    const f32x2 av = __builtin_elementwise_abs(v), d = av * 0.2316418882f + 1.0f;
    f32x2 t; t.x = __builtin_amdgcn_rcpf(d.x); t.y = __builtin_amdgcn_rcpf(d.y);
    f32x2 q = t * 0.5307027145f + (-0.7265760135f); q = q * t + 0.7107068705f; q = q * t + (-0.142248368f); q = q * t + 0.127414796f; q = q * t;
    const f32x2 s = (v * v) * (-0.72134752044f);
    f32x2 e; e.x = __builtin_amdgcn_exp2f(s.x); e.y = __builtin_amdgcn_exp2f(s.y);
    const f32x2 m = v * (q * e), r = v - m;
    f32x2 o; o.x = v.x < 0.f ? m.x : r.x; o.y = v.y < 0.f ? m.y : r.y; return o;
}

template <int ACT  > struct EpiBf16 {
    static constexpr bool PERM = true, AFTER_DRAIN = false; static_assert(ACT == 0 || ACT == 1, "EpiBf16: ACT is 0 (none) or 1 (gelu_pk)");
    bf16_t* O; int ldc; const float* bias; int split_cols; size_t split_stride; float scale0;
    __device__ __forceinline__ void operator()(const f32x4 (&acc)[2][2][4][2], const Unit& u, int wr, int wc, int fr, int fq) const {
        const int row0 = u.pm * BM + wr * 64 + fr; int colt = u.pn * BM; bf16_t* base = O;
        float sc = 1.f; if (split_cols) { const int t = colt / split_cols; base += (size_t)t * split_stride; colt -= t * split_cols; if (t == 0) sc = scale0; }
        const int col0 = colt + wc * 32 + 8 * fq, bcol0 = u.pn * BM + wc * 32 + 8 * fq;
        f32x4 bv[2][2];
#pragma unroll
        for (int bj = 0; bj < 2; ++bj)
#pragma unroll
            for (int n = 0; n < 2; ++n) bv[bj][n] = bias ? *(const f32x4*)(bias + bcol0 + bj * HALF + 4 * n) : (f32x4){0.f, 0.f, 0.f, 0.f};
#pragma unroll
        for (int ai = 0; ai < 2; ++ai)
#pragma unroll
            for (int m = 0; m < 4; ++m) { bf16_t* rowp = base + (size_t)(row0 + ai * HALF + m * 16) * ldc + col0;
#pragma unroll
                for (int bj = 0; bj < 2; ++bj) { f32x4 v0 = acc[ai][bj][m][0] + bv[bj][0], v1 = acc[ai][bj][m][1] + bv[bj][1];
                    if (ACT == 1) { f32x2 a = gelu_pk((f32x2){v0[0], v0[1]}), b = gelu_pk((f32x2){v0[2], v0[3]}), c = gelu_pk((f32x2){v1[0], v1[1]}), d = gelu_pk((f32x2){v1[2], v1[3]});
                        v0 = (f32x4){a.x, a.y, b.x, b.y}; v1 = (f32x4){c.x, c.y, d.x, d.y}; }
                    v0 = v0 * sc; v1 = v1 * sc; u32x4 w; w.x = cvt_pk_bf16(v0[0], v0[1]); w.y = cvt_pk_bf16(v0[2], v0[3]); w.z = cvt_pk_bf16(v1[0], v1[1]); w.w = cvt_pk_bf16(v1[2], v1[3]);
                    *(u32x4*)(rowp + bj * HALF) = w; } }
    }
};
template <class Epi, class Sched, bool ALIGN_EPI = false, bool SP2 = false, int QM = 0, int NST = 0, bool ATILED = false, bool DUAL = false, int CHAIN = 0>
__device__ __forceinline__ void gemm_phase(PG8_LAS unsigned char* lds, const Gemm g, const Sched& S, const Epi& E, const char* chA = nullptr, const char* chB = nullptr) {
    int tid_ = threadIdx.x; asm volatile("" : "+v"(tid_));
    const int tid = tid_, wid = __builtin_amdgcn_readfirstlane(tid >> 6), lane = tid & 63, wr = wid >> 2, wc = wid & 3, fr = lane & 15, fq = lane >> 4;
    constexpr bool F8 = (QM == 1), I8 = (QM == 2), F4 = (QM == 3);
    const int K = g.K, nt = K / BK;
    unsigned voffA[2], voffB[2];
#pragma unroll
    for (int i = 0; i < 2; ++i) { int R, C; stage_rc(tid * 16 + i * 8192, R, C); const int Rb = Epi::PERM ? ((R & ~31) + perm32(R & 31)) : R;
        voffA[i] = (unsigned)(R * (ATILED ? BK : K) + C) * 2u; voffB[i] = (unsigned)(Rb * BK + C) * 2u; }
    const size_t kstep = (size_t)(BK * 2);
    const size_t hstep = (size_t)HALF * K * 2;
    const size_t kstepB = (size_t)BM * BK * 2, hstepB = (size_t)HALF * BK * 2;
    const size_t kstepA = ATILED ? (size_t)BM * BK * 2 : kstep, hstepA = ATILED ? (size_t)HALF * BK * 2 : hstep;
    const size_t tstep = 2 * hstep;
    const unsigned ldsw = (unsigned)wid * 1024u;
    const int aoff = lds_byte(wr * 64 + fr, fq * 8), boff = lds_byte(wc * 32 + fr, fq * 8);
#define PG8_SA(b, h) (((b) * 2 + (h)) * HTB)
#define PG8_SB(b, h) ((4 + (b) * 2 + (h)) * HTB)
#define PG8_STAGE(bufoff, gbase, voff) do { _Pragma("unroll") for (int _i = 0; _i < 2; ++_i) \
        __builtin_amdgcn_global_load_lds((const unsigned*)((const char*)(gbase) + (voff)[_i]), (PG8_LAS unsigned*)(lds + (bufoff) + ldsw + _i * 8192), 16, 0, 0); } while (0)
#define PG8_LDA(dst, b, h) do { _Pragma("unroll") for (int m = 0; m < 4; ++m) { if constexpr (F8) dst##8[m] = cat16(*(const PG8_LAS bf16x8*)(lds + PG8_SA(b, h) + aoff + m * 2048), *(const PG8_LAS bf16x8*)(lds + PG8_SA(b, h) + aoff + m * 2048 + 1024)); \
        else { _Pragma("unroll") for (int k = 0; k < 2; ++k) dst[m][k] = *(const PG8_LAS bf16x8*)(lds + PG8_SA(b, h) + aoff + m * 2048 + k * 1024); } } } while (0)
#define PG8_LDB(dst, b, h) do { _Pragma("unroll") for (int n = 0; n < 2; ++n) { if constexpr (F8) dst##8[n] = cat16(*(const PG8_LAS bf16x8*)(lds + PG8_SB(b, h) + boff + n * 2048), *(const PG8_LAS bf16x8*)(lds + PG8_SB(b, h) + boff + n * 2048 + 1024)); \
        else { _Pragma("unroll") for (int k = 0; k < 2; ++k) dst[n][k] = *(const PG8_LAS bf16x8*)(lds + PG8_SB(b, h) + boff + n * 2048 + k * 1024); } } } while (0)
#define PG8_MMA(ai, bj, At, Bt) do { __builtin_amdgcn_s_setprio(1); _Pragma("unroll") for (int m = 0; m < 4; ++m) _Pragma("unroll") for (int n = 0; n < 2; ++n) { \
        if constexpr (F8) asm volatile("v_mfma_f32_16x16x128_f8f6f4 %0, %1, %2, %0" : "+v"(acc[ai][bj][m][n]) : "v"(Bt##8[n]), "v"(At##8[m]));     \
        else if constexpr (I8) { _Pragma("unroll") for (int k = 0; k < 2; ++k) asm volatile("v_mfma_i32_16x16x64_i8 %0, %1, %2, %0" : "+v"(acc[ai][bj][m][n]) : "v"(Bt[n][k]), "v"(At[m][k])); } \
        else if constexpr (F4) { _Pragma("unroll") for (int k = 0; k < 2; ++k) asm volatile("v_mfma_f32_16x16x128_f8f6f4 %0, %1, %2, %0 cbsz:4 blgp:4" : "+v"(acc[ai][bj][m][n]) : "v"(Bt[n][k]), "v"(At[m][k])); } \
        else { _Pragma("unroll") for (int k = 0; k < 2; ++k) acc[ai][bj][m][n] = __builtin_amdgcn_mfma_f32_16x16x32_bf16(Bt[n][k], At[m][k], acc[ai][bj][m][n], 0, 0, 0); } } \
        __builtin_amdgcn_s_setprio(0); } while (0)
#define PG8_WAIT_V(n) asm volatile("s_waitcnt vmcnt(" #n ")" ::: "memory")
#define PG8_WAIT_VF(fresh_) do { if constexpr (NST != 0) asm volatile("s_waitcnt vmcnt(%1)\n\ts_cmp_lg_u32 %0, 0\n\ts_cbranch_scc1 .Lpg8w%=\n\ts_waitcnt vmcnt(8)\n.Lpg8w%=:" :: "s"(fresh_), "n"(10 + NST) : "scc", "memory"); else PG8_WAIT_V(8); } while (0)
#define PG8_WAIT_L(n) asm volatile("s_waitcnt lgkmcnt(" #n ")" ::: "memory")
#define PG8_BAR __builtin_amdgcn_s_barrier()
#define PG8_SCHED __builtin_amdgcn_sched_barrier(0)
    Unit cur, nxt; int ui = 0;
    if (!S.next(0, cur)) return;
    f32x4 acc[2][2][4][2];
#pragma unroll
    for (int a = 0; a < 2; ++a)
#pragma unroll
        for (int b = 0; b < 2; ++b)
#pragma unroll
            for (int m = 0; m < 4; ++m)
#pragma unroll
                for (int n = 0; n < 2; ++n) acc[a][b][m][n] = (f32x4){0.f, 0.f, 0.f, 0.f};
    bf16x8 At[4][2], B0[2][2], B1[2][2];
    i32x8 At8[4], B08[2], B18[2];
    const char* cA = (const char*)g.A + (size_t)cur.pm * tstep; const char* cB = (const char*)g.Bt + (size_t)cur.pn * tstep;
    S.a_ready(cur);
    static_assert(CHAIN == 0 || (NST != 0 && !DUAL), "CHAIN rides on the NST hand-over");
    if constexpr (CHAIN & 1) {   }
    else if constexpr (SP2) {
        PG8_STAGE(PG8_SB(0, 0), cB, voffB); PG8_STAGE(PG8_SB(0, 1), cB + hstepB, voffB); PG8_STAGE(PG8_SA(0, 0), cA, voffA); PG8_STAGE(PG8_SA(0, 1), cA + hstepA, voffA);
        if (wr == 1) PG8_BAR;
        PG8_WAIT_V(2); PG8_BAR;
        PG8_STAGE(PG8_SB(1, 0), cB + kstepB, voffB); PG8_STAGE(PG8_SA(1, 0), cA + kstepA, voffA); PG8_STAGE(PG8_SB(1, 1), cB + hstepB + kstepB, voffB);
        PG8_WAIT_V(6); PG8_BAR;
    } else {
        PG8_STAGE(PG8_SB(0, 0), cB, voffB); PG8_STAGE(PG8_SA(0, 0), cA, voffA); PG8_STAGE(PG8_SB(0, 1), cB + hstepB, voffB); PG8_STAGE(PG8_SA(0, 1), cA + hstepA, voffA);
        if (wr == 1) PG8_BAR;
        PG8_WAIT_V(4); PG8_BAR;
        PG8_STAGE(PG8_SB(1, 0), cB + kstepB, voffB); PG8_STAGE(PG8_SA(1, 0), cA + kstepA, voffA); PG8_STAGE(PG8_SB(1, 1), cB + hstepB + kstepB, voffB);
        PG8_WAIT_V(6); PG8_BAR;
    }
    for (;;) {
        const bool has_next = S.next(ui + 1, nxt);
        const char* uA = has_next ? (const char*)g.A + (size_t)nxt.pm * tstep : ((CHAIN & 2) ? chA : cA); const char* uB = has_next ? (const char*)g.Bt + (size_t)nxt.pn * tstep : ((CHAIN & 2) ? chB : cB);
        const char* nA = uA; const char* nB = uB;
#pragma unroll
        for (int seg = 0; seg < (DUAL ? 2 : 1); ++seg) {
        if (DUAL && seg == 0) { nA = (const char*)g.A2 + (size_t)cur.pm * tstep; nB = (const char*)g.Bt2 + (size_t)cur.pn * tstep; } else { nA = uA; nB = uB; }
        for (int t = 0; t < nt; t += 2) {
            const bool last = (t == nt - 2);
            const char* a1 = cA + (size_t)(t + 1) * kstepA;
            const char* a2 = last ? nA : cA + (size_t)(t + 2) * kstepA; const char* b2 = last ? nB : cB + (size_t)(t + 2) * kstepB;
            const char* a3 = a2 + kstepA; const char* b3 = b2 + kstepB;
            if (last && has_next) S.a_ready(nxt);
            if constexpr (SP2) {
            const int fresh = __builtin_amdgcn_readfirstlane((NST != 0 && t == 0 && (ui > 0 || (CHAIN & 1)) && seg == 0) ? 1 : 0);
            PG8_LDB(B0, 0, 0); PG8_LDB(B1, 0, 1); PG8_SCHED; PG8_LDA(At, 0, 0); PG8_STAGE(PG8_SA(1, 1), a1 + hstepA, voffA);
            PG8_WAIT_VF(fresh); PG8_WAIT_L(0); PG8_BAR; PG8_MMA(0, 0, At, B0); PG8_MMA(0, 1, At, B1); PG8_BAR; PG8_SCHED;
            PG8_LDA(At, 0, 1); PG8_STAGE(PG8_SB(0, 0), b2, voffB); PG8_STAGE(PG8_SB(0, 1), b2 + hstepB, voffB); PG8_STAGE(PG8_SA(0, 0), a2, voffA);
            PG8_WAIT_VF(fresh); PG8_WAIT_L(0); PG8_BAR; PG8_MMA(1, 0, At, B0); PG8_MMA(1, 1, At, B1); PG8_BAR; PG8_SCHED;
            PG8_LDB(B0, 1, 0); PG8_LDB(B1, 1, 1); PG8_SCHED; PG8_LDA(At, 1, 0); PG8_STAGE(PG8_SA(0, 1), a2 + hstepA, voffA);
            PG8_WAIT_VF(fresh); PG8_WAIT_L(0); PG8_BAR; PG8_MMA(0, 0, At, B0); PG8_MMA(0, 1, At, B1); PG8_BAR; PG8_SCHED;
            PG8_LDA(At, 1, 1); PG8_STAGE(PG8_SB(1, 0), b3, voffB); PG8_STAGE(PG8_SB(1, 1), b3 + hstepB, voffB); PG8_STAGE(PG8_SA(1, 0), a3, voffA);
            PG8_WAIT_V(8); PG8_WAIT_L(0); PG8_BAR; PG8_MMA(1, 0, At, B0); PG8_MMA(1, 1, At, B1); PG8_BAR; PG8_SCHED;
            } else {
            PG8_LDB(B0, 0, 0); PG8_SCHED; PG8_LDA(At, 0, 0); PG8_STAGE(PG8_SA(1, 1), a1 + hstepA, voffA);
            PG8_WAIT_L(8); PG8_BAR; PG8_WAIT_L(0); PG8_MMA(0, 0, At, B0); PG8_BAR; PG8_SCHED;
            PG8_LDB(B1, 0, 1); PG8_STAGE(PG8_SB(0, 0), b2, voffB);
            PG8_BAR; PG8_WAIT_L(0); PG8_MMA(0, 1, At, B1); PG8_BAR;
            PG8_LDA(At, 0, 1); PG8_STAGE(PG8_SA(0, 0), a2, voffA);
            PG8_BAR; PG8_WAIT_L(0); PG8_MMA(1, 0, At, B0); PG8_BAR; PG8_SCHED;
            PG8_STAGE(PG8_SB(0, 1), b2 + hstepB, voffB);
            PG8_WAIT_V(6); PG8_BAR; PG8_MMA(1, 1, At, B1); PG8_BAR;
            PG8_LDB(B0, 1, 0); PG8_SCHED; PG8_LDA(At, 1, 0); PG8_STAGE(PG8_SA(0, 1), a2 + hstepA, voffA);
            PG8_WAIT_L(8); PG8_BAR; PG8_WAIT_L(0); PG8_MMA(0, 0, At, B0); PG8_BAR; PG8_SCHED;
            PG8_LDB(B1, 1, 1); PG8_STAGE(PG8_SB(1, 0), b3, voffB);
            PG8_BAR; PG8_WAIT_L(0); PG8_MMA(0, 1, At, B1); PG8_BAR;
            PG8_LDA(At, 1, 1); PG8_STAGE(PG8_SA(1, 0), a3, voffA);
            PG8_BAR; PG8_WAIT_L(0); PG8_MMA(1, 0, At, B0); PG8_BAR; PG8_SCHED;
            PG8_STAGE(PG8_SB(1, 1), b3 + hstepB, voffB);
            PG8_WAIT_V(6); PG8_BAR; PG8_MMA(1, 1, At, B1); PG8_BAR;
            }
        }
        if constexpr (ALIGN_EPI) { if (wr == 0) PG8_BAR; }
        if constexpr (DUAL) { if (seg == 0) {
            asm volatile("s_nop 15\n\ts_nop 15" ::: "memory");
            E.mid(acc, cur, wr, wc, fr, fq);
            cA = nA; cB = nB;
            if constexpr (ALIGN_EPI) { if (wr == 1) PG8_BAR; } } }
        }
        if constexpr (F8 || F4) { asm volatile("s_nop 15\n\ts_nop 15" ::: "memory");
            const float os_ = g.oscale;
#pragma unroll
            for (int a = 0; a < 2; ++a)
#pragma unroll
                for (int b = 0; b < 2; ++b)
#pragma unroll
                    for (int m = 0; m < 4; ++m)
#pragma unroll
                        for (int n = 0; n < 2; ++n) acc[a][b][m][n] = acc[a][b][m][n] * os_; }
        if constexpr (I8) { asm volatile("s_nop 15\n\ts_nop 15" ::: "memory"); const float os_ = g.oscale;
#pragma unroll
            for (int a = 0; a < 2; ++a)
#pragma unroll
                for (int b = 0; b < 2; ++b)
#pragma unroll
                    for (int m = 0; m < 4; ++m)
#pragma unroll
                        for (int n = 0; n < 2; ++n) { const i32x4v iv = __builtin_bit_cast(i32x4v, acc[a][b][m][n]); acc[a][b][m][n] = (f32x4){(float)iv[0], (float)iv[1], (float)iv[2], (float)iv[3]} * os_; } }
        if constexpr (NST != 0) { static_assert(ALIGN_EPI && SP2, "NST needs both halves past the K-loop's last read of As[1][1] (ALIGN_EPI) and the SP2 loop");
            if (has_next || (CHAIN & 2)) PG8_STAGE(PG8_SA(1, 1), nA + kstepA + hstepA, voffA);
            asm volatile("" ::: "memory"); }
        if constexpr (!Epi::AFTER_DRAIN) { E(acc, cur, wr, wc, fr, fq); S.done(cur); }
        if (!has_next) break;
#pragma unroll
        for (int a = 0; a < 2; ++a)
#pragma unroll
            for (int b = 0; b < 2; ++b)
#pragma unroll
                for (int m = 0; m < 4; ++m)
#pragma unroll
                    for (int n = 0; n < 2; ++n) acc[a][b][m][n] = (f32x4){0.f, 0.f, 0.f, 0.f};
        cur = nxt; cA = nA; cB = nB; ++ui;
        if constexpr (ALIGN_EPI) { if (wr == 1) PG8_BAR; }
    }
    if constexpr (CHAIN & 2) { if constexpr (ALIGN_EPI) { if (wr == 1) PG8_BAR; } }
    else {
    PG8_WAIT_V(0);
    if constexpr (!ALIGN_EPI) { if (wr == 0) PG8_BAR; }
    PG8_BAR;
    }
    if constexpr (Epi::AFTER_DRAIN) { E.fused(acc, cur, wr, wc, fr, fq, lds, wid, lane); S.done(cur); }
#undef PG8_SA
#undef PG8_SB
#undef PG8_STAGE
#undef PG8_LDA
#undef PG8_LDB
#undef PG8_MMA
#undef PG8_WAIT_V
#undef PG8_WAIT_L
#undef PG8_BAR
#undef PG8_SCHED
}
}

constexpr int NWAVES = 8;
constexpr int BATCH = 4, SEQ = 2048, DM = 4096, M = BATCH * SEQ;
constexpr int AW = 2048, AHEADS = 16, AD = 128;
constexpr int BQH = 32, BKVH = 4, BD = 64, BKVW = 256, WIN = 128;
constexpr int NIN = 16896, DFF = 16384, PLE = 256;
constexpr int MBLK = 256, NBLK = SEQ / MBLK, TOPK = 3;
constexpr float LN_EPS = 1e-5f;
constexpr float ALPHA = 1.189207115002721f;
constexpr float LOG2E = 1.4426950408889634f;
constexpr float QSCALE_A = 0.08838834764831845f * LOG2E;
constexpr float QSCALE_B = 0.125f * LOG2E;
constexpr int NPH = 10;

constexpr size_t MiB = 1u << 20;
constexpr size_t WS_CTL = 0, CTL_ZERO_BYTES = 832 * 1024;
constexpr size_t WS_TABA = 1 * MiB;
constexpr size_t WS_TABB = 2 * MiB;
constexpr size_t WS_KMP  = 3 * MiB;
constexpr size_t WS_WIN  = 4 * MiB;
constexpr size_t WS_TA   = WS_WIN;
constexpr size_t WS_WUPA = 136 * MiB, WS_WUPB = 152 * MiB, WS_WO = 168 * MiB, WS_WPLE = 200 * MiB, WS_WPLEG = 202 * MiB;
constexpr size_t WS_WFFUP = 234 * MiB;
constexpr size_t WS_PLE  = 72 * MiB;
constexpr size_t WS_WFFDN = 362 * MiB;
constexpr size_t WS_XB   = 490 * MiB;
constexpr size_t WS_H1B  = WS_XB;
constexpr size_t WS_PB   = 554 * MiB;
constexpr size_t WS_QA = 558 * MiB, WS_KA = 590 * MiB, WS_VA = 622 * MiB, WS_QB = 654 * MiB, WS_KB = 686 * MiB, WS_VB = 690 * MiB, WS_GA = 694 * MiB, WS_GB = 758 * MiB;
constexpr size_t WS_MG   = WS_QA;
constexpr size_t WS_U    = WS_QA;
constexpr size_t WS_YA = 822 * MiB, WS_YB = 854 * MiB;
constexpr size_t WS_H2B  = WS_YA;
constexpr size_t WS_XB4  = 888 * MiB;
constexpr size_t WS_WG4  = 904 * MiB;
constexpr size_t WS_T12  = 940 * MiB;
constexpr size_t WS_END  = 1004 * MiB;
constexpr int CW_BAR = 4096;
constexpr size_t CB_ST1 = 256 * 1024, CB_ST2 = 384 * 1024, CB_C1F = 512 * 1024, CB_C2F = 640 * 1024, CB_C1G = 768 * 1024, CB_C2G = 800 * 1024;
constexpr size_t WS_CF32 = 3 * MiB + 512 * 1024;
constexpr float FXS = 4294967296.0f;
__device__ __forceinline__ void fx_add(long long* p, float v) { atomicAdd((unsigned long long*)p, (unsigned long long)(long long)(v * FXS)); }

constexpr int RING_OFF = 0, RING_BYTES = 131072;
constexpr int CV_CH = 1056, CV_SLOT = 8 * CV_CH, CV_WAVE = 2 * CV_SLOT;
constexpr int LDSCTL_OFF = 8 * CV_WAVE, MISC_OFF = LDSCTL_OFF + 320;
static_assert(LDSCTL_OFF >= RING_BYTES && LDSCTL_OFF % 16 == 0, "LDS map");
constexpr int LDS_BYTES = 147456;

#define GAS __attribute__((address_space(1)))
#define LAS __attribute__((address_space(3)))
typedef unsigned short bf16;
typedef float f32x4 __attribute__((ext_vector_type(4)));
typedef float f32x2 __attribute__((ext_vector_type(2)));
typedef unsigned u32x4 __attribute__((ext_vector_type(4)));
typedef unsigned u32x2 __attribute__((ext_vector_type(2)));
typedef unsigned char f8;
constexpr float F8S_X = 4.f, F8S_WIN = 512.f, F8S_Y = 64.f, F8S_WUP = 512.f, F8S_MG = 64.f, F8S_WO = 512.f;
constexpr float F4S_X = 2.f, F4S_WG = 128.f;
__device__ __forceinline__ unsigned pk8f4(float a, float b, float c, float d, float e, float f, float g, float h) {
    unsigned w = 0u; w = __builtin_amdgcn_cvt_scalef32_pk_fp4_f32(w, a, b, 1.0f, 0); w = __builtin_amdgcn_cvt_scalef32_pk_fp4_f32(w, c, d, 1.0f, 1);
    w = __builtin_amdgcn_cvt_scalef32_pk_fp4_f32(w, e, f, 1.0f, 2); w = __builtin_amdgcn_cvt_scalef32_pk_fp4_f32(w, g, h, 1.0f, 3); return w;
}
constexpr float I8S_T2 = 20.f, I8S_WG = 1800.f;
__device__ __forceinline__ unsigned pk4u8(float a, float b, float c, float d) { unsigned r = 0; r = __builtin_amdgcn_cvt_pk_u8_f32(a * 255.f, 0, r); r = __builtin_amdgcn_cvt_pk_u8_f32(b * 255.f, 1, r); r = __builtin_amdgcn_cvt_pk_u8_f32(c * 255.f, 2, r); return __builtin_amdgcn_cvt_pk_u8_f32(d * 255.f, 3, r); }
__device__ __forceinline__ f32x4 un4u8(unsigned w) { return (f32x4){(float)(w & 0xffu), (float)((w >> 8) & 0xffu), (float)((w >> 16) & 0xffu), (float)(w >> 24)} * (1.0f / 255.f); }
__device__ __forceinline__ unsigned pk4i8(float a, float b, float c, float d) {
    const int ia = (int)__builtin_rintf(__builtin_amdgcn_fmed3f(a, -127.f, 127.f)), ib = (int)__builtin_rintf(__builtin_amdgcn_fmed3f(b, -127.f, 127.f)), ic = (int)__builtin_rintf(__builtin_amdgcn_fmed3f(c, -127.f, 127.f)), id = (int)__builtin_rintf(__builtin_amdgcn_fmed3f(d, -127.f, 127.f));
    return ((unsigned)ia & 0xffu) | (((unsigned)ib & 0xffu) << 8) | (((unsigned)ic & 0xffu) << 16) | ((unsigned)id << 24);
}
__device__ __forceinline__ unsigned pk4f8(float a, float b, float c, float d) {
    a = __builtin_amdgcn_fmed3f(a, -448.f, 448.f); b = __builtin_amdgcn_fmed3f(b, -448.f, 448.f); c = __builtin_amdgcn_fmed3f(c, -448.f, 448.f); d = __builtin_amdgcn_fmed3f(d, -448.f, 448.f);
    unsigned w = 0u; w = __builtin_amdgcn_cvt_pk_fp8_f32(a, b, w, false); w = __builtin_amdgcn_cvt_pk_fp8_f32(c, d, w, true); return w;
}
#define LDS_WAIT() asm volatile("s_waitcnt lgkmcnt(0)" ::: "memory")
#define VM_WAIT() asm volatile("s_waitcnt vmcnt(0)" ::: "memory")

typedef __bf16 bf16x2_t __attribute__((ext_vector_type(2)));
__device__ __forceinline__ unsigned pk2(float lo, float hi) { const f32x2 v = {lo, hi}; const bf16x2_t b = __builtin_convertvector(v, bf16x2_t); return __builtin_bit_cast(unsigned, b); }
__device__ __forceinline__ float bflo(unsigned u) { return __uint_as_float(u << 16); }
__device__ __forceinline__ float bfhi(unsigned u) { return __uint_as_float(u & 0xffff0000u); }
__device__ __forceinline__ float sigmoidf_(float x) { return __builtin_amdgcn_rcpf(1.0f + __expf(-x)); }
__device__ __forceinline__ float wave_sum(float v) {
#pragma unroll
    for (int o = 1; o < 64; o <<= 1) v += __shfl_xor(v, o);
    return v;
}
__device__ __forceinline__ float wave_max(float v) {
#pragma unroll
    for (int o = 1; o < 64; o <<= 1) v = fmaxf(v, __shfl_xor(v, o));
    return v;
}

#define XB_TMO      128
#define XB_XCNT(j)  (256  + 64 * (j))
#define XB_XSUB(j)  (1280 + 64 * (j))
#define XB_XGEN(j)  (2304 + 64 * (j))
#define XB_TOP      3328
#define XB_TOPGEN   3392
#define XCD_BAR_WORDS 3456
#define XB_SPIN_CAP (1u << 18)

__device__ __forceinline__ unsigned xb_ld(unsigned* p)              { return __hip_atomic_load(p, __ATOMIC_RELAXED, __HIP_MEMORY_SCOPE_AGENT); }
__device__ __forceinline__ unsigned xb_add(unsigned* p, unsigned v) { return __hip_atomic_fetch_add(p, v, __ATOMIC_RELAXED, __HIP_MEMORY_SCOPE_AGENT); }
__device__ __forceinline__ unsigned xb_xcc_id() { return (unsigned)__builtin_amdgcn_s_getreg((3 << 11) | 20) & 0xFu; }
#define XB_SPIN(cond, bar) do { unsigned _sp = 0; while (cond) { __builtin_amdgcn_s_sleep(1); \
    if ((++_sp & 255u) == 0u) { if (xb_ld(&(bar)[XB_TMO])) break; if (_sp > XB_SPIN_CAP) { atomicAdd(&(bar)[XB_TMO], 1u); break; } } } } while (0)

struct XcdBarrier {
    unsigned* bar; unsigned x;
    volatile LAS unsigned* st;
};

__device__ __forceinline__ XcdBarrier xcd_barrier_post(unsigned* bar, volatile LAS unsigned* st) {
    XcdBarrier b; b.bar = bar; b.x = xb_xcc_id(); b.st = st;
    if (threadIdx.x == 0) (void)xb_add(&bar[XB_XCNT(b.x)], 1u);
    return b;
}
__device__ __forceinline__ void xcd_barrier_complete(unsigned* bar, unsigned x, unsigned& nloc, unsigned& nx) {
    const unsigned G = gridDim.x * gridDim.y * gridDim.z;
    unsigned sum, cnt, mine, sp = 0u;
    for (;;) {
        sum = 0u; cnt = 0u; mine = 0u;
#pragma unroll
        for (unsigned j = 0; j < 16; ++j) { const unsigned c = xb_ld(&bar[XB_XCNT(j)]); sum += c; cnt += (c > 0u) ? 1u : 0u; mine = (j == x) ? c : mine; }
        if (sum == G) break;
        __builtin_amdgcn_s_sleep(1);
        if ((++sp & 255u) == 0u) { if (xb_ld(&bar[XB_TMO])) break; if (sp > XB_SPIN_CAP) { atomicAdd(&bar[XB_TMO], 1u); break; } }
    }
    nloc = mine > 0u ? mine : 1u; nx = cnt > 0u ? cnt : 1u;
}

__device__ __forceinline__ void xcd_barrier(const XcdBarrier& b) {
    asm volatile("s_waitcnt vmcnt(0)" ::: "memory");
    __syncthreads();
    if (threadIdx.x == 0) {
        unsigned* bar = b.bar;
        __builtin_amdgcn_s_waitcnt(0);
        unsigned nloc = b.st[0], nx = b.st[1];
        if (nloc == 0u) { xcd_barrier_complete(bar, b.x, nloc, nx); b.st[0] = nloc; b.st[1] = nx; }
        const unsigned old = xb_add(&bar[XB_XSUB(b.x)], 1u);
        const unsigned gen = old / nloc;
        if (old + 1u == (gen + 1u) * nloc) {
            __builtin_amdgcn_fence(__ATOMIC_RELEASE, "agent");
            asm volatile("s_waitcnt vmcnt(0)" ::: "memory");
            const unsigned og = xb_add(&bar[XB_TOP], 1u);
            const unsigned tg = og / nx;
            if (og + 1u == (tg + 1u) * nx) xb_add(&bar[XB_TOPGEN], 1u);
            else XB_SPIN(xb_ld(&bar[XB_TOPGEN]) == tg, bar);
            __builtin_amdgcn_fence(__ATOMIC_ACQUIRE, "agent");
            xb_add(&bar[XB_XGEN(b.x)], 1u);
            asm volatile("s_waitcnt vmcnt(0)" ::: "memory");
        } else {
            XB_SPIN(xb_ld(&bar[XB_XGEN(b.x)]) == gen, bar);
            __builtin_amdgcn_fence(__ATOMIC_ACQUIRE, "agent");
            asm volatile("s_waitcnt vmcnt(0)" ::: "memory");
        }
    }
    __syncthreads();
}


__device__ __forceinline__ size_t toff(int n, int kbyte, int rowbytes) { return (size_t)(n >> 8) * ((size_t)rowbytes * 256) + ((size_t)(kbyte >> 7) * 256 + (n & 255)) * 128 + (kbyte & 127); }
template <class T> __device__ __forceinline__ T* tp_base(T* p, int pm, int pn, int ntn, int nsteps, int step) { return p + ((size_t)(pm * ntn + pn) * nsteps + step) * 512; }
using pg8::Unit;
template <int MODE> struct EpiZ {
    static constexpr bool PERM = true, AFTER_DRAIN = false;
    bf16* O; bf16* O2; int ldc; float sc; const float* tab; const float* bias; float* kmp;
    __device__ __forceinline__ void plain(const f32x4 (&acc)[2][2][4][2], bf16* Op, int row0, int col0) const {
#pragma unroll
        for (int ai = 0; ai < 2; ++ai)
#pragma unroll
            for (int m = 0; m < 4; ++m) { bf16* rowp = Op + (size_t)(row0 + ai * 128 + m * 16) * ldc + col0;
#pragma unroll
                for (int bj = 0; bj < 2; ++bj) { const f32x4 v0 = acc[ai][bj][m][0], v1 = acc[ai][bj][m][1];
                    u32x4 w; w.x = pk2(v0[0], v0[1]); w.y = pk2(v0[2], v0[3]); w.z = pk2(v1[0], v1[1]); w.w = pk2(v1[2], v1[3]);
                    *(u32x4*)(rowp + bj * 128) = w; } }
    }
    template <bool ISA> __device__ __forceinline__ void rope(const f32x4 (&acc)[2][2][4][2], bf16* Op, int row0, int col0, int wc, int fq) const {
        constexpr int tstride = ISA ? 128 : 64;
        const int i0 = ISA ? (16 * wc + 4 * fq) : (16 * (wc & 1) + 4 * fq);
#pragma unroll
        for (int ai = 0; ai < 2; ++ai)
#pragma unroll
            for (int m = 0; m < 4; ++m) { const int row = row0 + ai * 128 + m * 16, pos = row & (SEQ - 1);
                const f32x4 t0 = *(const f32x4*)(tab + (size_t)pos * tstride + 2 * i0), t1 = *(const f32x4*)(tab + (size_t)pos * tstride + 2 * i0 + 4);
                bf16* rowp = Op + (size_t)row * ldc + col0;
#pragma unroll
                for (int bj = 0; bj < 2; ++bj) { const f32x4 v0 = acc[ai][bj][m][0], v1 = acc[ai][bj][m][1];
                    f32x4 o0, o1;
                    o0[0] = v0[0] * t0[0] - v0[1] * t0[1]; o0[1] = v0[0] * t0[1] + v0[1] * t0[0];
                    o0[2] = v0[2] * t0[2] - v0[3] * t0[3]; o0[3] = v0[2] * t0[3] + v0[3] * t0[2];
                    o1[0] = v1[0] * t1[0] - v1[1] * t1[1]; o1[1] = v1[0] * t1[1] + v1[1] * t1[0];
                    o1[2] = v1[2] * t1[2] - v1[3] * t1[3]; o1[3] = v1[2] * t1[3] + v1[3] * t1[2];
                    o0 = o0 * sc; o1 = o1 * sc;
                    u32x4 w; w.x = pk2(o0[0], o0[1]); w.y = pk2(o0[2], o0[3]); w.z = pk2(o1[0], o1[1]); w.w = pk2(o1[2], o1[3]);
                    *(u32x4*)(rowp + bj * 128) = w; }
                asm volatile("" ::: "memory"); }
    }
    __device__ __forceinline__ void operator()(const f32x4 (&acc)[2][2][4][2], const Unit& u, int wr, int wc, int fr, int fq) const {
        const int row0 = u.pm * 256 + wr * 64 + fr, col0 = u.pn * 256 + wc * 32 + 8 * fq, tidp = ((wr * 4 + wc) * 64 + fq * 16 + fr) & 511;
        if constexpr (MODE == 0) plain(acc, O, row0, col0);
        else if constexpr (MODE == 1) rope<true>(acc, O, row0, col0, wc, fq);
        else if constexpr (MODE == 3) rope<false>(acc, O, row0, col0, wc, fq);
        else if constexpr (MODE == 5) { if (u.pn == 0) rope<false>(acc, O, row0, col0, wc, fq); else plain(acc, O2, row0, col0 - 256); }
        else if constexpr (MODE == 4) {
            f32x4 bv[2][2];
#pragma unroll
            for (int bj = 0; bj < 2; ++bj)
#pragma unroll
                for (int n = 0; n < 2; ++n) bv[bj][n] = *(const f32x4*)(bias + col0 + bj * 128 + 4 * n);
#pragma unroll
            for (int ai = 0; ai < 2; ++ai)
#pragma unroll
                for (int m = 0; m < 4; ++m) {
#pragma unroll
                    for (int bj = 0; bj < 2; ++bj) { const f32x4 v0 = acc[ai][bj][m][0] + bv[bj][0], v1 = acc[ai][bj][m][1] + bv[bj][1];
                        u32x2 w; w.x = pk4u8(sigmoidf_(v0[0]), sigmoidf_(v0[1]), sigmoidf_(v0[2]), sigmoidf_(v0[3])); w.y = pk4u8(sigmoidf_(v1[0]), sigmoidf_(v1[1]), sigmoidf_(v1[2]), sigmoidf_(v1[3]));
                        tp_base((u32x2*)(u.pn >= 16 ? O2 : O), u.pm, u.pn & 15, 16, 16, (ai * 4 + m) * 2 + bj)[tidp] = w; } }
        } else {
            rope<true>(acc, O, row0, col0, wc, fq);
            const int i0 = 16 * wc + 4 * fq;
            float* kp = kmp + (size_t)(u.pm * 2 + wr) * AW + col0;
#pragma unroll
            for (int bj = 0; bj < 2; ++bj) { f32x4 c0 = (f32x4){0.f, 0.f, 0.f, 0.f}, c1 = (f32x4){0.f, 0.f, 0.f, 0.f};
#pragma unroll
                for (int ai = 0; ai < 2; ++ai)
#pragma unroll
                    for (int m = 0; m < 4; ++m) { const int pos = (row0 + ai * 128 + m * 16) & (SEQ - 1);
                        const f32x4 t0 = *(const f32x4*)(tab + (size_t)pos * 128 + 2 * i0), t1 = *(const f32x4*)(tab + (size_t)pos * 128 + 2 * i0 + 4);
                        const f32x4 v0 = acc[ai][bj][m][0], v1 = acc[ai][bj][m][1];
                        c0[0] += v0[0] * t0[0] - v0[1] * t0[1]; c0[1] += v0[0] * t0[1] + v0[1] * t0[0];
                        c0[2] += v0[2] * t0[2] - v0[3] * t0[3]; c0[3] += v0[2] * t0[3] + v0[3] * t0[2];
                        c1[0] += v1[0] * t1[0] - v1[1] * t1[1]; c1[1] += v1[0] * t1[1] + v1[1] * t1[0];
                        c1[2] += v1[2] * t1[2] - v1[3] * t1[3]; c1[3] += v1[2] * t1[3] + v1[3] * t1[2]; }
#pragma unroll
                for (int o = 1; o < 16; o <<= 1) {
#pragma unroll
                    for (int j = 0; j < 4; ++j) { c0[j] += __shfl_xor(c0[j], o); c1[j] += __shfl_xor(c1[j], o); } }
                if (fr == 0) { *(f32x4*)(kp + bj * 128) = c0; *(f32x4*)(kp + bj * 128 + 4) = c1; }
                asm volatile("" ::: "memory"); }
        }
    }
};
constexpr float GB_MIN = 9.094947e-13f;
struct EpiMG {
    static constexpr bool PERM = true, AFTER_DRAIN = false;
    const bf16* Ga; const bf16* Gb; f8* MG;
    __device__ __forceinline__ void mid(f32x4 (&acc)[2][2][4][2], const Unit& u, int wr, int wc, int fr, int fq) const {
        asm volatile("" : "+v"(fr));
        const int tidp = ((wr * 4 + wc) * 64 + fq * 16 + fr) & 511;
#pragma unroll
        for (int ai = 0; ai < 2; ++ai)
#pragma unroll
            for (int m = 0; m < 4; ++m) {
#pragma unroll
                for (int bj = 0; bj < 2; ++bj) { const u32x2 ga = tp_base((const u32x2*)Ga, u.pm, u.pn, DM / 256, 16, (ai * 4 + m) * 2 + bj)[tidp], gb = tp_base((const u32x2*)Gb, u.pm, u.pn, DM / 256, 16, (ai * 4 + m) * 2 + bj)[tidp];
                    const f32x4 a0 = un4u8(ga.x), a1 = un4u8(ga.y), b0 = un4u8(gb.x), b1 = un4u8(gb.y);
                    f32x4 r0, r1;
#pragma unroll
                    for (int j = 0; j < 4; ++j) { r0[j] = a0[j] * __builtin_amdgcn_rcpf(fmaxf(b0[j], GB_MIN)); r1[j] = a1[j] * __builtin_amdgcn_rcpf(fmaxf(b1[j], GB_MIN)); }
                    acc[ai][bj][m][0] = acc[ai][bj][m][0] * r0; acc[ai][bj][m][1] = acc[ai][bj][m][1] * r1; }
                asm volatile("" : "+v"(acc[ai][0][m][0]), "+v"(acc[ai][0][m][1]), "+v"(acc[ai][1][m][0]), "+v"(acc[ai][1][m][1]) :: "memory"); }
    }
    __device__ __forceinline__ void operator()(const f32x4 (&acc)[2][2][4][2], const Unit& u, int wr, int wc, int fr, int fq) const {
        asm volatile("" : "+v"(fr));
        const int row0 = u.pm * 256 + wr * 64 + fr, col0 = u.pn * 256 + wc * 32 + 8 * fq, tidp = ((wr * 4 + wc) * 64 + fq * 16 + fr) & 511;
#pragma unroll
        for (int ai = 0; ai < 2; ++ai)
#pragma unroll
            for (int m = 0; m < 4; ++m) {
#pragma unroll
                for (int bj = 0; bj < 2; ++bj) { const u32x2 gb = tp_base((const u32x2*)Gb, u.pm, u.pn, DM / 256, 16, (ai * 4 + m) * 2 + bj)[tidp];
                    f32x4 b0 = un4u8(gb.x), b1 = un4u8(gb.y);
#pragma unroll
                    for (int j = 0; j < 4; ++j) { b0[j] = fmaxf(b0[j], GB_MIN) * F8S_MG; b1[j] = fmaxf(b1[j], GB_MIN) * F8S_MG; }
                    const f32x4 v0 = acc[ai][bj][m][0] * b0, v1 = acc[ai][bj][m][1] * b1;
                    u32x2 w; w.x = pk4f8(v0[0], v0[1], v0[2], v0[3]); w.y = pk4f8(v1[0], v1[1], v1[2], v1[3]);
                    *(u32x2*)((unsigned char*)MG + toff(row0 + ai * 128 + m * 16, col0 + bj * 128, DM)) = w; } }
    }
};
__device__ __forceinline__ f32x2 ln_stats(const long long* st, int row) {
    const double s1 = (double)st[2 * row] * (1.0 / 4294967296.0 / DM), s2 = (double)st[2 * row + 1] * (1.0 / 4294967296.0 / DM);
    const float mean = (float)s1, var = fmaxf((float)(s2 - s1 * s1), 0.f);
    return (f32x2){mean, __builtin_amdgcn_rsqf(var + LN_EPS)};
}
template <bool LN> struct EpiRes {
    static constexpr bool PERM = true, AFTER_DRAIN = false;
    const void* base; bf16* out; bf16* outb; const long long* st; const float* g; const float* b; long long* stn;
    __device__ __forceinline__ void operator()(const f32x4 (&acc)[2][2][4][2], const Unit& u, int wr, int wc, int fr, int fq) const {
        const int row0 = u.pm * 256 + wr * 64 + fr, col0 = u.pn * 256 + wc * 32 + 8 * fq, tidp = ((wr * 4 + wc) * 64 + fq * 16 + fr) & 511;
        f32x4 gg[2][2], bb[2][2];
        if (LN) {
#pragma unroll
            for (int bj = 0; bj < 2; ++bj)
#pragma unroll
                for (int n = 0; n < 2; ++n) { gg[bj][n] = *(const f32x4*)(g + col0 + bj * 128 + 4 * n); bb[bj][n] = *(const f32x4*)(b + col0 + bj * 128 + 4 * n); } }
#pragma unroll
        for (int ai = 0; ai < 2; ++ai)
#pragma unroll
            for (int m = 0; m < 4; ++m) { const int row = row0 + ai * 128 + m * 16; const size_t off = (size_t)row * DM + col0;
                f32x2 sr = {0.f, 0.f}; if (LN) sr = ln_stats(st, row);
                float s1 = 0.f, s2 = 0.f;
#pragma unroll
                for (int bj = 0; bj < 2; ++bj) { f32x4 t[2];
                    if (LN) { const u32x4 tw = *(const u32x4*)((const unsigned char*)base + toff(row, 2 * (col0 + bj * 128), 2 * DM));
                        t[0] = (f32x4){bflo(tw.x), bfhi(tw.x), bflo(tw.y), bfhi(tw.y)}; t[1] = (f32x4){bflo(tw.z), bfhi(tw.z), bflo(tw.w), bfhi(tw.w)}; }
                    else { t[0] = *(const f32x4*)((const float*)base + off + bj * 128); t[1] = *(const f32x4*)((const float*)base + off + bj * 128 + 4); }
#pragma unroll
                    for (int n = 0; n < 2; ++n) { f32x4 x = t[n];
                        if (LN) x = ((x - sr[0]) * sr[1] * gg[bj][n] + bb[bj][n]) * ALPHA + acc[ai][bj][m][n]; else x = x * ALPHA + acc[ai][bj][m][n];
                        t[n] = x; s1 += (x[0] + x[1]) + (x[2] + x[3]); s2 += (x[0] * x[0] + x[1] * x[1]) + (x[2] * x[2] + x[3] * x[3]); }
                    u32x4 w; w.x = pk2(t[0][0], t[0][1]); w.y = pk2(t[0][2], t[0][3]); w.z = pk2(t[1][0], t[1][1]); w.w = pk2(t[1][2], t[1][3]);
                    if (LN) { tp_base((u32x4*)out, u.pm, u.pn, DM / 256, 16, (ai * 4 + m) * 2 + bj)[tidp] = w;
                        u32x2 w8; w8.x = pk4i8(t[0][0] * I8S_T2, t[0][1] * I8S_T2, t[0][2] * I8S_T2, t[0][3] * I8S_T2); w8.y = pk4i8(t[1][0] * I8S_T2, t[1][1] * I8S_T2, t[1][2] * I8S_T2, t[1][3] * I8S_T2);
                        *(u32x2*)((unsigned char*)outb + toff(row, col0 + bj * 128, DM)) = w8; }
                    else *(u32x4*)((unsigned char*)outb + toff(row, 2 * (col0 + bj * 128), 2 * DM)) = w; }
                s1 += __shfl_xor(s1, 16); s2 += __shfl_xor(s2, 16); s1 += __shfl_xor(s1, 32); s2 += __shfl_xor(s2, 32);
                if (fq == 0) { fx_add(stn + 2 * row, s1); fx_add(stn + 2 * row + 1, s2); }
                asm volatile("" ::: "memory"); }
    }
};
struct EpiU {
    static constexpr bool PERM = true, AFTER_DRAIN = false;
    bf16* U; const long long* st; const float* c1; const float* c2;
    __device__ __forceinline__ void operator()(const f32x4 (&acc)[2][2][4][2], const Unit& u, int wr, int wc, int fr, int fq) const {
        const int row0 = u.pm * 256 + wr * 64 + fr, col0 = u.pn * 256 + wc * 32 + 8 * fq, rit = wr * 64 + fr;
        bf16* Ut = U + ((size_t)u.pm * (DFF / 64) + 4 * u.pn + (wc >> 1)) * (256 * 64) + 32 * (wc & 1) + 8 * fq;
        f32x2 sr[2][4];
#pragma unroll
        for (int ai = 0; ai < 2; ++ai)
#pragma unroll
            for (int m = 0; m < 4; ++m) sr[ai][m] = ln_stats(st, row0 + ai * 128 + m * 16);
        f32x4 cc[2][4];
#pragma unroll
        for (int bj = 0; bj < 2; ++bj) { cc[bj][0] = *(const f32x4*)(c1 + col0 + bj * 128); cc[bj][1] = *(const f32x4*)(c1 + col0 + bj * 128 + 4); cc[bj][2] = *(const f32x4*)(c2 + col0 + bj * 128); cc[bj][3] = *(const f32x4*)(c2 + col0 + bj * 128 + 4); }
#pragma unroll
        for (int bj = 0; bj < 2; ++bj)
#pragma unroll
            for (int i = 0; i < 4; ++i) asm volatile("" : "+v"(cc[bj][i]));
#pragma unroll
        for (int bj = 0; bj < 2; ++bj)
#pragma unroll
            for (int ai = 0; ai < 2; ++ai)
#pragma unroll
                for (int m = 0; m < 4; ++m) {
                    f32x4 v0 = (acc[ai][bj][m][0] - cc[bj][0] * sr[ai][m][0]) * sr[ai][m][1] + cc[bj][2], v1 = (acc[ai][bj][m][1] - cc[bj][1] * sr[ai][m][0]) * sr[ai][m][1] + cc[bj][3];
#pragma unroll
                    for (int j = 0; j < 4; ++j) { const float a = fmaxf(v0[j], 0.f), b = fmaxf(v1[j], 0.f); v0[j] = a * a; v1[j] = b * b; }
                    u32x4 w; w.x = pk2(v0[0], v0[1]); w.y = pk2(v0[2], v0[3]); w.z = pk2(v1[0], v1[1]); w.w = pk2(v1[2], v1[3]);
                    *(u32x4*)(Ut + (size_t)(2 * bj) * (256 * 64) + (unsigned)(rit + ai * 128 + m * 16) * 64u) = w; }
    }
};
struct EpiPle {
    static constexpr bool PERM = true, AFTER_DRAIN = false;
    bf16* C;
    __device__ __forceinline__ void operator()(const f32x4 (&acc)[2][2][4][2], const Unit& u, int wr, int wc, int fr, int fq) const {
        const int tidp = ((wr * 4 + wc) * 64 + fq * 16 + fr) & 511;
#pragma unroll
        for (int ai = 0; ai < 2; ++ai)
#pragma unroll
            for (int m = 0; m < 4; ++m)
#pragma unroll
                for (int bj = 0; bj < 2; ++bj) { const f32x4 v0 = acc[ai][bj][m][0], v1 = acc[ai][bj][m][1]; u32x4 w; w.x = pk2(v0[0], v0[1]); w.y = pk2(v0[2], v0[3]); w.z = pk2(v1[0], v1[1]); w.w = pk2(v1[2], v1[3]);
                    tp_base((u32x4*)C, u.pm, u.pn, DM / 256, 16, (ai * 4 + m) * 2 + bj)[tidp] = w; }
    }
};
struct EpiFinal {
    static constexpr bool PERM = true, AFTER_DRAIN = false;
    const bf16* PLEp; const bf16* t2p; float* out; const long long* st; const float* g; const float* b; const float* c1; const float* c2;
    __device__ __forceinline__ void operator()(const f32x4 (&acc)[2][2][4][2], const Unit& u, int wr, int wc, int fr, int fq) const {
        const int row0 = u.pm * 256 + wr * 64 + fr, col0 = u.pn * 256 + wc * 32 + 8 * fq, tidp = ((wr * 4 + wc) * 64 + fq * 16 + fr) & 511;
        f32x2 sr[2][4];
#pragma unroll
        for (int ai = 0; ai < 2; ++ai)
#pragma unroll
            for (int m = 0; m < 4; ++m) sr[ai][m] = ln_stats(st, row0 + ai * 128 + m * 16);
#pragma unroll
        for (int bj = 0; bj < 2; ++bj) { const int co = col0 + bj * 128; f32x4 gg[2], bb[2], cc1[2], cc2[2];
#pragma unroll
            for (int n = 0; n < 2; ++n) { gg[n] = *(const f32x4*)(g + co + 4 * n); bb[n] = *(const f32x4*)(b + co + 4 * n); cc1[n] = *(const f32x4*)(c1 + co + 4 * n); cc2[n] = *(const f32x4*)(c2 + co + 4 * n); }
#pragma unroll
            for (int ai = 0; ai < 2; ++ai)
#pragma unroll
                for (int m = 0; m < 4; ++m) { const int row = row0 + ai * 128 + m * 16; const f32x2 s_ = sr[ai][m];
                    const u32x4 pw = tp_base((const u32x4*)PLEp, u.pm, u.pn, DM / 256, 16, (ai * 4 + m) * 2 + bj)[tidp];
                    const f32x4 pl[2] = {{bflo(pw.x), bfhi(pw.x), bflo(pw.y), bfhi(pw.y)}, {bflo(pw.z), bfhi(pw.z), bflo(pw.w), bfhi(pw.w)}};
                    const u32x4 tw = tp_base((const u32x4*)t2p, u.pm, u.pn, DM / 256, 16, (ai * 4 + m) * 2 + bj)[tidp];
                    const f32x4 tv[2] = {{bflo(tw.x), bfhi(tw.x), bflo(tw.y), bfhi(tw.y)}, {bflo(tw.z), bfhi(tw.z), bflo(tw.w), bfhi(tw.w)}};
#pragma unroll
                    for (int n = 0; n < 2; ++n) { const f32x4 t2 = tv[n];
                        const f32x4 h = (t2 - s_[0]) * s_[1] * gg[n] + bb[n], a = (acc[ai][bj][m][n] - cc1[n] * s_[0]) * s_[1] + cc2[n];
                        f32x4 o; o[0] = h[0] + sigmoidf_(a[0]) * pl[n][0]; o[1] = h[1] + sigmoidf_(a[1]) * pl[n][1]; o[2] = h[2] + sigmoidf_(a[2]) * pl[n][2]; o[3] = h[3] + sigmoidf_(a[3]) * pl[n][3];
                        *(f32x4*)(out + (size_t)row * DM + co + 4 * n) = o; }
                    asm volatile("" ::: "memory"); } }
    }
};

template <bool FOLD> __device__ __forceinline__ void p0_transpose_item(const float* W, int K, int N, bf16* WT, int kb, int nb, int mode, int lane, const float* gf = nullptr, const float* bfv = nullptr, long long* c1 = nullptr, long long* c2 = nullptr) {
    int lane_ = lane; asm volatile("" : "+v"(lane_));
    const int kg = lane_ & 7, nq = lane_ >> 3, k0 = 64 * kb + 8 * kg, ns = 32 * nb + 4 * nq;
    const float* src = W + (size_t)k0 * N + ns;
    f32x4 v[8];
#pragma unroll
    for (int j = 0; j < 8; ++j) v[j] = __builtin_nontemporal_load((const f32x4*)(src + (size_t)j * N));
    f32x4 a1 = {0.f, 0.f, 0.f, 0.f}, a2 = {0.f, 0.f, 0.f, 0.f};
    if (FOLD) {
#pragma unroll
        for (int j = 0; j < 8; ++j) { const float gk = gf[k0 + j], bk = bfv[k0 + j]; a2 += v[j] * bk; v[j] = v[j] * gk; } }
    int drow = ns, dstep = 1;
    if (mode != 0) { const int HW = (mode == 1) ? 128 : 64, half = HW >> 1, hbase = ns & ~(HW - 1), d = ns & (HW - 1), t = d >= half ? 1 : 0, i = d - half * t; drow = hbase + 2 * i + t; dstep = 2; }
#pragma unroll
    for (int c = 0; c < 4; ++c) { u32x4 o; o.x = pk2(v[0][c], v[1][c]); o.y = pk2(v[2][c], v[3][c]); o.z = pk2(v[4][c], v[5][c]); o.w = pk2(v[6][c], v[7][c]);
        if (FOLD) a1[c] = ((bflo(o.x) + bfhi(o.x)) + (bflo(o.y) + bfhi(o.y))) + ((bflo(o.z) + bfhi(o.z)) + (bflo(o.w) + bfhi(o.w)));
        __builtin_nontemporal_store(o, (u32x4*)(WT + (size_t)(drow + c * dstep) * K + k0)); }
    if (FOLD) {
#pragma unroll
        for (int o = 1; o < 8; o <<= 1) {
#pragma unroll
            for (int c = 0; c < 4; ++c) { a1[c] += __shfl_xor(a1[c], o); a2[c] += __shfl_xor(a2[c], o); } }
        if (kg == 0) {
#pragma unroll
            for (int c = 0; c < 4; ++c) { fx_add(c1 + ns + c, a1[c]); fx_add(c2 + ns + c, a2[c]); } }
    }
}
__device__ __forceinline__ void p0_transpose_item_f8(const float* W, int K, int N, f8* WT, int kb, int nb, int mode, float scale, int lane) {
    const int kg = lane & 7, nq = lane >> 3, k0 = 128 * kb + 16 * kg, ns = 32 * nb + 4 * nq;
    const float* src = W + (size_t)k0 * N + ns;
    f32x4 v[16];
#pragma unroll
    for (int j = 0; j < 16; ++j) v[j] = __builtin_nontemporal_load((const f32x4*)(src + (size_t)j * N)) * scale;
    int drow = ns, dstep = 1;
    if (mode != 0) { const int HW = (mode == 1) ? 128 : 64, half = HW >> 1, hbase = ns & ~(HW - 1), d = ns & (HW - 1), t = d >= half ? 1 : 0, i = d - half * t; drow = hbase + 2 * i + t; dstep = 2; }
#pragma unroll
    for (int c = 0; c < 4; ++c) { u32x4 o; o.x = pk4f8(v[0][c], v[1][c], v[2][c], v[3][c]); o.y = pk4f8(v[4][c], v[5][c], v[6][c], v[7][c]); o.z = pk4f8(v[8][c], v[9][c], v[10][c], v[11][c]); o.w = pk4f8(v[12][c], v[13][c], v[14][c], v[15][c]);
        __builtin_nontemporal_store(o, (u32x4*)(WT + (size_t)(drow + c * dstep) * K + k0)); }
}
struct CvDesc { const float* W; unsigned char* WT; int K, N, kb, nb, kind  , mode; float scale; const float* gf; const float* bfv; long long* c1; long long* c2; };
__device__ __forceinline__ void cv_issue(const CvDesc& d, LAS unsigned char* slot, int lane) {
    const float* src = d.W + (size_t)(64 * d.kb + (lane >> 3)) * d.N + 32 * d.nb + 4 * (lane & 7);
#pragma unroll
    for (int j = 0; j < 8; ++j) __builtin_amdgcn_global_load_lds((const unsigned*)(src + (size_t)(8 * j) * d.N), (LAS unsigned*)(slot + j * CV_CH), 16, 0, 2);
}
__device__ __forceinline__ void cv_finish(const CvDesc& d, const LAS unsigned char* slot, int lane) {
    const int kg = lane & 7, nq = lane >> 3, k0 = 64 * d.kb + 8 * kg, ns = 32 * d.nb + 4 * nq;
    f32x4 v[8];
#pragma unroll
    for (int j = 0; j < 8; ++j) v[j] = *(const LAS f32x4*)(slot + kg * CV_CH + j * 128 + nq * 16);
    int drow = ns, dstep = 1;
    if (d.mode != 0) { const int HW = (d.mode == 1) ? 128 : 64, half = HW >> 1, hbase = ns & ~(HW - 1), dd = ns & (HW - 1), t = dd >= half ? 1 : 0, i = dd - half * t; drow = hbase + 2 * i + t; dstep = 2; }
    if (d.kind == 4) {
        const float sc = d.scale; unsigned char* wt = d.WT;
#pragma unroll
        for (int c = 0; c < 4; ++c) __builtin_nontemporal_store(pk8f4(v[0][c] * sc, v[1][c] * sc, v[2][c] * sc, v[3][c] * sc, v[4][c] * sc, v[5][c] * sc, v[6][c] * sc, v[7][c] * sc), (unsigned*)(wt + toff(drow + c * dstep, k0 >> 1, d.K >> 1)));
    } else if (d.kind == 3) {
        const float sc = d.scale, isc = 1.0f / d.scale; unsigned char* wt = d.WT; f32x4 a1 = {0.f, 0.f, 0.f, 0.f}, a2 = {0.f, 0.f, 0.f, 0.f};
#pragma unroll
        for (int j = 0; j < 8; ++j) { const float gk = d.gf[k0 + j], bk = d.bfv[k0 + j]; a2 += v[j] * bk; v[j] = v[j] * (gk * sc);
#pragma unroll
            for (int c = 0; c < 4; ++c) { v[j][c] = __builtin_rintf(__builtin_amdgcn_fmed3f(v[j][c], -127.f, 127.f)); a1[c] += v[j][c]; } }
#pragma unroll
        for (int c = 0; c < 4; ++c) { u32x2 o; o.x = pk4i8(v[0][c], v[1][c], v[2][c], v[3][c]); o.y = pk4i8(v[4][c], v[5][c], v[6][c], v[7][c]);
            __builtin_nontemporal_store(o, (u32x2*)(wt + toff(drow + c * dstep, k0, d.K))); }
#pragma unroll
        for (int o = 1; o < 8; o <<= 1) {
#pragma unroll
            for (int c = 0; c < 4; ++c) { a1[c] += __shfl_xor(a1[c], o); a2[c] += __shfl_xor(a2[c], o); } }
        if (kg == 0) {
#pragma unroll
            for (int c = 0; c < 4; ++c) { fx_add(d.c1 + ns + c, a1[c] * isc); fx_add(d.c2 + ns + c, a2[c]); } }
    } else if (d.kind == 2) {
        const float sc = d.scale; unsigned char* wt = d.WT;
#pragma unroll
        for (int c = 0; c < 4; ++c) { u32x2 o; o.x = pk4f8(v[0][c] * sc, v[1][c] * sc, v[2][c] * sc, v[3][c] * sc); o.y = pk4f8(v[4][c] * sc, v[5][c] * sc, v[6][c] * sc, v[7][c] * sc);
            __builtin_nontemporal_store(o, (u32x2*)(wt + toff(drow + c * dstep, k0, d.K))); }
    } else {
        unsigned char* wt = d.WT; f32x4 a1 = {0.f, 0.f, 0.f, 0.f}, a2 = {0.f, 0.f, 0.f, 0.f};
        if (d.kind == 1) {
#pragma unroll
            for (int j = 0; j < 8; ++j) { const float gk = d.gf[k0 + j], bk = d.bfv[k0 + j]; a2 += v[j] * bk; v[j] = v[j] * gk; } }
#pragma unroll
        for (int c = 0; c < 4; ++c) { u32x4 o; o.x = pk2(v[0][c], v[1][c]); o.y = pk2(v[2][c], v[3][c]); o.z = pk2(v[4][c], v[5][c]); o.w = pk2(v[6][c], v[7][c]);
            if (d.kind == 1) a1[c] = ((bflo(o.x) + bfhi(o.x)) + (bflo(o.y) + bfhi(o.y))) + ((bflo(o.z) + bfhi(o.z)) + (bflo(o.w) + bfhi(o.w)));
            __builtin_nontemporal_store(o, (u32x4*)(wt + toff(drow + c * dstep, 2 * k0, 2 * d.K))); }
        if (d.kind == 1) {
#pragma unroll
            for (int o = 1; o < 8; o <<= 1) {
#pragma unroll
                for (int c = 0; c < 4; ++c) { a1[c] += __shfl_xor(a1[c], o); a2[c] += __shfl_xor(a2[c], o); } }
            if (kg == 0) {
#pragma unroll
                for (int c = 0; c < 4; ++c) { fx_add(d.c1 + ns + c, a1[c]); fx_add(d.c2 + ns + c, a2[c]); } } }
    }
}
#define CV_RUN(lo_, hi_, cw_, ncw_, DECODE) do { LAS unsigned char* ring_ = L + RING_OFF + wave * CV_WAVE; int it_ = (lo_) + (cw_); \
    if (it_ < (hi_)) { CvDesc dc_ = DECODE(it_); cv_issue(dc_, ring_, lane); int sl_ = 0; \
        for (;;) { const int itn_ = it_ + (ncw_); const bool hn_ = itn_ < (hi_); CvDesc dn_ = dc_; \
            if (hn_) { dn_ = DECODE(itn_); cv_issue(dn_, ring_ + (sl_ ^ 1) * CV_SLOT, lane); asm volatile("s_waitcnt vmcnt(8)" ::: "memory"); } else asm volatile("s_waitcnt vmcnt(0)" ::: "memory"); \
            cv_finish(dc_, ring_ + sl_ * CV_SLOT, lane); asm volatile("s_waitcnt lgkmcnt(0)" ::: "memory"); \
            if (!hn_) break; dc_ = dn_; it_ = itn_; sl_ ^= 1; } } } while (0)
__device__ __forceinline__ void sincos_acc(float a, float& s, float& c) {
    const double x = (double)a, kd = rint(x * 0.63661977236758134308);
    double r = fma(-kd, 1.57079632679489655800e+00, x); r = fma(-kd, 6.12323399573676603587e-17, r);
    const double r2 = r * r;
    const double sp = r * (1.0 + r2 * (-1.0 / 6 + r2 * (1.0 / 120 + r2 * (-1.0 / 5040 + r2 * (1.0 / 362880 + r2 * (-1.0 / 39916800 + r2 * (1.0 / 6227020800.0)))))));
    const double cp = 1.0 + r2 * (-0.5 + r2 * (1.0 / 24 + r2 * (-1.0 / 720 + r2 * (1.0 / 40320 + r2 * (-1.0 / 3628800 + r2 * (1.0 / 479001600 + r2 * (-1.0 / 87178291200.0)))))));
    const int q = (int)kd & 3;
    const double sv = (q == 0) ? sp : (q == 1) ? cp : (q == 2) ? -sp : -cp, cv = (q == 0) ? cp : (q == 1) ? -sp : (q == 2) ? -cp : sp;
    s = (float)sv; c = (float)cv;
}

typedef short bf16x8 __attribute__((ext_vector_type(8)));
typedef short s16x4 __attribute__((ext_vector_type(4)));
typedef float f32x16 __attribute__((ext_vector_type(16)));
#define MFMA32(a, b, c) __builtin_amdgcn_mfma_f32_32x32x16_bf16((a), (b), (c), 0, 0, 0)
__device__ __forceinline__ bf16x8 pack8(const f32x16& p, int o) {
    u32x4 w; w.x = pk2(p[o], p[o + 1]); w.y = pk2(p[o + 2], p[o + 3]); w.z = pk2(p[o + 4], p[o + 5]); w.w = pk2(p[o + 6], p[o + 7]); return __builtin_bit_cast(bf16x8, w);
}
__device__ __forceinline__ bf16x8 cat44(s16x4 lo, s16x4 hi) { return (bf16x8){lo[0], lo[1], lo[2], lo[3], hi[0], hi[1], hi[2], hi[3]}; }
__device__ __forceinline__ float max16(const f32x16& p) {
    float a = fmaxf(fmaxf(p[0], p[1]), fmaxf(p[2], p[3])), b = fmaxf(fmaxf(p[4], p[5]), fmaxf(p[6], p[7])), c = fmaxf(fmaxf(p[8], p[9]), fmaxf(p[10], p[11])), d = fmaxf(fmaxf(p[12], p[13]), fmaxf(p[14], p[15]));
    return fmaxf(fmaxf(a, b), fmaxf(c, d));
}
constexpr int A_KP = 272, A_VP = 136;
constexpr int A_KT = 64 * A_KP, A_VT = 128 * A_VP;
constexpr int A_KM = 2 * (A_KT + A_VT);
__device__ __forceinline__ void moba_unit(int b, int h, int blk, const bf16* QA, const bf16* KA, const bf16* VA, const float* kmp, f8* YA, LAS unsigned char* lds, int tid) {
    const int lane = tid & 63, w = __builtin_amdgcn_readfirstlane(tid >> 6), r32 = lane & 31, hi = lane >> 5;
    const size_t rowb = (size_t)b * SEQ;
    const int qrel = 32 * w + r32;
    __syncthreads();
    LAS float* km = (LAS float*)(lds + A_KM);
    for (int i = tid; i < blk * AD; i += 512) { const int n = i >> 7, d = i & 127; const float* k0p = kmp + (size_t)((b * NBLK + n) * 2) * AW + h * AD + d; km[i] = (k0p[0] + k0p[AW]) * (1.0f / MBLK); }
    bf16x8 qf[8];
    { const bf16* qp = QA + (rowb + blk * MBLK + qrel) * AW + h * AD + 8 * hi;
#pragma unroll
      for (int st = 0; st < 8; ++st) qf[st] = *(const bf16x8*)(qp + 16 * st); }
    const int kkey = tid >> 4, kc = tid & 15;
    const bf16* kgp = KA + (rowb + kkey) * AW + h * AD + 8 * kc;
    const bf16* vgp = VA + (rowb + 2 * kkey) * AW + h * AD + 8 * kc;
    const int kls = kkey * A_KP + kc * 16, vls = (8 * kc) * A_VP + kkey * 4;
    u32x4 kr0, kr1, vr0, vr1;
#define A_LOAD(kbase) do { kr0 = *(const u32x4*)(kgp + (size_t)(kbase) * AW); kr1 = *(const u32x4*)(kgp + (size_t)((kbase) + 32) * AW); \
        vr0 = *(const u32x4*)(vgp + (size_t)(kbase) * AW); vr1 = *(const u32x4*)(vgp + (size_t)((kbase) + 1) * AW); } while (0)
#define A_STORE(buf) do { LAS unsigned char* kb_ = lds + (buf) * (A_KT + A_VT); LAS unsigned char* vb_ = kb_ + A_KT; \
        *(LAS u32x4*)(kb_ + kls) = kr0; *(LAS u32x4*)(kb_ + kls + 32 * A_KP) = kr1; \
        _Pragma("unroll") for (int e_ = 0; e_ < 4; ++e_) { const unsigned a_ = vr0[e_], b_ = vr1[e_]; \
            *(LAS unsigned*)(vb_ + vls + (2 * e_) * A_VP) = (a_ & 0xffffu) | (b_ << 16); *(LAS unsigned*)(vb_ + vls + (2 * e_ + 1) * A_VP) = (a_ >> 16) | (b_ & 0xffff0000u); } } while (0)
    A_LOAD(blk * MBLK); A_STORE(0);
    __syncthreads();
    unsigned sel = (blk <= TOPK) ? ((1u << blk) - 1u) : 0u;
    if (blk > TOPK) {
        float gt[NBLK];
#pragma unroll
        for (int n = 0; n < NBLK; ++n) { float part = 0.f;
            if (n < blk) {
#pragma unroll
                for (int st = 0; st < 8; ++st) { const f32x4 k0 = *(const LAS f32x4*)(km + n * AD + 16 * st + 8 * hi), k1 = *(const LAS f32x4*)(km + n * AD + 16 * st + 8 * hi + 4);
                    const u32x4 qw = __builtin_bit_cast(u32x4, qf[st]);
                    part += bflo(qw.x) * k0[0] + bfhi(qw.x) * k0[1] + bflo(qw.y) * k0[2] + bfhi(qw.y) * k0[3] + bflo(qw.z) * k1[0] + bfhi(qw.z) * k1[1] + bflo(qw.w) * k1[2] + bfhi(qw.w) * k1[3]; } }
            part += __shfl_xor(part, 32);
            gt[n] = (n < blk) ? part : -INFINITY; }
#pragma unroll
        for (int t = 0; t < TOPK; ++t) { float best = -INFINITY; int bi = -1;
#pragma unroll
            for (int n = 0; n < NBLK; ++n) if (gt[n] > best) { best = gt[n]; bi = n; }
            if (bi >= 0) sel |= 1u << bi;
#pragma unroll
            for (int n = 0; n < NBLK; ++n) if (n == bi) gt[n] = -INFINITY; }
    }
    f32x16 o[4];
#pragma unroll
    for (int db = 0; db < 4; ++db) o[db] = (f32x16){0.f, 0.f, 0.f, 0.f, 0.f, 0.f, 0.f, 0.f, 0.f, 0.f, 0.f, 0.f, 0.f, 0.f, 0.f, 0.f};
    float m = -INFINITY, l = 0.f;
    const int NT = 4 * (blk + 1);
    for (int ti = 0; ti < NT; ++ti) {
        const int n = (ti < 4) ? blk : ((ti - 4) >> 2), t = (ti < 4) ? ti : ((ti - 4) & 3);
        const bool more = ti + 1 < NT;
        if (more) { const int n1 = (ti + 1 < 4) ? blk : ((ti - 3) >> 2), t1 = (ti + 1 < 4) ? (ti + 1) : ((ti - 3) & 3); A_LOAD(n1 * MBLK + 64 * t1); }
        const bool own = (n == blk), mine = ((sel >> n) & 1u) != 0u;
        const bool active = own ? (t <= (w >> 1)) : (__any(mine) != 0);
        if (active) {
            const LAS unsigned char* kb = lds + (ti & 1) * (A_KT + A_VT); const LAS unsigned char* vb = kb + A_KT;
            f32x16 s0 = (f32x16){0.f, 0.f, 0.f, 0.f, 0.f, 0.f, 0.f, 0.f, 0.f, 0.f, 0.f, 0.f, 0.f, 0.f, 0.f, 0.f}, s1 = s0;
#pragma unroll
            for (int st = 0; st < 8; ++st) { const bf16x8 a0 = *(const LAS bf16x8*)(kb + r32 * A_KP + (16 * st + 8 * hi) * 2), a1 = *(const LAS bf16x8*)(kb + (32 + r32) * A_KP + (16 * st + 8 * hi) * 2);
                s0 = MFMA32(a0, qf[st], s0); s1 = MFMA32(a1, qf[st], s1); }
            if (own) { if (t == (w >> 1)) {
#pragma unroll
                    for (int r = 0; r < 16; ++r) { const int kr = 64 * t + (r & 3) + 8 * (r >> 2) + 4 * hi; if (kr > qrel) s0[r] = -INFINITY; if (kr + 32 > qrel) s1[r] = -INFINITY; } } }
            else if (!mine) {
#pragma unroll
                for (int r = 0; r < 16; ++r) { s0[r] = -INFINITY; s1[r] = -INFINITY; } }
            float tm = fmaxf(max16(s0), max16(s1)); tm = fmaxf(tm, __shfl_xor(tm, 32));
            const float mn = fmaxf(m, tm), al = __builtin_amdgcn_exp2f(m - mn); m = mn;
            float ls = 0.f;
#pragma unroll
            for (int r = 0; r < 16; ++r) { s0[r] = __builtin_amdgcn_exp2f(s0[r] - mn); s1[r] = __builtin_amdgcn_exp2f(s1[r] - mn); ls += s0[r] + s1[r]; }
            l = l * al + ls;
#pragma unroll
            for (int db = 0; db < 4; ++db) o[db] = o[db] * al;
#pragma unroll
            for (int u = 0; u < 2; ++u)
#pragma unroll
                for (int ks = 0; ks < 2; ++ks) { const bf16x8 pf = pack8(u ? s1 : s0, 8 * ks);
#pragma unroll
                    for (int db = 0; db < 4; ++db) { const LAS unsigned char* vp = vb + (32 * db + r32) * A_VP + (32 * u + 16 * ks + 4 * hi) * 2;
                        o[db] = MFMA32(cat44(*(const LAS s16x4*)vp, *(const LAS s16x4*)(vp + 16)), pf, o[db]); } }
        }
        if (more) A_STORE((ti + 1) & 1);
        __syncthreads();
    }
    l += __shfl_xor(l, 32);
    const float inv = F8S_Y / l;
    f8* yp = YA + toff(rowb + blk * MBLK + qrel, h * AD + 4 * hi, AW);
#pragma unroll
    for (int db = 0; db < 4; ++db)
#pragma unroll
        for (int g = 0; g < 4; ++g) *(unsigned*)(yp + 32 * db + 8 * g) = pk4f8(o[db][4 * g] * inv, o[db][4 * g + 1] * inv, o[db][4 * g + 2] * inv, o[db][4 * g + 3] * inv);
#undef A_LOAD
#undef A_STORE
}
constexpr int B_KP = 144, B_VP = 520;
constexpr int B_KT = 256 * B_KP, B_VT = 64 * B_VP;
__device__ __forceinline__ void swa_unit(int b, int kvh, int qb, const bf16* QB, const bf16* KB, const bf16* VB, const float* sinks, f8* YB, LAS unsigned char* lds, int tid) {
    const int lane = tid & 63, w = __builtin_amdgcn_readfirstlane(tid >> 6), r32 = lane & 31, hi = lane >> 5;
    const size_t rowb = (size_t)b * SEQ; const int band0 = qb * WIN - WIN, hq = kvh * 8 + w;
    __syncthreads();
    LAS unsigned char* ks_ = lds; LAS unsigned char* vs_ = lds + B_KT;
#pragma unroll
    for (int i = 0; i < 4; ++i) { const int p = tid + 512 * i, key = p >> 3, c = p & 7, pos = band0 + key;
        if (pos >= 0) *(LAS u32x4*)(ks_ + key * B_KP + c * 16) = *(const u32x4*)(KB + (rowb + pos) * BKVW + kvh * BD + 8 * c); }
#pragma unroll
    for (int i = 0; i < 2; ++i) { const int p = tid + 512 * i, kp = p >> 3, c = p & 7, pos = band0 + 2 * kp;
        if (pos >= 0) { const u32x4 v0 = *(const u32x4*)(VB + (rowb + pos) * BKVW + kvh * BD + 8 * c), v1 = *(const u32x4*)(VB + (rowb + pos + 1) * BKVW + kvh * BD + 8 * c);
#pragma unroll
            for (int e = 0; e < 4; ++e) { const unsigned a_ = v0[e], b_ = v1[e];
                *(LAS unsigned*)(vs_ + (8 * c + 2 * e) * B_VP + kp * 4) = (a_ & 0xffffu) | (b_ << 16); *(LAS unsigned*)(vs_ + (8 * c + 2 * e + 1) * B_VP + kp * 4) = (a_ >> 16) | (b_ & 0xffff0000u); } } }
    __syncthreads();
    const float sk = sinks[hq] * LOG2E;
    for (int sub = 0; sub < 4; ++sub) {
        const int qrow = qb * WIN + 32 * sub + r32;
        bf16x8 qf[4];
        { const bf16* qp = QB + (rowb + qrow) * 2048 + hq * BD + 8 * hi;
#pragma unroll
          for (int st = 0; st < 4; ++st) qf[st] = *(const bf16x8*)(qp + 16 * st); }
        f32x16 o[2];
        o[0] = (f32x16){0.f, 0.f, 0.f, 0.f, 0.f, 0.f, 0.f, 0.f, 0.f, 0.f, 0.f, 0.f, 0.f, 0.f, 0.f, 0.f}; o[1] = o[0];
        float m = sk, l = (hi == 0) ? 1.0f : 0.0f;
        const int qi = WIN + 32 * sub + r32;
        for (int tt = 0; tt < 5; ++tt) { const int tile = sub + tt;
            if (band0 + 32 * tile < 0) continue;
            f32x16 s = (f32x16){0.f, 0.f, 0.f, 0.f, 0.f, 0.f, 0.f, 0.f, 0.f, 0.f, 0.f, 0.f, 0.f, 0.f, 0.f, 0.f};
#pragma unroll
            for (int st = 0; st < 4; ++st) s = MFMA32(*(const LAS bf16x8*)(ks_ + (32 * tile + r32) * B_KP + (16 * st + 8 * hi) * 2), qf[st], s);
            if (tt == 0 || tt == 4) {
#pragma unroll
                for (int r = 0; r < 16; ++r) { const int ki = 32 * tile + (r & 3) + 8 * (r >> 2) + 4 * hi; if (!(ki <= qi && qi - ki < WIN)) s[r] = -INFINITY; } }
            float tm = max16(s); tm = fmaxf(tm, __shfl_xor(tm, 32));
            const float mn = fmaxf(m, tm), al = __builtin_amdgcn_exp2f(m - mn); m = mn;
            float ls = 0.f;
#pragma unroll
            for (int r = 0; r < 16; ++r) { s[r] = __builtin_amdgcn_exp2f(s[r] - mn); ls += s[r]; }
            l = l * al + ls; o[0] = o[0] * al; o[1] = o[1] * al;
#pragma unroll
            for (int ks = 0; ks < 2; ++ks) { const bf16x8 pf = pack8(s, 8 * ks);
#pragma unroll
                for (int db = 0; db < 2; ++db) { const LAS unsigned char* vp = vs_ + (32 * db + r32) * B_VP + (32 * tile + 16 * ks + 4 * hi) * 2;
                    o[db] = MFMA32(cat44(*(const LAS s16x4*)vp, *(const LAS s16x4*)(vp + 16)), pf, o[db]); } }
        }
        l += __shfl_xor(l, 32);
        const float inv = F8S_Y / l;
        f8* yp = YB + toff(rowb + qrow, hq * BD + 4 * hi, 2048);
#pragma unroll
        for (int db = 0; db < 2; ++db)
#pragma unroll
            for (int g = 0; g < 4; ++g) *(unsigned*)(yp + 32 * db + 8 * g) = pk4f8(o[db][4 * g] * inv, o[db][4 * g + 1] * inv, o[db][4 * g + 2] * inv, o[db][4 * g + 3] * inv);
    }
}

struct Args { const float* in[16]; float* out; unsigned char* ws; float invf[64]; int ph_lo, ph_hi; };
__global__ void __launch_bounds__(NWAVES * 64, 2) mk_fwd(Args args) {
    extern __shared__ __attribute__((aligned(16))) unsigned char lds[];
    LAS unsigned char* L = (LAS unsigned char*)lds;
    volatile LAS unsigned* MISC = (volatile LAS unsigned*)(L + MISC_OFF);
    const int tid = threadIdx.x, lane = tid & 63, wave = __builtin_amdgcn_readfirstlane(tid >> 6);
    const int G = gridDim.x, bx = blockIdx.x;
    const int gw = bx * NWAVES + wave, NGW = G * NWAVES;
    unsigned char* ws = args.ws;
    const int lo = args.ph_lo, hi = args.ph_hi;
    for (int u = tid; u < (LDS_BYTES - LDSCTL_OFF) / 4; u += NWAVES * 64) ((LAS unsigned*)(L + LDSCTL_OFF))[u] = 0u;
    __syncthreads();
    XcdBarrier bar; bar.bar = (unsigned*)(ws + WS_CTL) + CW_BAR; bar.x = 0; bar.st = nullptr;
    if (hi - lo > 1) bar = xcd_barrier_post((unsigned*)(ws + WS_CTL) + CW_BAR, MISC + 8);
#ifndef MK_PHASE_MASK
#define MK_PHASE_MASK 0x3ff
#endif
#define IN(k) (((MK_PHASE_MASK >> (k)) & 1) && lo <= (k) && (k) < hi)
#define SEAM(k) do { if (IN(k) && IN((k) + 1)) xcd_barrier(bar); } while (0)
    const float* x = args.in[0];
    bf16* XB = (bf16*)(ws + WS_XB); bf16* PB = (bf16*)(ws + WS_PB);

    if (IN(0)) {
        for (int t = bx * (NWAVES * 64) + tid; t < SEQ * 64; t += G * NWAVES * 64) { const int pos = t >> 6, i = t & 63;
            const float ang = (float)pos * args.invf[i]; float s, c; sincos_acc(ang, s, c);
            ((f32x2*)(ws + WS_TABA))[t] = (f32x2){c, s};
            if ((i & 1) == 0) ((f32x2*)(ws + WS_TABB))[pos * 32 + (i >> 1)] = (f32x2){c, s}; }
        constexpr int I_IN = (DM / 64) * (NIN / 32), I_PL0 = (PLE / 64) * (DM / 32);
        auto dec0 = [&](int it) { CvDesc d{}; d.scale = 1.f;
            if (it < I_IN) { const int nblk = NIN / 32, n0 = 32 * (it % nblk); d.W = args.in[2]; d.WT = ws + WS_WIN; d.K = DM; d.N = NIN; d.kb = it / nblk; d.nb = it % nblk; d.kind = 2; d.scale = F8S_WIN;
                if (n0 < 2 * AW || (n0 >= 3 * AW && n0 < 3 * AW + 2048) || n0 >= 8704) { d.kind = 4; d.scale = F4S_WG; d.WT = ws + WS_WG4; }
                d.mode = (n0 < 2 * AW) ? 1 : (n0 < 3 * AW) ? 0 : (n0 < 3 * AW + 2048 + BKVW) ? 2 : 0; }
            else { const int r = it - I_IN; d.W = args.in[14]; d.WT = ws + WS_WPLE; d.K = PLE; d.N = DM; d.kb = r / (DM / 32); d.nb = r % (DM / 32); d.kind = 0; d.mode = 0; }
            return d; };
        CV_RUN(0, I_IN + I_PL0, gw, NGW, dec0);
        { const size_t nthr = (size_t)G * NWAVES * 64, t0 = (size_t)bx * (NWAVES * 64) + tid;
#define CVT_ROWS(SRC, DST, NCH) for (size_t c = t0; c < (size_t)(NCH); c += 4 * nthr) { f32x4 a_[4], b_[4]; \
              _Pragma("unroll") for (int q = 0; q < 4; ++q) { const size_t cc = c + q * nthr; if (cc < (size_t)(NCH)) { a_[q] = __builtin_nontemporal_load((const f32x4*)(SRC) + 2 * cc); b_[q] = __builtin_nontemporal_load((const f32x4*)(SRC) + 2 * cc + 1); } } \
              _Pragma("unroll") for (int q = 0; q < 4; ++q) { const size_t cc = c + q * nthr; if (cc < (size_t)(NCH)) { u32x4 w; w.x = pk2(a_[q][0], a_[q][1]); w.y = pk2(a_[q][2], a_[q][3]); w.z = pk2(b_[q][0], b_[q][1]); w.w = pk2(b_[q][2], b_[q][3]); ((u32x4*)(DST))[cc] = w; } } }
          for (size_t c = t0; c < (size_t)M * DM / 16; c += nthr) { const f32x4* xp = (const f32x4*)x + 4 * c; f32x4 a_[4];
#pragma unroll
              for (int q = 0; q < 4; ++q) a_[q] = __builtin_nontemporal_load(xp + q) * F8S_X;
              u32x4 w; w.x = pk4f8(a_[0][0], a_[0][1], a_[0][2], a_[0][3]); w.y = pk4f8(a_[1][0], a_[1][1], a_[1][2], a_[1][3]); w.z = pk4f8(a_[2][0], a_[2][1], a_[2][2], a_[2][3]); w.w = pk4f8(a_[3][0], a_[3][1], a_[3][2], a_[3][3]);
              ((u32x4*)XB)[c] = w;
              const float r4 = F4S_X / F8S_X; u32x2 w4;
              w4.x = pk8f4(a_[0][0] * r4, a_[0][1] * r4, a_[0][2] * r4, a_[0][3] * r4, a_[1][0] * r4, a_[1][1] * r4, a_[1][2] * r4, a_[1][3] * r4);
              w4.y = pk8f4(a_[2][0] * r4, a_[2][1] * r4, a_[2][2] * r4, a_[2][3] * r4, a_[3][0] * r4, a_[3][1] * r4, a_[3][2] * r4, a_[3][3] * r4);
              ((u32x2*)(ws + WS_XB4))[c] = w4; }
          CVT_ROWS(args.in[1], PB, (size_t)M * PLE / 8);
#undef CVT_ROWS
        }
        VM_WAIT(); __syncthreads();
    }
    SEAM(0);
    if (IN(1)) {
        const bf16* WIN = (const bf16*)(ws + WS_WIN); const float* tabA = (const float*)(ws + WS_TABA); const float* tabB = (const float*)(ws + WS_TABB);
#define P1_CALL(MODE, nrow0, ncols, ...) do { pg8::Gemm g{XB, WIN + (size_t)(nrow0) * (DM / 2), M, (ncols), DM / 2, 1.0f / (F8S_X * F8S_WIN)}; pg8::StaticOrder S; S.init(M, (ncols), G, bx); \
            EpiZ<MODE> E{__VA_ARGS__}; pg8::gemm_phase<EpiZ<MODE>, pg8::StaticOrder, true, true, 1, NST_ALL>(L + RING_OFF, g, S, E); } while (0)
#define P1_CALL4(MODE, CH, nrow0, ncols, nx_nrow0, nx_ncols, ...) do { const char* chA_ = nullptr; const char* chB_ = nullptr; \
            if ((CH) & 2) { pg8::StaticOrder S2; S2.init(M, (nx_ncols), G, bx); pg8::Unit u2{0, 0}; S2.next(0, u2); const size_t ts_ = (size_t)256 * (DM / 4) * 2;        \
                chA_ = (const char*)(ws + WS_XB4) + (size_t)u2.pm * ts_; chB_ = (const char*)(ws + WS_WG4) + (size_t)(nx_nrow0) * (DM / 2) + (size_t)u2.pn * ts_; } \
            pg8::Gemm g{(const bf16*)(ws + WS_XB4), (const bf16*)(ws + WS_WG4) + (size_t)(nrow0) * (DM / 4), M, (ncols), DM / 4, 1.0f / (F4S_X * F4S_WG)}; pg8::StaticOrder S; S.init(M, (ncols), G, bx); \
            EpiZ<MODE> E{__VA_ARGS__}; pg8::gemm_phase<EpiZ<MODE>, pg8::StaticOrder, true, true, 3, NST_ALL, false, false, CH>(L + RING_OFF, g, S, E, chA_, chB_); } while (0)
        P1_CALL(0, 4096, 2048, (bf16*)(ws + WS_VA), nullptr, AW, 1.0f, nullptr, nullptr, nullptr);
#define P1_FP4(C1, C2, C3, C4) do { \
        P1_CALL4(1, C1, 0,    2048, 2048, 2048, (bf16*)(ws + WS_QA), nullptr, AW, QSCALE_A, tabA, nullptr, nullptr);                          \
        P1_CALL4(2, C2, 2048, 2048, 6144, 2048, (bf16*)(ws + WS_KA), nullptr, AW, 1.0f, tabA, nullptr, (float*)(ws + WS_KMP));                \
        P1_CALL4(3, C3, 6144, 2048, 8704, 8192, (bf16*)(ws + WS_QB), nullptr, 2048, QSCALE_B, tabB, nullptr, nullptr);                        \
        P1_CALL4(4, C4, 8704, 8192, 0, 2048, (bf16*)(ws + WS_GA), (bf16*)(ws + WS_GB), DM, 1.0f, nullptr, args.in[3], nullptr); } while (0)
        if (G <= 256) P1_FP4(2, 3, 3, 1); else P1_FP4(0, 0, 0, 0);
#undef P1_FP4
#undef P1_CALL4
        constexpr int TAILW = (M / 256) * (512 / 256);
        if (bx < TAILW || G <= TAILW) { P1_CALL(5, 8192, 512, (bf16*)(ws + WS_KB), (bf16*)(ws + WS_VB), BKVW, 1.0f, tabB, nullptr, nullptr);
            pg8::Gemm g{PB, (const bf16*)(ws + WS_WPLE), M, DM, PLE}; pg8::StaticOrder S; S.init(M, DM, (G <= TAILW) ? G : TAILW, bx);
            EpiPle E{(bf16*)(ws + WS_PLE)};
            pg8::gemm_phase<EpiPle, pg8::StaticOrder, true, true, 0, NST_ALL>(L + RING_OFF, g, S, E); }
#undef P1_CALL
        if (bx >= TAILW || G <= TAILW) {
            constexpr int I_UP = (AW / 64) * (DM / 32), I_O = (DM / 64) * (DM / 32), I_FU = (DM / 64) * (DFF / 32), I_FD = (DFF / 64) * (DM / 32);
            constexpr int NREST = 2 * I_UP + I_O + I_FU + I_FD + I_O;
            const int gw2 = (G <= TAILW) ? gw : (bx - TAILW) * NWAVES + wave, NGW2 = (G <= TAILW) ? NGW : (G - TAILW) * NWAVES;
            auto decr = [&](int it) { CvDesc d{}; d.scale = 1.f; d.mode = 0; int r = it;
                if (r < I_UP) { d.W = args.in[5]; d.WT = ws + WS_WUPA; d.K = AW; d.N = DM; d.kb = r / (DM / 32); d.nb = r % (DM / 32); d.kind = 2; d.scale = F8S_WUP; return d; } r -= I_UP;
                if (r < I_UP) { d.W = args.in[6]; d.WT = ws + WS_WUPB; d.K = AW; d.N = DM; d.kb = r / (DM / 32); d.nb = r % (DM / 32); d.kind = 2; d.scale = F8S_WUP; return d; } r -= I_UP;
                if (r < I_O)  { d.W = args.in[7]; d.WT = ws + WS_WO; d.K = DM; d.N = DM; d.kb = r / (DM / 32); d.nb = r % (DM / 32); d.kind = 2; d.scale = F8S_WO; return d; } r -= I_O;
                if (r < I_FU) { d.W = args.in[10]; d.WT = ws + WS_WFFUP; d.K = DM; d.N = DFF; d.kb = r / (DFF / 32); d.nb = r % (DFF / 32); d.kind = 1; d.gf = args.in[8]; d.bfv = args.in[9]; d.c1 = (long long*)(ws + CB_C1F); d.c2 = (long long*)(ws + CB_C2F); return d; } r -= I_FU;
                if (r < I_FD) { d.W = args.in[11]; d.WT = ws + WS_WFFDN; d.K = DFF; d.N = DM; d.kb = r / (DM / 32); d.nb = r % (DM / 32); d.kind = 0; return d; } r -= I_FD;
                d.W = args.in[15]; d.WT = ws + WS_WPLEG; d.K = DM; d.N = DM; d.kb = r / (DM / 32); d.nb = r % (DM / 32); d.kind = 3; d.scale = I8S_WG; d.gf = args.in[12]; d.bfv = args.in[13]; d.c1 = (long long*)(ws + CB_C1G); d.c2 = (long long*)(ws + CB_C2G); return d; };
            CV_RUN(0, NREST, gw2, NGW2, decr);
            VM_WAIT(); __syncthreads();
        }
    }
    SEAM(1);
    if (IN(2)) {
        { float* cf = (float*)(ws + WS_CF32); const int t = bx * (NWAVES * 64) + tid, T = G * NWAVES * 64;
          for (int i = t; i < 2 * DFF + 2 * DM; i += T) { const long long* srcp = (i < DFF) ? (const long long*)(ws + CB_C1F) + i : (i < 2 * DFF) ? (const long long*)(ws + CB_C2F) + (i - DFF)
                  : (i < 2 * DFF + DM) ? (const long long*)(ws + CB_C1G) + (i - 2 * DFF) : (const long long*)(ws + CB_C2G) + (i - 2 * DFF - DM);
              cf[i] = (float)((double)*srcp * (1.0 / 4294967296.0)); } }
        const int vcu = (G % 8 == 0) ? (bx % 8) * (G / 8) + bx / 8 : bx;
        for (int it = vcu; it < BATCH * AHEADS * 4; it += G) { const int bh = it >> 2, sidx = it & 3;
#pragma unroll 1
            for (int k = 0; k < 2; ++k) moba_unit(bh >> 4, bh & 15, k ? sidx : 7 - sidx, (const bf16*)(ws + WS_QA), (const bf16*)(ws + WS_KA), (const bf16*)(ws + WS_VA), (const float*)(ws + WS_KMP), (f8*)(ws + WS_YA), L + RING_OFF, tid); }
#pragma unroll 1
        for (int it = vcu; it < BATCH * BKVH * (SEQ / WIN); it += G) swa_unit(it >> 6, (it >> 4) & 3, it & 15, (const bf16*)(ws + WS_QB), (const bf16*)(ws + WS_KB), (const bf16*)(ws + WS_VB), args.in[4], (f8*)(ws + WS_YB), L + RING_OFF, tid);
        VM_WAIT(); __syncthreads();
    }
    SEAM(2);
    if (IN(3)) {
        pg8::Gemm g{(const bf16*)(ws + WS_YA), (const bf16*)(ws + WS_WUPA), M, DM, AW / 2, 1.0f / (F8S_Y * F8S_WUP), (const bf16*)(ws + WS_YB), (const bf16*)(ws + WS_WUPB)}; pg8::StaticOrder S; S.init(M, DM, G, bx);
        EpiMG E{(const bf16*)(ws + WS_GA), (const bf16*)(ws + WS_GB), (f8*)(ws + WS_MG)};
        pg8::gemm_phase<EpiMG, pg8::StaticOrder, true, true, 1, NST_ALL, true, true>(L + RING_OFF, g, S, E);
    }
    SEAM(3);
    if (IN(4)) {
        pg8::Gemm g{(const bf16*)(ws + WS_MG), (const bf16*)(ws + WS_WO), M, DM, DM / 2, 1.0f / (F8S_MG * F8S_WO)}; pg8::StaticOrder S; S.init(M, DM, G, bx);
        EpiRes<false> E{x, nullptr, (bf16*)(ws + WS_H1B), nullptr, nullptr, nullptr, (long long*)(ws + CB_ST1)};
        pg8::gemm_phase<EpiRes<false>, pg8::StaticOrder, true, true, 1, NST_ALL, true>(L + RING_OFF, g, S, E);
    }
    do { if (IN(4) && IN(6)) xcd_barrier(bar); } while (0);
    if (IN(6)) {
        pg8::Gemm g{(const bf16*)(ws + WS_H1B), (const bf16*)(ws + WS_WFFUP), M, DFF, DM}; pg8::StaticOrder S; S.init(M, DFF, G, bx);
        EpiU E{(bf16*)(ws + WS_U), (const long long*)(ws + CB_ST1), (const float*)(ws + WS_CF32), (const float*)(ws + WS_CF32) + DFF};
        pg8::gemm_phase<EpiU, pg8::StaticOrder, true, true, 0, NST_ALL, true>(L + RING_OFF, g, S, E);
    }
    SEAM(6);
    if (IN(7)) {
        pg8::Gemm g{(const bf16*)(ws + WS_U), (const bf16*)(ws + WS_WFFDN), M, DM, DFF}; pg8::StaticOrder S; S.init(M, DM, G, bx);
        EpiRes<true> E{(const void*)(ws + WS_H1B), (bf16*)(ws + WS_T12), (bf16*)(ws + WS_H2B), (const long long*)(ws + CB_ST1), args.in[8], args.in[9], (long long*)(ws + CB_ST2)};
        pg8::gemm_phase<EpiRes<true>, pg8::StaticOrder, true, true, 0, NST_ALL, true>(L + RING_OFF, g, S, E);
    }
    do { if (IN(7) && IN(9)) xcd_barrier(bar); } while (0);
    if (IN(9)) {
        { pg8::Gemm g{(const bf16*)(ws + WS_H2B), (const bf16*)(ws + WS_WPLEG), M, DM, DM / 2, 1.0f / (I8S_T2 * I8S_WG)}; pg8::StaticOrder S; S.init(M, DM, G, bx);
          EpiFinal E{(const bf16*)(ws + WS_PLE), (const bf16*)(ws + WS_T12), args.out, (const long long*)(ws + CB_ST2), args.in[12], args.in[13], (const float*)(ws + WS_CF32) + 2 * DFF, (const float*)(ws + WS_CF32) + 2 * DFF + DM};
          pg8::gemm_phase<EpiFinal, pg8::StaticOrder, true, true, 2, NST_ALL, true>(L + RING_OFF, g, S, E); }
    }
#undef IN
#undef SEAM
}

#ifndef MK_PER_PHASE
#define MK_PER_PHASE 0
#endif
extern "C" void kernel_launch(void* const* d_in, const int* in_sizes, int n_in, void* d_out, int out_size, void* d_ws, size_t ws_size, hipStream_t stream) {
    static int grid = 0;
    if (grid == 0) {
        if (n_in != 16 || in_sizes[0] != M * DM || out_size != M * DM || ws_size < WS_END) { fprintf(stderr, "kernel_launch: unexpected shapes (n_in %d, in0 %d, out %d, ws %zu < %zu); nothing launched\n", n_in, n_in > 0 ? in_sizes[0] : -1, out_size, ws_size, (size_t)WS_END); grid = -1; return; }
        int dev = 0, cus = 0, per_cu = 0;
        if (hipGetDevice(&dev) != hipSuccess || hipDeviceGetAttribute(&cus, hipDeviceAttributeMultiprocessorCount, dev) != hipSuccess) { grid = -1; return; }
        if (hipFuncSetAttribute((const void*)mk_fwd, hipFuncAttributeMaxDynamicSharedMemorySize, LDS_BYTES) != hipSuccess) { fprintf(stderr, "kernel_launch: hipFuncSetAttribute failed\n"); grid = -1; return; }
        if (hipOccupancyMaxActiveBlocksPerMultiprocessor(&per_cu, (const void*)mk_fwd, NWAVES * 64, LDS_BYTES) != hipSuccess || per_cu < 1) fprintf(stderr, "kernel_launch: occupancy query reports %d workgroups per CU\n", per_cu);
        (void)hipGetLastError();
        grid = cus;
    }
    if (grid < 0) return;
    if (hipMemsetAsync((char*)d_ws + WS_CTL, 0, CTL_ZERO_BYTES, stream) != hipSuccess) return;
    Args a{};
    for (int i = 0; i < 16; ++i) a.in[i] = (const float*)d_in[i];
    a.out = (float*)d_out; a.ws = (unsigned char*)d_ws;
    for (int i = 0; i < 64; ++i) a.invf[i] = (float)pow(10000.0, -(double)i / 64.0);
#if MK_PER_PHASE
#ifndef MK_DUP_MASK
#define MK_DUP_MASK 0
#endif
#ifndef MK_DUP_REPS
#define MK_DUP_REPS 2
#endif
    for (int ph = 0; ph < NPH; ++ph) { a.ph_lo = ph; a.ph_hi = ph + 1; const int reps = ((MK_DUP_MASK >> ph) & 1) ? MK_DUP_REPS : 1;
        for (int r = 0; r < reps; ++r) hipLaunchKernelGGL(mk_fwd, dim3(grid), dim3(NWAVES * 64), LDS_BYTES, stream, a); }
#else
    a.ph_lo = 0; a.ph_hi = NPH; hipLaunchKernelGGL(mk_fwd, dim3(grid), dim3(NWAVES * 64), LDS_BYTES, stream, a);
#endif
    const hipError_t le = hipPeekAtLastError();
    if (le != hipSuccess) fprintf(stderr, "kernel_launch: launch failed: %s\n", hipGetErrorName(le));
}
```

```cpp
#include <hip/hip_runtime.h>
#ifndef NST_ALL
#define NST_ALL 16
#endif
#include <cstdio>
#include <cstdint>
#include <cmath>
namespace pg8 {
#define PG8_LAS __attribute__((address_space(3)))
typedef unsigned short bf16_t;
typedef short bf16x8 __attribute__((ext_vector_type(8)));
typedef float f32x4 __attribute__((ext_vector_type(4)));
typedef unsigned u32x4 __attribute__((ext_vector_type(4)));
constexpr int BM = 256, BK = 64, HALF = 128, HTB = HALF * BK * 2  , STAGE_BYTES = 8 * HTB, NXCD = 8, WGM = 8;

__host__ __device__ __forceinline__ int lds_byte(int r, int c) { const int st = (r >> 4) * 2 + (c >> 5), rr = r & 15, cc = c & 31, ob = rr * 64 + cc * 2; return st * 1024 + (ob ^ (((ob >> 9) & 1) << 5)); }
__host__ __device__ __forceinline__ void stage_rc(int b, int& R, int& C) { const int st = b / 1024, sb = b % 1024, swz = sb ^ (((sb >> 9) & 1) << 5); R = (st >> 1) * 16 + swz / 64; C = (st & 1) * 32 + (swz % 64) / 2; }
__host__ __device__ __forceinline__ int perm32(int rho) { const int n = rho >> 4, i = rho & 15; return 8 * (i >> 2) + 4 * n + (i & 3); }

struct Unit { int pm, pn; };
struct Gemm { const bf16_t* A; const bf16_t* Bt; int M, N, K; float oscale; const bf16_t* A2; const bf16_t* Bt2; };
typedef int i32x8 __attribute__((ext_vector_type(8)));
typedef int i32x4v __attribute__((ext_vector_type(4)));
__device__ __forceinline__ i32x8 cat16(bf16x8 lo, bf16x8 hi) { const i32x4v a = __builtin_bit_cast(i32x4v, lo), b = __builtin_bit_cast(i32x4v, hi); return __builtin_shufflevector(a, b, 0, 1, 2, 3, 4, 5, 6, 7); }

struct StaticOrder {
    int nM, nN, nwg, G, c;
    __host__ __device__ void init(int M, int N, int G_, int c_) { nM = M / BM; nN = N / BM; nwg = nM * nN; G = G_; c = c_; }
    __host__ __device__ bool next(int i, Unit& u) const {
        const long L = (long)i * G + c; if (L >= nwg) return false;
        int wgid = (int)L; { const int q = nwg / NXCD, r = nwg % NXCD, xcd = wgid % NXCD, off = wgid / NXCD; wgid = (xcd < r ? xcd * (q + 1) : r * (q + 1) + (xcd - r) * q) + off; }
        const int nig = WGM * nN, gid = wgid / nig, fm = gid * WGM, gsz = (nM - fm) < WGM ? (nM - fm) : WGM;
        u.pm = fm + ((wgid % nig) % gsz); u.pn = (wgid % nig) / gsz; return true;
    }
    __device__ __forceinline__ void a_ready(const Unit&) const {}
    __device__ __forceinline__ void done(const Unit&) const {}
};

__device__ __forceinline__ unsigned cvt_pk_bf16(float lo, float hi) { unsigned r; asm volatile("v_cvt_pk_bf16_f32 %0, %1, %2" : "=v"(r) : "v"(lo), "v"(hi)); return r; }
typedef float f32x2 __attribute__((ext_vector_type(2)));
__device__ __forceinline__ f32x2 gelu_pk(f32x2 v) {
    const f32x2 av = __builtin_elementwise_abs(v), d = av * 0.2316418882f + 1.0f;
    f32x2 t; t.x = __builtin_amdgcn_rcpf(d.x); t.y = __builtin_amdgcn_rcpf(d.y);
    f32x2 q = t * 0.5307027145f + (-0.7265760135f); q = q * t + 0.7107068705f; q = q * t + (-0.142248368f); q = q * t + 0.127414796f; q = q * t;
    const f32x2 s = (v * v) * (-0.72134752044f);
    f32x2 e; e.x = __builtin_amdgcn_exp2f(s.x); e.y = __builtin_amdgcn_exp2f(s.y);
    const f32x2 m = v * (q * e), r = v - m;
    f32x2 o; o.x = v.x < 0.f ? m.x : r.x; o.y = v.y < 0.f ? m.y : r.y; return o;
}

template <int ACT  > struct EpiBf16 {
    static constexpr bool PERM = true, AFTER_DRAIN = false, BMAP64 = false; static_assert(ACT == 0 || ACT == 1, "EpiBf16: ACT is 0 (none) or 1 (gelu_pk)");
    bf16_t* O; int ldc; const float* bias; int split_cols; size_t split_stride; float scale0;
    __device__ __forceinline__ void operator()(const f32x4 (&acc)[2][2][4][2], const Unit& u, int wr, int wc, int fr, int fq) const {
        const int row0 = u.pm * BM + wr * 64 + fr; int colt = u.pn * BM; bf16_t* base = O;
        float sc = 1.f; if (split_cols) { const int t = colt / split_cols; base += (size_t)t * split_stride; colt -= t * split_cols; if (t == 0) sc = scale0; }
        const int col0 = colt + wc * 32 + 8 * fq, bcol0 = u.pn * BM + wc * 32 + 8 * fq;
        f32x4 bv[2][2];
#pragma unroll
        for (int bj = 0; bj < 2; ++bj)
#pragma unroll
            for (int n = 0; n < 2; ++n) bv[bj][n] = bias ? *(const f32x4*)(bias + bcol0 + bj * HALF + 4 * n) : (f32x4){0.f, 0.f, 0.f, 0.f};
#pragma unroll
        for (int ai = 0; ai < 2; ++ai)
#pragma unroll
            for (int m = 0; m < 4; ++m) { bf16_t* rowp = base + (size_t)(row0 + ai * HALF + m * 16) * ldc + col0;
#pragma unroll
                for (int bj = 0; bj < 2; ++bj) { f32x4 v0 = acc[ai][bj][m][0] + bv[bj][0], v1 = acc[ai][bj][m][1] + bv[bj][1];
                    if (ACT == 1) { f32x2 a = gelu_pk((f32x2){v0[0], v0[1]}), b = gelu_pk((f32x2){v0[2], v0[3]}), c = gelu_pk((f32x2){v1[0], v1[1]}), d = gelu_pk((f32x2){v1[2], v1[3]});
                        v0 = (f32x4){a.x, a.y, b.x, b.y}; v1 = (f32x4){c.x, c.y, d.x, d.y}; }
                    v0 = v0 * sc; v1 = v1 * sc; u32x4 w; w.x = cvt_pk_bf16(v0[0], v0[1]); w.y = cvt_pk_bf16(v0[2], v0[3]); w.z = cvt_pk_bf16(v1[0], v1[1]); w.w = cvt_pk_bf16(v1[2], v1[3]);
                    *(u32x4*)(rowp + bj * HALF) = w; } }
    }
};
template <class Epi, class Sched, bool ALIGN_EPI = false, bool SP2 = false, int QM = 0, int NST = 0, bool ATILED = false, bool DUAL = false, int CHAIN = 0>
__device__ __forceinline__ void gemm_phase(PG8_LAS unsigned char* lds, const Gemm g, const Sched& S, const Epi& E, const char* chA = nullptr, const char* chB = nullptr) {
    int tid_ = threadIdx.x; asm volatile("" : "+v"(tid_));
    const int tid = tid_, wid = __builtin_amdgcn_readfirstlane(tid >> 6), lane = tid & 63, wr = wid >> 2, wc = wid & 3, fr = lane & 15, fq = lane >> 4;
    constexpr bool F8 = (QM == 1), I8 = (QM == 2), F4 = (QM == 3);
    const int K = g.K, nt = K / BK;
    unsigned voffA[2], voffB[2];
#pragma unroll
    for (int i = 0; i < 2; ++i) { int R, C; stage_rc(tid * 16 + i * 8192, R, C); const int Rb = Epi::BMAP64 ? (64 * (R >> 5) + perm32(R & 31)) : Epi::PERM ? ((R & ~31) + perm32(R & 31)) : R;
        voffA[i] = (unsigned)(R * (ATILED ? BK : K) + C) * 2u; voffB[i] = (unsigned)(Rb * BK + C) * 2u; }
    const size_t kstep = (size_t)(BK * 2);
    const size_t hstep = (size_t)HALF * K * 2;
    const size_t kstepB = (size_t)BM * BK * 2, hstepB = (size_t)(Epi::BMAP64 ? 32 : HALF) * BK * 2;
    const size_t kstepA = ATILED ? (size_t)BM * BK * 2 : kstep, hstepA = ATILED ? (size_t)HALF * BK * 2 : hstep;
    const size_t tstep = 2 * hstep;
    const unsigned ldsw = (unsigned)wid * 1024u;
    const int aoff = lds_byte(wr * 64 + fr, fq * 8), boff = lds_byte(wc * 32 + fr, fq * 8);
#define PG8_SA(b, h) (((b) * 2 + (h)) * HTB)
#define PG8_SB(b, h) ((4 + (b) * 2 + (h)) * HTB)
#define PG8_STAGE(bufoff, gbase, voff) do { _Pragma("unroll") for (int _i = 0; _i < 2; ++_i) \
        __builtin_amdgcn_global_load_lds((const unsigned*)((const char*)(gbase) + (voff)[_i]), (PG8_LAS unsigned*)(lds + (bufoff) + ldsw + _i * 8192), 16, 0, 0); } while (0)
#define PG8_LDA(dst, b, h) do { _Pragma("unroll") for (int m = 0; m < 4; ++m) { if constexpr (F8) dst##8[m] = cat16(*(const PG8_LAS bf16x8*)(lds + PG8_SA(b, h) + aoff + m * 2048), *(const PG8_LAS bf16x8*)(lds + PG8_SA(b, h) + aoff + m * 2048 + 1024)); \
        else { _Pragma("unroll") for (int k = 0; k < 2; ++k) dst[m][k] = *(const PG8_LAS bf16x8*)(lds + PG8_SA(b, h) + aoff + m * 2048 + k * 1024); } } } while (0)
#define PG8_LDB(dst, b, h) do { _Pragma("unroll") for (int n = 0; n < 2; ++n) { if constexpr (F8) dst##8[n] = cat16(*(const PG8_LAS bf16x8*)(lds + PG8_SB(b, h) + boff + n * 2048), *(const PG8_LAS bf16x8*)(lds + PG8_SB(b, h) + boff + n * 2048 + 1024)); \
        else { _Pragma("unroll") for (int k = 0; k < 2; ++k) dst[n][k] = *(const PG8_LAS bf16x8*)(lds + PG8_SB(b, h) + boff + n * 2048 + k * 1024); } } } while (0)
#define PG8_MMA(ai, bj, At, Bt) do { __builtin_amdgcn_s_setprio(1); _Pragma("unroll") for (int m = 0; m < 4; ++m) _Pragma("unroll") for (int n = 0; n < 2; ++n) { \
        if constexpr (F8) asm volatile("v_mfma_f32_16x16x128_f8f6f4 %0, %1, %2, %0" : "+v"(acc[ai][bj][m][n]) : "v"(Bt##8[n]), "v"(At##8[m]));     \
        else if constexpr (I8) { _Pragma("unroll") for (int k = 0; k < 2; ++k) asm volatile("v_mfma_i32_16x16x64_i8 %0, %1, %2, %0" : "+v"(acc[ai][bj][m][n]) : "v"(Bt[n][k]), "v"(At[m][k])); } \
        else if constexpr (F4) { _Pragma("unroll") for (int k = 0; k < 2; ++k) asm volatile("v_mfma_f32_16x16x128_f8f6f4 %0, %1, %2, %0 cbsz:4 blgp:4" : "+v"(acc[ai][bj][m][n]) : "v"(Bt[n][k]), "v"(At[m][k])); } \
        else { _Pragma("unroll") for (int k = 0; k < 2; ++k) acc[ai][bj][m][n] = __builtin_amdgcn_mfma_f32_16x16x32_bf16(Bt[n][k], At[m][k], acc[ai][bj][m][n], 0, 0, 0); } } \
        __builtin_amdgcn_s_setprio(0); } while (0)
#define PG8_WAIT_V(n) asm volatile("s_waitcnt vmcnt(" #n ")" ::: "memory")
#define PG8_WAIT_VF(fresh_) do { if constexpr (NST != 0) asm volatile("s_waitcnt vmcnt(%1)\n\ts_cmp_lg_u32 %0, 0\n\ts_cbranch_scc1 .Lpg8w%=\n\ts_waitcnt vmcnt(8)\n.Lpg8w%=:" :: "s"(fresh_), "n"(10 + NST) : "scc", "memory"); else PG8_WAIT_V(8); } while (0)
#define PG8_WAIT_L(n) asm volatile("s_waitcnt lgkmcnt(" #n ")" ::: "memory")
#define PG8_BAR __builtin_amdgcn_s_barrier()
#define PG8_SCHED __builtin_amdgcn_sched_barrier(0)
    Unit cur, nxt; int ui = 0;
    if (!S.next(0, cur)) return;
    f32x4 acc[2][2][4][2];
#pragma unroll
    for (int a = 0; a < 2; ++a)
#pragma unroll
        for (int b = 0; b < 2; ++b)
#pragma unroll
            for (int m = 0; m < 4; ++m)
#pragma unroll
                for (int n = 0; n < 2; ++n) acc[a][b][m][n] = (f32x4){0.f, 0.f, 0.f, 0.f};
    bf16x8 At[4][2], B0[2][2], B1[2][2];
    i32x8 At8[4], B08[2], B18[2];
    const char* cA = (const char*)g.A + (size_t)cur.pm * tstep; const char* cB = (const char*)g.Bt + (size_t)cur.pn * tstep;
    S.a_ready(cur);
    static_assert(CHAIN == 0 || (NST != 0 && !DUAL), "CHAIN rides on the NST hand-over");
    if constexpr (CHAIN & 1) {   }
    else if constexpr (SP2) {
        PG8_STAGE(PG8_SB(0, 0), cB, voffB); PG8_STAGE(PG8_SB(0, 1), cB + hstepB, voffB); PG8_STAGE(PG8_SA(0, 0), cA, voffA); PG8_STAGE(PG8_SA(0, 1), cA + hstepA, voffA);
        if (wr == 1) PG8_BAR;
        PG8_WAIT_V(2); PG8_BAR;
        PG8_STAGE(PG8_SB(1, 0), cB + kstepB, voffB); PG8_STAGE(PG8_SA(1, 0), cA + kstepA, voffA); PG8_STAGE(PG8_SB(1, 1), cB + hstepB + kstepB, voffB);
        PG8_WAIT_V(6); PG8_BAR;
    } else {
        PG8_STAGE(PG8_SB(0, 0), cB, voffB); PG8_STAGE(PG8_SA(0, 0), cA, voffA); PG8_STAGE(PG8_SB(0, 1), cB + hstepB, voffB); PG8_STAGE(PG8_SA(0, 1), cA + hstepA, voffA);
        if (wr == 1) PG8_BAR;
        PG8_WAIT_V(4); PG8_BAR;
        PG8_STAGE(PG8_SB(1, 0), cB + kstepB, voffB); PG8_STAGE(PG8_SA(1, 0), cA + kstepA, voffA); PG8_STAGE(PG8_SB(1, 1), cB + hstepB + kstepB, voffB);
        PG8_WAIT_V(6); PG8_BAR;
    }
    for (;;) {
        const bool has_next = S.next(ui + 1, nxt);
        const char* uA = has_next ? (const char*)g.A + (size_t)nxt.pm * tstep : ((CHAIN & 2) ? chA : cA); const char* uB = has_next ? (const char*)g.Bt + (size_t)nxt.pn * tstep : ((CHAIN & 2) ? chB : cB);
        const char* nA = uA; const char* nB = uB;
#pragma unroll
        for (int seg = 0; seg < (DUAL ? 2 : 1); ++seg) {
        if (DUAL && seg == 0) { nA = (const char*)g.A2 + (size_t)cur.pm * tstep; nB = (const char*)g.Bt2 + (size_t)cur.pn * tstep; } else { nA = uA; nB = uB; }
        for (int t = 0; t < nt; t += 2) {
            const bool last = (t == nt - 2);
            const char* a1 = cA + (size_t)(t + 1) * kstepA;
            const char* a2 = last ? nA : cA + (size_t)(t + 2) * kstepA; const char* b2 = last ? nB : cB + (size_t)(t + 2) * kstepB;
            const char* a3 = a2 + kstepA; const char* b3 = b2 + kstepB;
            if (last && has_next) S.a_ready(nxt);
            if constexpr (SP2) {
            const int fresh = __builtin_amdgcn_readfirstlane((NST != 0 && t == 0 && (ui > 0 || (CHAIN & 1)) && seg == 0) ? 1 : 0);
            PG8_LDB(B0, 0, 0); PG8_LDB(B1, 0, 1); PG8_SCHED; PG8_LDA(At, 0, 0); PG8_STAGE(PG8_SA(1, 1), a1 + hstepA, voffA);
            PG8_WAIT_VF(fresh); PG8_WAIT_L(0); PG8_BAR; PG8_MMA(0, 0, At, B0); PG8_MMA(0, 1, At, B1); PG8_BAR; PG8_SCHED;
            PG8_LDA(At, 0, 1); PG8_STAGE(PG8_SB(0, 0), b2, voffB); PG8_STAGE(PG8_SB(0, 1), b2 + hstepB, voffB); PG8_STAGE(PG8_SA(0, 0), a2, voffA);
            PG8_WAIT_VF(fresh); PG8_WAIT_L(0); PG8_BAR; PG8_MMA(1, 0, At, B0); PG8_MMA(1, 1, At, B1); PG8_BAR; PG8_SCHED;
            PG8_LDB(B0, 1, 0); PG8_LDB(B1, 1, 1); PG8_SCHED; PG8_LDA(At, 1, 0); PG8_STAGE(PG8_SA(0, 1), a2 + hstepA, voffA);
            PG8_WAIT_VF(fresh); PG8_WAIT_L(0); PG8_BAR; PG8_MMA(0, 0, At, B0); PG8_MMA(0, 1, At, B1); PG8_BAR; PG8_SCHED;
            PG8_LDA(At, 1, 1); PG8_STAGE(PG8_SB(1, 0), b3, voffB); PG8_STAGE(PG8_SB(1, 1), b3 + hstepB, voffB); PG8_STAGE(PG8_SA(1, 0), a3, voffA);
            PG8_WAIT_V(8); PG8_WAIT_L(0); PG8_BAR; PG8_MMA(1, 0, At, B0); PG8_MMA(1, 1, At, B1); PG8_BAR; PG8_SCHED;
            } else {
            PG8_LDB(B0, 0, 0); PG8_SCHED; PG8_LDA(At, 0, 0); PG8_STAGE(PG8_SA(1, 1), a1 + hstepA, voffA);
            PG8_WAIT_L(8); PG8_BAR; PG8_WAIT_L(0); PG8_MMA(0, 0, At, B0); PG8_BAR; PG8_SCHED;
            PG8_LDB(B1, 0, 1); PG8_STAGE(PG8_SB(0, 0), b2, voffB);
            PG8_BAR; PG8_WAIT_L(0); PG8_MMA(0, 1, At, B1); PG8_BAR;
            PG8_LDA(At, 0, 1); PG8_STAGE(PG8_SA(0, 0), a2, voffA);
            PG8_BAR; PG8_WAIT_L(0); PG8_MMA(1, 0, At, B0); PG8_BAR; PG8_SCHED;
            PG8_STAGE(PG8_SB(0, 1), b2 + hstepB, voffB);
            PG8_WAIT_V(6); PG8_BAR; PG8_MMA(1, 1, At, B1); PG8_BAR;
            PG8_LDB(B0, 1, 0); PG8_SCHED; PG8_LDA(At, 1, 0); PG8_STAGE(PG8_SA(0, 1), a2 + hstepA, voffA);
            PG8_WAIT_L(8); PG8_BAR; PG8_WAIT_L(0); PG8_MMA(0, 0, At, B0); PG8_BAR; PG8_SCHED;
            PG8_LDB(B1, 1, 1); PG8_STAGE(PG8_SB(1, 0), b3, voffB);
            PG8_BAR; PG8_WAIT_L(0); PG8_MMA(0, 1, At, B1); PG8_BAR;
            PG8_LDA(At, 1, 1); PG8_STAGE(PG8_SA(1, 0), a3, voffA);
            PG8_BAR; PG8_WAIT_L(0); PG8_MMA(1, 0, At, B0); PG8_BAR; PG8_SCHED;
            PG8_STAGE(PG8_SB(1, 1), b3 + hstepB, voffB);
            PG8_WAIT_V(6); PG8_BAR; PG8_MMA(1, 1, At, B1); PG8_BAR;
            }
        }
        if constexpr (ALIGN_EPI) { if (wr == 0) PG8_BAR; }
        if constexpr (DUAL) { if (seg == 0) {
            asm volatile("s_nop 15\n\ts_nop 15" ::: "memory");
            E.mid(acc, cur, wr, wc, fr, fq);
            cA = nA; cB = nB;
            if constexpr (ALIGN_EPI) { if (wr == 1) PG8_BAR; } } }
        }
        if constexpr (F8 || F4) { asm volatile("s_nop 15\n\ts_nop 15" ::: "memory");
            const float os_ = g.oscale;
#pragma unroll
            for (int a = 0; a < 2; ++a)
#pragma unroll
                for (int b = 0; b < 2; ++b)
#pragma unroll
                    for (int m = 0; m < 4; ++m)
#pragma unroll
                        for (int n = 0; n < 2; ++n) acc[a][b][m][n] = acc[a][b][m][n] * os_; }
        if constexpr (I8) { asm volatile("s_nop 15\n\ts_nop 15" ::: "memory"); const float os_ = g.oscale;
#pragma unroll
            for (int a = 0; a < 2; ++a)
#pragma unroll
                for (int b = 0; b < 2; ++b)
#pragma unroll
                    for (int m = 0; m < 4; ++m)
#pragma unroll
                        for (int n = 0; n < 2; ++n) { const i32x4v iv = __builtin_bit_cast(i32x4v, acc[a][b][m][n]); acc[a][b][m][n] = (f32x4){(float)iv[0], (float)iv[1], (float)iv[2], (float)iv[3]} * os_; } }
        if constexpr (NST != 0) { static_assert(ALIGN_EPI && SP2, "NST needs both halves past the K-loop's last read of As[1][1] (ALIGN_EPI) and the SP2 loop");
            if (has_next || (CHAIN & 2)) PG8_STAGE(PG8_SA(1, 1), nA + kstepA + hstepA, voffA);
            asm volatile("" ::: "memory"); }
        if constexpr (!Epi::AFTER_DRAIN) { E(acc, cur, wr, wc, fr, fq); S.done(cur); }
        if (!has_next) break;
#pragma unroll
        for (int a = 0; a < 2; ++a)
#pragma unroll
            for (int b = 0; b < 2; ++b)
#pragma unroll
                for (int m = 0; m < 4; ++m)
#pragma unroll
                    for (int n = 0; n < 2; ++n) acc[a][b][m][n] = (f32x4){0.f, 0.f, 0.f, 0.f};
        cur = nxt; cA = nA; cB = nB; ++ui;
        if constexpr (ALIGN_EPI) { if (wr == 1) PG8_BAR; }
    }
    if constexpr (CHAIN & 2) { if constexpr (ALIGN_EPI) { if (wr == 1) PG8_BAR; } }
    else {
    PG8_WAIT_V(0);
    if constexpr (!ALIGN_EPI) { if (wr == 0) PG8_BAR; }
    PG8_BAR;
    }
    if constexpr (Epi::AFTER_DRAIN) { E.fused(acc, cur, wr, wc, fr, fq, lds, wid, lane); S.done(cur); }
#undef PG8_SA
#undef PG8_SB
#undef PG8_STAGE
#undef PG8_LDA
#undef PG8_LDB
#undef PG8_MMA
#undef PG8_WAIT_V
#undef PG8_WAIT_L
#undef PG8_BAR
#undef PG8_SCHED
}
}

constexpr int NWAVES = 8;
constexpr int BATCH = 4, SEQ = 2048, DM = 4096, M = BATCH * SEQ;
constexpr int AW = 2048, AHEADS = 16, AD = 128;
constexpr int BQH = 32, BKVH = 4, BD = 64, BKVW = 256, WIN = 128;
constexpr int NIN = 16896, DFF = 16384, PLE = 256;
constexpr int MBLK = 256, NBLK = SEQ / MBLK, TOPK = 3;
constexpr float LN_EPS = 1e-5f;
constexpr float ALPHA = 1.189207115002721f;
constexpr float LOG2E = 1.4426950408889634f;
constexpr float QSCALE_A = 0.08838834764831845f * LOG2E;
constexpr float QSCALE_B = 0.125f * LOG2E;
constexpr int NPH = 10;

constexpr size_t MiB = 1u << 20;
constexpr size_t WS_CTL = 0, CTL_ZERO_BYTES = 832 * 1024;
constexpr size_t WS_TABA = 1 * MiB;
constexpr size_t WS_TABB = 2 * MiB;
constexpr size_t WS_KMP  = 3 * MiB;
constexpr size_t WS_WIN  = 4 * MiB;
constexpr size_t WS_TA   = WS_WIN;
constexpr size_t WS_WUPA = 136 * MiB, WS_WUPB = 152 * MiB, WS_WO = 168 * MiB, WS_WPLE = 200 * MiB, WS_WPLEG = 202 * MiB;
constexpr size_t WS_WFFUP = 234 * MiB;
constexpr size_t WS_PLE  = 72 * MiB;
constexpr size_t WS_WFFDN = 362 * MiB;
constexpr size_t WS_XB   = 490 * MiB;
constexpr size_t WS_H1B  = WS_XB;
constexpr size_t WS_PB   = 554 * MiB;
constexpr size_t WS_QA = 558 * MiB, WS_KA = 590 * MiB, WS_VA = 622 * MiB, WS_QB = 654 * MiB, WS_KB = 686 * MiB, WS_VB = 690 * MiB, WS_GA = 694 * MiB, WS_GB = 758 * MiB;
constexpr size_t WS_MG   = WS_QA;
constexpr size_t WS_U    = WS_QA;
constexpr size_t WS_YA = 822 * MiB, WS_YB = 854 * MiB;
constexpr size_t WS_H2B  = WS_YA;
constexpr size_t WS_XB4  = 888 * MiB;
constexpr size_t WS_WG4  = 904 * MiB;
constexpr size_t WS_T12  = 940 * MiB;
constexpr size_t WS_END  = 1004 * MiB;
constexpr int CW_BAR = 4096;
constexpr size_t CB_ST1 = 256 * 1024, CB_ST2 = 384 * 1024, CB_C1F = 512 * 1024, CB_C2F = 640 * 1024, CB_C1G = 768 * 1024, CB_C2G = 800 * 1024;
constexpr size_t WS_CF32 = 3 * MiB + 512 * 1024;
constexpr float FXS = 4294967296.0f;
__device__ __forceinline__ void fx_add(long long* p, float v) { atomicAdd((unsigned long long*)p, (unsigned long long)(long long)(v * FXS)); }

constexpr int RING_OFF = 0, RING_BYTES = 131072;
constexpr int CV_CH = 1056, CV_SLOT = 8 * CV_CH, CV_WAVE = 2 * CV_SLOT;
constexpr int LDSCTL_OFF = 8 * CV_WAVE, MISC_OFF = LDSCTL_OFF + 320;
static_assert(LDSCTL_OFF >= RING_BYTES && LDSCTL_OFF % 16 == 0, "LDS map");
constexpr int LDS_BYTES = 147456;

#define GAS __attribute__((address_space(1)))
#define LAS __attribute__((address_space(3)))
typedef unsigned short bf16;
typedef float f32x4 __attribute__((ext_vector_type(4)));
typedef float f32x2 __attribute__((ext_vector_type(2)));
typedef unsigned u32x4 __attribute__((ext_vector_type(4)));
typedef unsigned u32x2 __attribute__((ext_vector_type(2)));
typedef unsigned char f8;
constexpr float F8S_X = 4.f, F8S_WIN = 512.f, F8S_Y = 64.f, F8S_WUP = 512.f, F8S_MG = 64.f, F8S_WO = 512.f;
constexpr float F4S_X = 2.f, F4S_WG = 128.f;
__device__ __forceinline__ unsigned pk8f4(float a, float b, float c, float d, float e, float f, float g, float h) {
    unsigned w = 0u; w = __builtin_amdgcn_cvt_scalef32_pk_fp4_f32(w, a, b, 1.0f, 0); w = __builtin_amdgcn_cvt_scalef32_pk_fp4_f32(w, c, d, 1.0f, 1);
    w = __builtin_amdgcn_cvt_scalef32_pk_fp4_f32(w, e, f, 1.0f, 2); w = __builtin_amdgcn_cvt_scalef32_pk_fp4_f32(w, g, h, 1.0f, 3); return w;
}
constexpr float I8S_T2 = 20.f, I8S_WG = 1800.f;
__device__ __forceinline__ unsigned pk4u8(float a, float b, float c, float d) { unsigned r = 0; r = __builtin_amdgcn_cvt_pk_u8_f32(a * 255.f, 0, r); r = __builtin_amdgcn_cvt_pk_u8_f32(b * 255.f, 1, r); r = __builtin_amdgcn_cvt_pk_u8_f32(c * 255.f, 2, r); return __builtin_amdgcn_cvt_pk_u8_f32(d * 255.f, 3, r); }
__device__ __forceinline__ f32x4 un4u8(unsigned w) { return (f32x4){(float)(w & 0xffu), (float)((w >> 8) & 0xffu), (float)((w >> 16) & 0xffu), (float)(w >> 24)} * (1.0f / 255.f); }
__device__ __forceinline__ unsigned pk4i8(float a, float b, float c, float d) {
    const int ia = (int)__builtin_rintf(__builtin_amdgcn_fmed3f(a, -127.f, 127.f)), ib = (int)__builtin_rintf(__builtin_amdgcn_fmed3f(b, -127.f, 127.f)), ic = (int)__builtin_rintf(__builtin_amdgcn_fmed3f(c, -127.f, 127.f)), id = (int)__builtin_rintf(__builtin_amdgcn_fmed3f(d, -127.f, 127.f));
    return ((unsigned)ia & 0xffu) | (((unsigned)ib & 0xffu) << 8) | (((unsigned)ic & 0xffu) << 16) | ((unsigned)id << 24);
}
__device__ __forceinline__ unsigned pk4f8(float a, float b, float c, float d) {
    a = __builtin_amdgcn_fmed3f(a, -448.f, 448.f); b = __builtin_amdgcn_fmed3f(b, -448.f, 448.f); c = __builtin_amdgcn_fmed3f(c, -448.f, 448.f); d = __builtin_amdgcn_fmed3f(d, -448.f, 448.f);
    unsigned w = 0u; w = __builtin_amdgcn_cvt_pk_fp8_f32(a, b, w, false); w = __builtin_amdgcn_cvt_pk_fp8_f32(c, d, w, true); return w;
}
#define LDS_WAIT() asm volatile("s_waitcnt lgkmcnt(0)" ::: "memory")
#define VM_WAIT() asm volatile("s_waitcnt vmcnt(0)" ::: "memory")

typedef __bf16 bf16x2_t __attribute__((ext_vector_type(2)));
__device__ __forceinline__ unsigned pk2(float lo, float hi) { const f32x2 v = {lo, hi}; const bf16x2_t b = __builtin_convertvector(v, bf16x2_t); return __builtin_bit_cast(unsigned, b); }
__device__ __forceinline__ float bflo(unsigned u) { return __uint_as_float(u << 16); }
__device__ __forceinline__ float bfhi(unsigned u) { return __uint_as_float(u & 0xffff0000u); }
__device__ __forceinline__ float sigmoidf_(float x) { return __builtin_amdgcn_rcpf(1.0f + __expf(-x)); }
__device__ __forceinline__ float wave_sum(float v) {
#pragma unroll
    for (int o = 1; o < 64; o <<= 1) v += __shfl_xor(v, o);
    return v;
}
__device__ __forceinline__ float wave_max(float v) {
#pragma unroll
    for (int o = 1; o < 64; o <<= 1) v = fmaxf(v, __shfl_xor(v, o));
    return v;
}

#define XB_TMO      128
#define XB_XCNT(j)  (256  + 64 * (j))
#define XB_XSUB(j)  (1280 + 64 * (j))
#define XB_XGEN(j)  (2304 + 64 * (j))
#define XB_TOP      3328
#define XB_TOPGEN   3392
#define XCD_BAR_WORDS 3456
#define XB_SPIN_CAP (1u << 18)

__device__ __forceinline__ unsigned xb_ld(unsigned* p)              { return __hip_atomic_load(p, __ATOMIC_RELAXED, __HIP_MEMORY_SCOPE_AGENT); }
__device__ __forceinline__ unsigned xb_add(unsigned* p, unsigned v) { return __hip_atomic_fetch_add(p, v, __ATOMIC_RELAXED, __HIP_MEMORY_SCOPE_AGENT); }
__device__ __forceinline__ unsigned xb_xcc_id() { return (unsigned)__builtin_amdgcn_s_getreg((3 << 11) | 20) & 0xFu; }
#define XB_SPIN(cond, bar) do { unsigned _sp = 0; while (cond) { __builtin_amdgcn_s_sleep(1); \
    if ((++_sp & 255u) == 0u) { if (xb_ld(&(bar)[XB_TMO])) break; if (_sp > XB_SPIN_CAP) { atomicAdd(&(bar)[XB_TMO], 1u); break; } } } } while (0)

struct XcdBarrier {
    unsigned* bar; unsigned x;
    volatile LAS unsigned* st;
};

__device__ __forceinline__ XcdBarrier xcd_barrier_post(unsigned* bar, volatile LAS unsigned* st) {
    XcdBarrier b; b.bar = bar; b.x = xb_xcc_id(); b.st = st;
    if (threadIdx.x == 0) (void)xb_add(&bar[XB_XCNT(b.x)], 1u);
    return b;
}
__device__ __forceinline__ void xcd_barrier_complete(unsigned* bar, unsigned x, unsigned& nloc, unsigned& nx) {
    const unsigned G = gridDim.x * gridDim.y * gridDim.z;
    unsigned sum, cnt, mine, sp = 0u;
    for (;;) {
        sum = 0u; cnt = 0u; mine = 0u;
#pragma unroll
        for (unsigned j = 0; j < 16; ++j) { const unsigned c = xb_ld(&bar[XB_XCNT(j)]); sum += c; cnt += (c > 0u) ? 1u : 0u; mine = (j == x) ? c : mine; }
        if (sum == G) break;
        __builtin_amdgcn_s_sleep(1);
        if ((++sp & 255u) == 0u) { if (xb_ld(&bar[XB_TMO])) break; if (sp > XB_SPIN_CAP) { atomicAdd(&bar[XB_TMO], 1u); break; } }
    }
    nloc = mine > 0u ? mine : 1u; nx = cnt > 0u ? cnt : 1u;
}

__device__ __forceinline__ void xcd_barrier(const XcdBarrier& b) {
    asm volatile("s_waitcnt vmcnt(0)" ::: "memory");
    __syncthreads();
    if (threadIdx.x == 0) {
        unsigned* bar = b.bar;
        __builtin_amdgcn_s_waitcnt(0);
        unsigned nloc = b.st[0], nx = b.st[1];
        if (nloc == 0u) { xcd_barrier_complete(bar, b.x, nloc, nx); b.st[0] = nloc; b.st[1] = nx; }
        const unsigned old = xb_add(&bar[XB_XSUB(b.x)], 1u);
        const unsigned gen = old / nloc;
        if (old + 1u == (gen + 1u) * nloc) {
            __builtin_amdgcn_fence(__ATOMIC_RELEASE, "agent");
            asm volatile("s_waitcnt vmcnt(0)" ::: "memory");
            const unsigned og = xb_add(&bar[XB_TOP], 1u);
            const unsigned tg = og / nx;
            if (og + 1u == (tg + 1u) * nx) xb_add(&bar[XB_TOPGEN], 1u);
            else XB_SPIN(xb_ld(&bar[XB_TOPGEN]) == tg, bar);
            __builtin_amdgcn_fence(__ATOMIC_ACQUIRE, "agent");
            xb_add(&bar[XB_XGEN(b.x)], 1u);
            asm volatile("s_waitcnt vmcnt(0)" ::: "memory");
        } else {
            XB_SPIN(xb_ld(&bar[XB_XGEN(b.x)]) == gen, bar);
            __builtin_amdgcn_fence(__ATOMIC_ACQUIRE, "agent");
            asm volatile("s_waitcnt vmcnt(0)" ::: "memory");
        }
    }
    __syncthreads();
}


__device__ __forceinline__ size_t toff(int n, int kbyte, int rowbytes) { return (size_t)(n >> 8) * ((size_t)rowbytes * 256) + ((size_t)(kbyte >> 7) * 256 + (n & 255)) * 128 + (kbyte & 127); }
template <class T> __device__ __forceinline__ T* tp_base(T* p, int pm, int pn, int ntn, int nsteps, int step) { return p + ((size_t)(pm * ntn + pn) * nsteps + step) * 512; }
using pg8::Unit;
template <int MODE> struct EpiZ {
    static constexpr bool PERM = true, AFTER_DRAIN = false, BMAP64 = false;
    bf16* O; bf16* O2; int ldc; float sc; const float* tab; const float* bias; float* kmp;
    __device__ __forceinline__ void plain(const f32x4 (&acc)[2][2][4][2], bf16* Op, int row0, int col0) const {
#pragma unroll
        for (int ai = 0; ai < 2; ++ai)
#pragma unroll
            for (int m = 0; m < 4; ++m) { bf16* rowp = Op + (size_t)(row0 + ai * 128 + m * 16) * ldc + col0;
#pragma unroll
                for (int bj = 0; bj < 2; ++bj) { const f32x4 v0 = acc[ai][bj][m][0], v1 = acc[ai][bj][m][1];
                    u32x4 w; w.x = pk2(v0[0], v0[1]); w.y = pk2(v0[2], v0[3]); w.z = pk2(v1[0], v1[1]); w.w = pk2(v1[2], v1[3]);
                    *(u32x4*)(rowp + bj * 128) = w; } }
    }
    template <bool ISA> __device__ __forceinline__ void rope(const f32x4 (&acc)[2][2][4][2], bf16* Op, int row0, int col0, int wc, int fq) const {
        constexpr int tstride = ISA ? 128 : 64;
        const int i0 = ISA ? (16 * wc + 4 * fq) : (16 * (wc & 1) + 4 * fq);
#pragma unroll
        for (int ai = 0; ai < 2; ++ai)
#pragma unroll
            for (int m = 0; m < 4; ++m) { const int row = row0 + ai * 128 + m * 16, pos = row & (SEQ - 1);
                const f32x4 t0 = *(const f32x4*)(tab + (size_t)pos * tstride + 2 * i0), t1 = *(const f32x4*)(tab + (size_t)pos * tstride + 2 * i0 + 4);
                bf16* rowp = Op + (size_t)row * ldc + col0;
#pragma unroll
                for (int bj = 0; bj < 2; ++bj) { const f32x4 v0 = acc[ai][bj][m][0], v1 = acc[ai][bj][m][1];
                    f32x4 o0, o1;
                    o0[0] = v0[0] * t0[0] - v0[1] * t0[1]; o0[1] = v0[0] * t0[1] + v0[1] * t0[0];
                    o0[2] = v0[2] * t0[2] - v0[3] * t0[3]; o0[3] = v0[2] * t0[3] + v0[3] * t0[2];
                    o1[0] = v1[0] * t1[0] - v1[1] * t1[1]; o1[1] = v1[0] * t1[1] + v1[1] * t1[0];
                    o1[2] = v1[2] * t1[2] - v1[3] * t1[3]; o1[3] = v1[2] * t1[3] + v1[3] * t1[2];
                    o0 = o0 * sc; o1 = o1 * sc;
                    u32x4 w; w.x = pk2(o0[0], o0[1]); w.y = pk2(o0[2], o0[3]); w.z = pk2(o1[0], o1[1]); w.w = pk2(o1[2], o1[3]);
                    *(u32x4*)(rowp + bj * 128) = w; }
                asm volatile("" ::: "memory"); }
    }
    __device__ __forceinline__ void operator()(const f32x4 (&acc)[2][2][4][2], const Unit& u, int wr, int wc, int fr, int fq) const {
        const int row0 = u.pm * 256 + wr * 64 + fr, col0 = u.pn * 256 + wc * 32 + 8 * fq, tidp = ((wr * 4 + wc) * 64 + fq * 16 + fr) & 511;
        if constexpr (MODE == 0) plain(acc, O, row0, col0);
        else if constexpr (MODE == 1) rope<true>(acc, O, row0, col0, wc, fq);
        else if constexpr (MODE == 3) rope<false>(acc, O, row0, col0, wc, fq);
        else if constexpr (MODE == 5) { if (u.pn == 0) rope<false>(acc, O, row0, col0, wc, fq); else plain(acc, O2, row0, col0 - 256); }
        else if constexpr (MODE == 4) {
            f32x4 bv[2][2];
#pragma unroll
            for (int bj = 0; bj < 2; ++bj)
#pragma unroll
                for (int n = 0; n < 2; ++n) bv[bj][n] = *(const f32x4*)(bias + col0 + bj * 128 + 4 * n);
#pragma unroll
            for (int ai = 0; ai < 2; ++ai)
#pragma unroll
                for (int m = 0; m < 4; ++m) {
#pragma unroll
                    for (int bj = 0; bj < 2; ++bj) { const f32x4 v0 = acc[ai][bj][m][0] + bv[bj][0], v1 = acc[ai][bj][m][1] + bv[bj][1];
                        u32x2 w; w.x = pk4u8(sigmoidf_(v0[0]), sigmoidf_(v0[1]), sigmoidf_(v0[2]), sigmoidf_(v0[3])); w.y = pk4u8(sigmoidf_(v1[0]), sigmoidf_(v1[1]), sigmoidf_(v1[2]), sigmoidf_(v1[3]));
                        tp_base((u32x2*)(u.pn >= 16 ? O2 : O), u.pm, u.pn & 15, 16, 16, (ai * 4 + m) * 2 + bj)[tidp] = w; } }
        } else {
            rope<true>(acc, O, row0, col0, wc, fq);
            const int i0 = 16 * wc + 4 * fq;
            float* kp = kmp + (size_t)(u.pm * 2 + wr) * AW + col0;
#pragma unroll
            for (int bj = 0; bj < 2; ++bj) { f32x4 c0 = (f32x4){0.f, 0.f, 0.f, 0.f}, c1 = (f32x4){0.f, 0.f, 0.f, 0.f};
#pragma unroll
                for (int ai = 0; ai < 2; ++ai)
#pragma unroll
                    for (int m = 0; m < 4; ++m) { const int pos = (row0 + ai * 128 + m * 16) & (SEQ - 1);
                        const f32x4 t0 = *(const f32x4*)(tab + (size_t)pos * 128 + 2 * i0), t1 = *(const f32x4*)(tab + (size_t)pos * 128 + 2 * i0 + 4);
                        const f32x4 v0 = acc[ai][bj][m][0], v1 = acc[ai][bj][m][1];
                        c0[0] += v0[0] * t0[0] - v0[1] * t0[1]; c0[1] += v0[0] * t0[1] + v0[1] * t0[0];
                        c0[2] += v0[2] * t0[2] - v0[3] * t0[3]; c0[3] += v0[2] * t0[3] + v0[3] * t0[2];
                        c1[0] += v1[0] * t1[0] - v1[1] * t1[1]; c1[1] += v1[0] * t1[1] + v1[1] * t1[0];
                        c1[2] += v1[2] * t1[2] - v1[3] * t1[3]; c1[3] += v1[2] * t1[3] + v1[3] * t1[2]; }
#pragma unroll
                for (int o = 1; o < 16; o <<= 1) {
#pragma unroll
                    for (int j = 0; j < 4; ++j) { c0[j] += __shfl_xor(c0[j], o); c1[j] += __shfl_xor(c1[j], o); } }
                if (fr == 0) { *(f32x4*)(kp + bj * 128) = c0; *(f32x4*)(kp + bj * 128 + 4) = c1; }
                asm volatile("" ::: "memory"); }
        }
    }
};
constexpr float GB_MIN = 9.094947e-13f;
struct EpiMG {
    static constexpr bool PERM = true, AFTER_DRAIN = false, BMAP64 = false;
    const bf16* Ga; const bf16* Gb; f8* MG;
    __device__ __forceinline__ void mid(f32x4 (&acc)[2][2][4][2], const Unit& u, int wr, int wc, int fr, int fq) const {
        asm volatile("" : "+v"(fr));
        const int tidp = ((wr * 4 + wc) * 64 + fq * 16 + fr) & 511;
#pragma unroll
        for (int ai = 0; ai < 2; ++ai)
#pragma unroll
            for (int m = 0; m < 4; ++m) {
#pragma unroll
                for (int bj = 0; bj < 2; ++bj) { const u32x2 ga = tp_base((const u32x2*)Ga, u.pm, u.pn, DM / 256, 16, (ai * 4 + m) * 2 + bj)[tidp], gb = tp_base((const u32x2*)Gb, u.pm, u.pn, DM / 256, 16, (ai * 4 + m) * 2 + bj)[tidp];
                    const f32x4 a0 = un4u8(ga.x), a1 = un4u8(ga.y), b0 = un4u8(gb.x), b1 = un4u8(gb.y);
                    f32x4 r0, r1;
#pragma unroll
                    for (int j = 0; j < 4; ++j) { r0[j] = a0[j] * __builtin_amdgcn_rcpf(fmaxf(b0[j], GB_MIN)); r1[j] = a1[j] * __builtin_amdgcn_rcpf(fmaxf(b1[j], GB_MIN)); }
                    acc[ai][bj][m][0] = acc[ai][bj][m][0] * r0; acc[ai][bj][m][1] = acc[ai][bj][m][1] * r1; }
                asm volatile("" : "+v"(acc[ai][0][m][0]), "+v"(acc[ai][0][m][1]), "+v"(acc[ai][1][m][0]), "+v"(acc[ai][1][m][1]) :: "memory"); }
    }
    __device__ __forceinline__ void operator()(const f32x4 (&acc)[2][2][4][2], const Unit& u, int wr, int wc, int fr, int fq) const {
        asm volatile("" : "+v"(fr));
        const int row0 = u.pm * 256 + wr * 64 + fr, col0 = u.pn * 256 + wc * 32 + 8 * fq, tidp = ((wr * 4 + wc) * 64 + fq * 16 + fr) & 511;
#pragma unroll
        for (int ai = 0; ai < 2; ++ai)
#pragma unroll
            for (int m = 0; m < 4; ++m) {
#pragma unroll
                for (int bj = 0; bj < 2; ++bj) { const u32x2 gb = tp_base((const u32x2*)Gb, u.pm, u.pn, DM / 256, 16, (ai * 4 + m) * 2 + bj)[tidp];
                    f32x4 b0 = un4u8(gb.x), b1 = un4u8(gb.y);
#pragma unroll
                    for (int j = 0; j < 4; ++j) { b0[j] = fmaxf(b0[j], GB_MIN) * F8S_MG; b1[j] = fmaxf(b1[j], GB_MIN) * F8S_MG; }
                    const f32x4 v0 = acc[ai][bj][m][0] * b0, v1 = acc[ai][bj][m][1] * b1;
                    u32x2 w; w.x = pk4f8(v0[0], v0[1], v0[2], v0[3]); w.y = pk4f8(v1[0], v1[1], v1[2], v1[3]);
                    *(u32x2*)((unsigned char*)MG + toff(row0 + ai * 128 + m * 16, col0 + bj * 128, DM)) = w; } }
    }
};
__device__ __forceinline__ f32x2 ln_stats(const long long* st, int row) {
    const double s1 = (double)st[2 * row] * (1.0 / 4294967296.0 / DM), s2 = (double)st[2 * row + 1] * (1.0 / 4294967296.0 / DM);
    const float mean = (float)s1, var = fmaxf((float)(s2 - s1 * s1), 0.f);
    return (f32x2){mean, __builtin_amdgcn_rsqf(var + LN_EPS)};
}
template <bool LN> struct EpiRes {
    static constexpr bool PERM = true, AFTER_DRAIN = false, BMAP64 = false;
    const void* base; bf16* out; bf16* outb; const long long* st; const float* g; const float* b; long long* stn;
    __device__ __forceinline__ void operator()(const f32x4 (&acc)[2][2][4][2], const Unit& u, int wr, int wc, int fr, int fq) const {
        const int row0 = u.pm * 256 + wr * 64 + fr, col0 = u.pn * 256 + wc * 32 + 8 * fq, tidp = ((wr * 4 + wc) * 64 + fq * 16 + fr) & 511;
        f32x4 gg[2][2], bb[2][2];
        if (LN) {
#pragma unroll
            for (int bj = 0; bj < 2; ++bj)
#pragma unroll
                for (int n = 0; n < 2; ++n) { gg[bj][n] = *(const f32x4*)(g + col0 + bj * 128 + 4 * n); bb[bj][n] = *(const f32x4*)(b + col0 + bj * 128 + 4 * n); } }
#pragma unroll
        for (int ai = 0; ai < 2; ++ai)
#pragma unroll
            for (int m = 0; m < 4; ++m) { const int row = row0 + ai * 128 + m * 16; const size_t off = (size_t)row * DM + col0;
                f32x2 sr = {0.f, 0.f}; if (LN) sr = ln_stats(st, row);
                float s1 = 0.f, s2 = 0.f;
#pragma unroll
                for (int bj = 0; bj < 2; ++bj) { f32x4 t[2];
                    if (LN) { const u32x4 tw = *(const u32x4*)((const unsigned char*)base + toff(row, 2 * (col0 + bj * 128), 2 * DM));
                        t[0] = (f32x4){bflo(tw.x), bfhi(tw.x), bflo(tw.y), bfhi(tw.y)}; t[1] = (f32x4){bflo(tw.z), bfhi(tw.z), bflo(tw.w), bfhi(tw.w)}; }
                    else { t[0] = *(const f32x4*)((const float*)base + off + bj * 128); t[1] = *(const f32x4*)((const float*)base + off + bj * 128 + 4); }
#pragma unroll
                    for (int n = 0; n < 2; ++n) { f32x4 x = t[n];
                        if (LN) x = ((x - sr[0]) * sr[1] * gg[bj][n] + bb[bj][n]) * ALPHA + acc[ai][bj][m][n]; else x = x * ALPHA + acc[ai][bj][m][n];
                        t[n] = x; s1 += (x[0] + x[1]) + (x[2] + x[3]); s2 += (x[0] * x[0] + x[1] * x[1]) + (x[2] * x[2] + x[3] * x[3]); }
                    u32x4 w; w.x = pk2(t[0][0], t[0][1]); w.y = pk2(t[0][2], t[0][3]); w.z = pk2(t[1][0], t[1][1]); w.w = pk2(t[1][2], t[1][3]);
                    if (LN) { tp_base((u32x4*)out, u.pm, u.pn, DM / 256, 16, (ai * 4 + m) * 2 + bj)[tidp] = w;
                        u32x2 w8; w8.x = pk4i8(t[0][0] * I8S_T2, t[0][1] * I8S_T2, t[0][2] * I8S_T2, t[0][3] * I8S_T2); w8.y = pk4i8(t[1][0] * I8S_T2, t[1][1] * I8S_T2, t[1][2] * I8S_T2, t[1][3] * I8S_T2);
                        *(u32x2*)((unsigned char*)outb + toff(row, col0 + bj * 128, DM)) = w8; }
                    else *(u32x4*)((unsigned char*)outb + toff(row, 2 * (col0 + bj * 128), 2 * DM)) = w; }
                s1 += __shfl_xor(s1, 16); s2 += __shfl_xor(s2, 16); s1 += __shfl_xor(s1, 32); s2 += __shfl_xor(s2, 32);
                if (fq == 0) { fx_add(stn + 2 * row, s1); fx_add(stn + 2 * row + 1, s2); }
                asm volatile("" ::: "memory"); }
    }
};
struct EpiU {
    static constexpr bool PERM = true, AFTER_DRAIN = false, BMAP64 = true;
    bf16* U; const long long* st; const float* c1; const float* c2;
    __device__ __forceinline__ void operator()(const f32x4 (&acc)[2][2][4][2], const Unit& u, int wr, int wc, int fr, int fq) const {
        const int row0 = u.pm * 256 + wr * 64 + fr, col0 = u.pn * 256 + wc * 64 + 8 * fq, odd = fr & 1;
        bf16* Ut = U + ((size_t)u.pm * (DFF / 64) + 4 * u.pn + wc) * (256 * 64) + (unsigned)(wr * 64) * 64u + 32 * odd + 8 * fq;
        f32x2 sr[2][4];
#pragma unroll
        for (int ai = 0; ai < 2; ++ai)
#pragma unroll
            for (int m = 0; m < 4; ++m) sr[ai][m] = ln_stats(st, row0 + ai * 128 + m * 16);
        f32x4 cc[2][4];
#pragma unroll
        for (int bj = 0; bj < 2; ++bj) { cc[bj][0] = *(const f32x4*)(c1 + col0 + bj * 32); cc[bj][1] = *(const f32x4*)(c1 + col0 + bj * 32 + 4); cc[bj][2] = *(const f32x4*)(c2 + col0 + bj * 32); cc[bj][3] = *(const f32x4*)(c2 + col0 + bj * 32 + 4); }
#pragma unroll
        for (int bj = 0; bj < 2; ++bj)
#pragma unroll
            for (int i = 0; i < 4; ++i) asm volatile("" : "+v"(cc[bj][i]));
#pragma unroll
        for (int ai = 0; ai < 2; ++ai)
#pragma unroll
            for (int m = 0; m < 4; ++m) { u32x4 w[2];
#pragma unroll
                for (int bj = 0; bj < 2; ++bj) {
                    f32x4 v0 = (acc[ai][bj][m][0] - cc[bj][0] * sr[ai][m][0]) * sr[ai][m][1] + cc[bj][2], v1 = (acc[ai][bj][m][1] - cc[bj][1] * sr[ai][m][0]) * sr[ai][m][1] + cc[bj][3];
#pragma unroll
                    for (int j = 0; j < 4; ++j) { const float a = fmaxf(v0[j], 0.f), b = fmaxf(v1[j], 0.f); v0[j] = a * a; v1[j] = b * b; }
                    w[bj].x = pk2(v0[0], v0[1]); w[bj].y = pk2(v0[2], v0[3]); w[bj].z = pk2(v1[0], v1[1]); w[bj].w = pk2(v1[2], v1[3]); }
                const u32x4 snd = odd ? w[0] : w[1]; u32x4 rcv;
                rcv.x = (unsigned)__builtin_amdgcn_mov_dpp((int)snd.x, 0xB1, 0xF, 0xF, true); rcv.y = (unsigned)__builtin_amdgcn_mov_dpp((int)snd.y, 0xB1, 0xF, 0xF, true);
                rcv.z = (unsigned)__builtin_amdgcn_mov_dpp((int)snd.z, 0xB1, 0xF, 0xF, true); rcv.w = (unsigned)__builtin_amdgcn_mov_dpp((int)snd.w, 0xB1, 0xF, 0xF, true);
                const u32x4 s1 = odd ? rcv : w[0], s2 = odd ? w[1] : rcv;
                bf16* rp = Ut + (unsigned)(ai * 128 + m * 16 + (fr & ~1)) * 64u;
                __builtin_nontemporal_store(s1, (u32x4*)rp); __builtin_nontemporal_store(s2, (u32x4*)(rp + 64)); }
    }
};
struct EpiPle {
    static constexpr bool PERM = true, AFTER_DRAIN = false, BMAP64 = false;
    bf16* C;
    __device__ __forceinline__ void operator()(const f32x4 (&acc)[2][2][4][2], const Unit& u, int wr, int wc, int fr, int fq) const {
        const int tidp = ((wr * 4 + wc) * 64 + fq * 16 + fr) & 511;
#pragma unroll
        for (int ai = 0; ai < 2; ++ai)
#pragma unroll
            for (int m = 0; m < 4; ++m)
#pragma unroll
                for (int bj = 0; bj < 2; ++bj) { const f32x4 v0 = acc[ai][bj][m][0], v1 = acc[ai][bj][m][1]; u32x4 w; w.x = pk2(v0[0], v0[1]); w.y = pk2(v0[2], v0[3]); w.z = pk2(v1[0], v1[1]); w.w = pk2(v1[2], v1[3]);
                    tp_base((u32x4*)C, u.pm, u.pn, DM / 256, 16, (ai * 4 + m) * 2 + bj)[tidp] = w; }
    }
};
struct EpiFinal {
    static constexpr bool PERM = true, AFTER_DRAIN = false, BMAP64 = false;
    const bf16* PLEp; const bf16* t2p; float* out; const long long* st; const float* g; const float* b; const float* c1; const float* c2;
    __device__ __forceinline__ void operator()(const f32x4 (&acc)[2][2][4][2], const Unit& u, int wr, int wc, int fr, int fq) const {
        const int row0 = u.pm * 256 + wr * 64 + fr, col0 = u.pn * 256 + wc * 32 + 8 * fq, tidp = ((wr * 4 + wc) * 64 + fq * 16 + fr) & 511;
        f32x2 sr[2][4];
#pragma unroll
        for (int ai = 0; ai < 2; ++ai)
#pragma unroll
            for (int m = 0; m < 4; ++m) sr[ai][m] = ln_stats(st, row0 + ai * 128 + m * 16);
#pragma unroll
        for (int bj = 0; bj < 2; ++bj) { const int co = col0 + bj * 128; f32x4 gg[2], bb[2], cc1[2], cc2[2];
#pragma unroll
            for (int n = 0; n < 2; ++n) { gg[n] = *(const f32x4*)(g + co + 4 * n); bb[n] = *(const f32x4*)(b + co + 4 * n); cc1[n] = *(const f32x4*)(c1 + co + 4 * n); cc2[n] = *(const f32x4*)(c2 + co + 4 * n); }
#pragma unroll
            for (int ai = 0; ai < 2; ++ai)
#pragma unroll
                for (int m = 0; m < 4; ++m) { const int row = row0 + ai * 128 + m * 16; const f32x2 s_ = sr[ai][m];
                    const u32x4 pw = tp_base((const u32x4*)PLEp, u.pm, u.pn, DM / 256, 16, (ai * 4 + m) * 2 + bj)[tidp];
                    const f32x4 pl[2] = {{bflo(pw.x), bfhi(pw.x), bflo(pw.y), bfhi(pw.y)}, {bflo(pw.z), bfhi(pw.z), bflo(pw.w), bfhi(pw.w)}};
                    const u32x4 tw = tp_base((const u32x4*)t2p, u.pm, u.pn, DM / 256, 16, (ai * 4 + m) * 2 + bj)[tidp];
                    const f32x4 tv[2] = {{bflo(tw.x), bfhi(tw.x), bflo(tw.y), bfhi(tw.y)}, {bflo(tw.z), bfhi(tw.z), bflo(tw.w), bfhi(tw.w)}};
#pragma unroll
                    for (int n = 0; n < 2; ++n) { const f32x4 t2 = tv[n];
                        const f32x4 h = (t2 - s_[0]) * s_[1] * gg[n] + bb[n], a = (acc[ai][bj][m][n] - cc1[n] * s_[0]) * s_[1] + cc2[n];
                        f32x4 o; o[0] = h[0] + sigmoidf_(a[0]) * pl[n][0]; o[1] = h[1] + sigmoidf_(a[1]) * pl[n][1]; o[2] = h[2] + sigmoidf_(a[2]) * pl[n][2]; o[3] = h[3] + sigmoidf_(a[3]) * pl[n][3];
                        *(f32x4*)(out + (size_t)row * DM + co + 4 * n) = o; }
                    asm volatile("" ::: "memory"); } }
    }
};

template <bool FOLD> __device__ __forceinline__ void p0_transpose_item(const float* W, int K, int N, bf16* WT, int kb, int nb, int mode, int lane, const float* gf = nullptr, const float* bfv = nullptr, long long* c1 = nullptr, long long* c2 = nullptr) {
    int lane_ = lane; asm volatile("" : "+v"(lane_));
    const int kg = lane_ & 7, nq = lane_ >> 3, k0 = 64 * kb + 8 * kg, ns = 32 * nb + 4 * nq;
    const float* src = W + (size_t)k0 * N + ns;
    f32x4 v[8];
#pragma unroll
    for (int j = 0; j < 8; ++j) v[j] = __builtin_nontemporal_load((const f32x4*)(src + (size_t)j * N));
    f32x4 a1 = {0.f, 0.f, 0.f, 0.f}, a2 = {0.f, 0.f, 0.f, 0.f};
    if (FOLD) {
#pragma unroll
        for (int j = 0; j < 8; ++j) { const float gk = gf[k0 + j], bk = bfv[k0 + j]; a2 += v[j] * bk; v[j] = v[j] * gk; } }
    int drow = ns, dstep = 1;
    if (mode != 0) { const int HW = (mode == 1) ? 128 : 64, half = HW >> 1, hbase = ns & ~(HW - 1), d = ns & (HW - 1), t = d >= half ? 1 : 0, i = d - half * t; drow = hbase + 2 * i + t; dstep = 2; }
#pragma unroll
    for (int c = 0; c < 4; ++c) { u32x4 o; o.x = pk2(v[0][c], v[1][c]); o.y = pk2(v[2][c], v[3][c]); o.z = pk2(v[4][c], v[5][c]); o.w = pk2(v[6][c], v[7][c]);
        if (FOLD) a1[c] = ((bflo(o.x) + bfhi(o.x)) + (bflo(o.y) + bfhi(o.y))) + ((bflo(o.z) + bfhi(o.z)) + (bflo(o.w) + bfhi(o.w)));
        __builtin_nontemporal_store(o, (u32x4*)(WT + (size_t)(drow + c * dstep) * K + k0)); }
    if (FOLD) {
#pragma unroll
        for (int o = 1; o < 8; o <<= 1) {
#pragma unroll
            for (int c = 0; c < 4; ++c) { a1[c] += __shfl_xor(a1[c], o); a2[c] += __shfl_xor(a2[c], o); } }
        if (kg == 0) {
#pragma unroll
            for (int c = 0; c < 4; ++c) { fx_add(c1 + ns + c, a1[c]); fx_add(c2 + ns + c, a2[c]); } }
    }
}
__device__ __forceinline__ void p0_transpose_item_f8(const float* W, int K, int N, f8* WT, int kb, int nb, int mode, float scale, int lane) {
    const int kg = lane & 7, nq = lane >> 3, k0 = 128 * kb + 16 * kg, ns = 32 * nb + 4 * nq;
    const float* src = W + (size_t)k0 * N + ns;
    f32x4 v[16];
#pragma unroll
    for (int j = 0; j < 16; ++j) v[j] = __builtin_nontemporal_load((const f32x4*)(src + (size_t)j * N)) * scale;
    int drow = ns, dstep = 1;
    if (mode != 0) { const int HW = (mode == 1) ? 128 : 64, half = HW >> 1, hbase = ns & ~(HW - 1), d = ns & (HW - 1), t = d >= half ? 1 : 0, i = d - half * t; drow = hbase + 2 * i + t; dstep = 2; }
#pragma unroll
    for (int c = 0; c < 4; ++c) { u32x4 o; o.x = pk4f8(v[0][c], v[1][c], v[2][c], v[3][c]); o.y = pk4f8(v[4][c], v[5][c], v[6][c], v[7][c]); o.z = pk4f8(v[8][c], v[9][c], v[10][c], v[11][c]); o.w = pk4f8(v[12][c], v[13][c], v[14][c], v[15][c]);
        __builtin_nontemporal_store(o, (u32x4*)(WT + (size_t)(drow + c * dstep) * K + k0)); }
}
struct CvDesc { const float* W; unsigned char* WT; int K, N, kb, nb, kind  , mode; float scale; const float* gf; const float* bfv; long long* c1; long long* c2; };
__device__ __forceinline__ void cv_issue(const CvDesc& d, LAS unsigned char* slot, int lane) {
    const float* src = d.W + (size_t)(64 * d.kb + (lane >> 3)) * d.N + 32 * d.nb + 4 * (lane & 7);
#pragma unroll
    for (int j = 0; j < 8; ++j) __builtin_amdgcn_global_load_lds((const unsigned*)(src + (size_t)(8 * j) * d.N), (LAS unsigned*)(slot + j * CV_CH), 16, 0, 2);
}
__device__ __forceinline__ void cv_finish(const CvDesc& d, const LAS unsigned char* slot, int lane) {
    const int kg = lane & 7, nq = lane >> 3, k0 = 64 * d.kb + 8 * kg, ns = 32 * d.nb + 4 * nq;
    f32x4 v[8];
#pragma unroll
    for (int j = 0; j < 8; ++j) v[j] = *(const LAS f32x4*)(slot + kg * CV_CH + j * 128 + nq * 16);
    int drow = ns, dstep = 1;
    if (d.mode != 0) { const int HW = (d.mode == 1) ? 128 : 64, half = HW >> 1, hbase = ns & ~(HW - 1), dd = ns & (HW - 1), t = dd >= half ? 1 : 0, i = dd - half * t; drow = hbase + 2 * i + t; dstep = 2; }
    if (d.kind == 4) {
        const float sc = d.scale; unsigned char* wt = d.WT;
#pragma unroll
        for (int c = 0; c < 4; ++c) __builtin_nontemporal_store(pk8f4(v[0][c] * sc, v[1][c] * sc, v[2][c] * sc, v[3][c] * sc, v[4][c] * sc, v[5][c] * sc, v[6][c] * sc, v[7][c] * sc), (unsigned*)(wt + toff(drow + c * dstep, k0 >> 1, d.K >> 1)));
    } else if (d.kind == 3) {
        const float sc = d.scale, isc = 1.0f / d.scale; unsigned char* wt = d.WT; f32x4 a1 = {0.f, 0.f, 0.f, 0.f}, a2 = {0.f, 0.f, 0.f, 0.f};
#pragma unroll
        for (int j = 0; j < 8; ++j) { const float gk = d.gf[k0 + j], bk = d.bfv[k0 + j]; a2 += v[j] * bk; v[j] = v[j] * (gk * sc);
#pragma unroll
            for (int c = 0; c < 4; ++c) { v[j][c] = __builtin_rintf(__builtin_amdgcn_fmed3f(v[j][c], -127.f, 127.f)); a1[c] += v[j][c]; } }
#pragma unroll
        for (int c = 0; c < 4; ++c) { u32x2 o; o.x = pk4i8(v[0][c], v[1][c], v[2][c], v[3][c]); o.y = pk4i8(v[4][c], v[5][c], v[6][c], v[7][c]);
            __builtin_nontemporal_store(o, (u32x2*)(wt + toff(drow + c * dstep, k0, d.K))); }
#pragma unroll
        for (int o = 1; o < 8; o <<= 1) {
#pragma unroll
            for (int c = 0; c < 4; ++c) { a1[c] += __shfl_xor(a1[c], o); a2[c] += __shfl_xor(a2[c], o); } }
        if (kg == 0) {
#pragma unroll
            for (int c = 0; c < 4; ++c) { fx_add(d.c1 + ns + c, a1[c] * isc); fx_add(d.c2 + ns + c, a2[c]); } }
    } else if (d.kind == 2) {
        const float sc = d.scale; unsigned char* wt = d.WT;
#pragma unroll
        for (int c = 0; c < 4; ++c) { u32x2 o; o.x = pk4f8(v[0][c] * sc, v[1][c] * sc, v[2][c] * sc, v[3][c] * sc); o.y = pk4f8(v[4][c] * sc, v[5][c] * sc, v[6][c] * sc, v[7][c] * sc);
            __builtin_nontemporal_store(o, (u32x2*)(wt + toff(drow + c * dstep, k0, d.K))); }
    } else {
        unsigned char* wt = d.WT; f32x4 a1 = {0.f, 0.f, 0.f, 0.f}, a2 = {0.f, 0.f, 0.f, 0.f};
        if (d.kind == 1) {
#pragma unroll
            for (int j = 0; j < 8; ++j) { const float gk = d.gf[k0 + j], bk = d.bfv[k0 + j]; a2 += v[j] * bk; v[j] = v[j] * gk; } }
#pragma unroll
        for (int c = 0; c < 4; ++c) { u32x4 o; o.x = pk2(v[0][c], v[1][c]); o.y = pk2(v[2][c], v[3][c]); o.z = pk2(v[4][c], v[5][c]); o.w = pk2(v[6][c], v[7][c]);
            if (d.kind == 1) a1[c] = ((bflo(o.x) + bfhi(o.x)) + (bflo(o.y) + bfhi(o.y))) + ((bflo(o.z) + bfhi(o.z)) + (bflo(o.w) + bfhi(o.w)));
            __builtin_nontemporal_store(o, (u32x4*)(wt + toff(drow + c * dstep, 2 * k0, 2 * d.K))); }
        if (d.kind == 1) {
#pragma unroll
            for (int o = 1; o < 8; o <<= 1) {
#pragma unroll
                for (int c = 0; c < 4; ++c) { a1[c] += __shfl_xor(a1[c], o); a2[c] += __shfl_xor(a2[c], o); } }
            if (kg == 0) {
#pragma unroll
                for (int c = 0; c < 4; ++c) { fx_add(d.c1 + ns + c, a1[c]); fx_add(d.c2 + ns + c, a2[c]); } } }
    }
}
#define CV_RUN(lo_, hi_, cw_, ncw_, DECODE) do { LAS unsigned char* ring_ = L + RING_OFF + wave * CV_WAVE; int it_ = (lo_) + (cw_); \
    if (it_ < (hi_)) { CvDesc dc_ = DECODE(it_); cv_issue(dc_, ring_, lane); int sl_ = 0; \
        for (;;) { const int itn_ = it_ + (ncw_); const bool hn_ = itn_ < (hi_); CvDesc dn_ = dc_; \
            if (hn_) { dn_ = DECODE(itn_); cv_issue(dn_, ring_ + (sl_ ^ 1) * CV_SLOT, lane); asm volatile("s_waitcnt vmcnt(8)" ::: "memory"); } else asm volatile("s_waitcnt vmcnt(0)" ::: "memory"); \
            cv_finish(dc_, ring_ + sl_ * CV_SLOT, lane); asm volatile("s_waitcnt lgkmcnt(0)" ::: "memory"); \
            if (!hn_) break; dc_ = dn_; it_ = itn_; sl_ ^= 1; } } } while (0)
__device__ __forceinline__ void sincos_acc(float a, float& s, float& c) {
    const double x = (double)a, kd = rint(x * 0.63661977236758134308);
    double r = fma(-kd, 1.57079632679489655800e+00, x); r = fma(-kd, 6.12323399573676603587e-17, r);
    const double r2 = r * r;
    const double sp = r * (1.0 + r2 * (-1.0 / 6 + r2 * (1.0 / 120 + r2 * (-1.0 / 5040 + r2 * (1.0 / 362880 + r2 * (-1.0 / 39916800 + r2 * (1.0 / 6227020800.0)))))));
    const double cp = 1.0 + r2 * (-0.5 + r2 * (1.0 / 24 + r2 * (-1.0 / 720 + r2 * (1.0 / 40320 + r2 * (-1.0 / 3628800 + r2 * (1.0 / 479001600 + r2 * (-1.0 / 87178291200.0)))))));
    const int q = (int)kd & 3;
    const double sv = (q == 0) ? sp : (q == 1) ? cp : (q == 2) ? -sp : -cp, cv = (q == 0) ? cp : (q == 1) ? -sp : (q == 2) ? -cp : sp;
    s = (float)sv; c = (float)cv;
}

typedef short bf16x8 __attribute__((ext_vector_type(8)));
typedef short s16x4 __attribute__((ext_vector_type(4)));
typedef float f32x16 __attribute__((ext_vector_type(16)));
#define MFMA32(a, b, c) __builtin_amdgcn_mfma_f32_32x32x16_bf16((a), (b), (c), 0, 0, 0)
__device__ __forceinline__ bf16x8 pack8(const f32x16& p, int o) {
    u32x4 w; w.x = pk2(p[o], p[o + 1]); w.y = pk2(p[o + 2], p[o + 3]); w.z = pk2(p[o + 4], p[o + 5]); w.w = pk2(p[o + 6], p[o + 7]); return __builtin_bit_cast(bf16x8, w);
}
__device__ __forceinline__ bf16x8 cat44(s16x4 lo, s16x4 hi) { return (bf16x8){lo[0], lo[1], lo[2], lo[3], hi[0], hi[1], hi[2], hi[3]}; }
__device__ __forceinline__ float max16(const f32x16& p) {
    float a = fmaxf(fmaxf(p[0], p[1]), fmaxf(p[2], p[3])), b = fmaxf(fmaxf(p[4], p[5]), fmaxf(p[6], p[7])), c = fmaxf(fmaxf(p[8], p[9]), fmaxf(p[10], p[11])), d = fmaxf(fmaxf(p[12], p[13]), fmaxf(p[14], p[15]));
    return fmaxf(fmaxf(a, b), fmaxf(c, d));
}
constexpr int A_KP = 272, A_VP = 136;
constexpr int A_KT = 64 * A_KP, A_VT = 128 * A_VP;
constexpr int A_KM = 2 * (A_KT + A_VT);
__device__ __forceinline__ void moba_unit(int b, int h, int blk, const bf16* QA, const bf16* KA, const bf16* VA, const float* kmp, f8* YA, LAS unsigned char* lds, int tid) {
    const int lane = tid & 63, w = __builtin_amdgcn_readfirstlane(tid >> 6), r32 = lane & 31, hi = lane >> 5;
    const size_t rowb = (size_t)b * SEQ;
    const int qrel = 32 * w + r32;
    __syncthreads();
    LAS float* km = (LAS float*)(lds + A_KM);
    for (int i = tid; i < blk * AD; i += 512) { const int n = i >> 7, d = i & 127; const float* k0p = kmp + (size_t)((b * NBLK + n) * 2) * AW + h * AD + d; km[i] = (k0p[0] + k0p[AW]) * (1.0f / MBLK); }
    bf16x8 qf[8];
    { const bf16* qp = QA + (rowb + blk * MBLK + qrel) * AW + h * AD + 8 * hi;
#pragma unroll
      for (int st = 0; st < 8; ++st) qf[st] = *(const bf16x8*)(qp + 16 * st); }
    const int kkey = tid >> 4, kc = tid & 15;
    const bf16* kgp = KA + (rowb + kkey) * AW + h * AD + 8 * kc;
    const bf16* vgp = VA + (rowb + 2 * kkey) * AW + h * AD + 8 * kc;
    const int kls = kkey * A_KP + kc * 16, vls = (8 * kc) * A_VP + kkey * 4;
    u32x4 kr0, kr1, vr0, vr1;
#define A_LOAD(kbase) do { kr0 = *(const u32x4*)(kgp + (size_t)(kbase) * AW); kr1 = *(const u32x4*)(kgp + (size_t)((kbase) + 32) * AW); \
        vr0 = *(const u32x4*)(vgp + (size_t)(kbase) * AW); vr1 = *(const u32x4*)(vgp + (size_t)((kbase) + 1) * AW); } while (0)
#define A_STORE(buf) do { LAS unsigned char* kb_ = lds + (buf) * (A_KT + A_VT); LAS unsigned char* vb_ = kb_ + A_KT; \
        *(LAS u32x4*)(kb_ + kls) = kr0; *(LAS u32x4*)(kb_ + kls + 32 * A_KP) = kr1; \
        _Pragma("unroll") for (int e_ = 0; e_ < 4; ++e_) { const unsigned a_ = vr0[e_], b_ = vr1[e_]; \
            *(LAS unsigned*)(vb_ + vls + (2 * e_) * A_VP) = (a_ & 0xffffu) | (b_ << 16); *(LAS unsigned*)(vb_ + vls + (2 * e_ + 1) * A_VP) = (a_ >> 16) | (b_ & 0xffff0000u); } } while (0)
    A_LOAD(blk * MBLK); A_STORE(0);
    __syncthreads();
    unsigned sel = (blk <= TOPK) ? ((1u << blk) - 1u) : 0u;
    if (blk > TOPK) {
        float gt[NBLK];
#pragma unroll
        for (int n = 0; n < NBLK; ++n) { float part = 0.f;
            if (n < blk) {
#pragma unroll
                for (int st = 0; st < 8; ++st) { const f32x4 k0 = *(const LAS f32x4*)(km + n * AD + 16 * st + 8 * hi), k1 = *(const LAS f32x4*)(km + n * AD + 16 * st + 8 * hi + 4);
                    const u32x4 qw = __builtin_bit_cast(u32x4, qf[st]);
                    part += bflo(qw.x) * k0[0] + bfhi(qw.x) * k0[1] + bflo(qw.y) * k0[2] + bfhi(qw.y) * k0[3] + bflo(qw.z) * k1[0] + bfhi(qw.z) * k1[1] + bflo(qw.w) * k1[2] + bfhi(qw.w) * k1[3]; } }
            part += __shfl_xor(part, 32);
            gt[n] = (n < blk) ? part : -INFINITY; }
#pragma unroll
        for (int t = 0; t < TOPK; ++t) { float best = -INFINITY; int bi = -1;
#pragma unroll
            for (int n = 0; n < NBLK; ++n) if (gt[n] > best) { best = gt[n]; bi = n; }
            if (bi >= 0) sel |= 1u << bi;
#pragma unroll
            for (int n = 0; n < NBLK; ++n) if (n == bi) gt[n] = -INFINITY; }
    }
    f32x16 o[4];
#pragma unroll
    for (int db = 0; db < 4; ++db) o[db] = (f32x16){0.f, 0.f, 0.f, 0.f, 0.f, 0.f, 0.f, 0.f, 0.f, 0.f, 0.f, 0.f, 0.f, 0.f, 0.f, 0.f};
    float m = -INFINITY, l = 0.f;
    const int NT = 4 * (blk + 1);
    for (int ti = 0; ti < NT; ++ti) {
        const int n = (ti < 4) ? blk : ((ti - 4) >> 2), t = (ti < 4) ? ti : ((ti - 4) & 3);
        const bool more = ti + 1 < NT;
        if (more) { const int n1 = (ti + 1 < 4) ? blk : ((ti - 3) >> 2), t1 = (ti + 1 < 4) ? (ti + 1) : ((ti - 3) & 3); A_LOAD(n1 * MBLK + 64 * t1); }
        const bool own = (n == blk), mine = ((sel >> n) & 1u) != 0u;
        const bool active = own ? (t <= (w >> 1)) : (__any(mine) != 0);
        if (active) {
            const LAS unsigned char* kb = lds + (ti & 1) * (A_KT + A_VT); const LAS unsigned char* vb = kb + A_KT;
            f32x16 s0 = (f32x16){0.f, 0.f, 0.f, 0.f, 0.f, 0.f, 0.f, 0.f, 0.f, 0.f, 0.f, 0.f, 0.f, 0.f, 0.f, 0.f}, s1 = s0;
#pragma unroll
            for (int st = 0; st < 8; ++st) { const bf16x8 a0 = *(const LAS bf16x8*)(kb + r32 * A_KP + (16 * st + 8 * hi) * 2), a1 = *(const LAS bf16x8*)(kb + (32 + r32) * A_KP + (16 * st + 8 * hi) * 2);
                s0 = MFMA32(a0, qf[st], s0); s1 = MFMA32(a1, qf[st], s1); }
            if (own) { if (t == (w >> 1)) {
#pragma unroll
                    for (int r = 0; r < 16; ++r) { const int kr = 64 * t + (r & 3) + 8 * (r >> 2) + 4 * hi; if (kr > qrel) s0[r] = -INFINITY; if (kr + 32 > qrel) s1[r] = -INFINITY; } } }
            else if (!mine) {
#pragma unroll
                for (int r = 0; r < 16; ++r) { s0[r] = -INFINITY; s1[r] = -INFINITY; } }
            float tm = fmaxf(max16(s0), max16(s1)); tm = fmaxf(tm, __shfl_xor(tm, 32));
            const float mn = fmaxf(m, tm), al = __builtin_amdgcn_exp2f(m - mn); m = mn;
            float ls = 0.f;
#pragma unroll
            for (int r = 0; r < 16; ++r) { s0[r] = __builtin_amdgcn_exp2f(s0[r] - mn); s1[r] = __builtin_amdgcn_exp2f(s1[r] - mn); ls += s0[r] + s1[r]; }
            l = l * al + ls;
#pragma unroll
            for (int db = 0; db < 4; ++db) o[db] = o[db] * al;
#pragma unroll
            for (int u = 0; u < 2; ++u)
#pragma unroll
                for (int ks = 0; ks < 2; ++ks) { const bf16x8 pf = pack8(u ? s1 : s0, 8 * ks);
#pragma unroll
                    for (int db = 0; db < 4; ++db) { const LAS unsigned char* vp = vb + (32 * db + r32) * A_VP + (32 * u + 16 * ks + 4 * hi) * 2;
                        o[db] = MFMA32(cat44(*(const LAS s16x4*)vp, *(const LAS s16x4*)(vp + 16)), pf, o[db]); } }
        }
        if (more) A_STORE((ti + 1) & 1);
        __syncthreads();
    }
    l += __shfl_xor(l, 32);
    const float inv = F8S_Y / l;
    f8* yp = YA + toff(rowb + blk * MBLK + qrel, h * AD + 4 * hi, AW);
#pragma unroll
    for (int db = 0; db < 4; ++db)
#pragma unroll
        for (int g = 0; g < 4; ++g) *(unsigned*)(yp + 32 * db + 8 * g) = pk4f8(o[db][4 * g] * inv, o[db][4 * g + 1] * inv, o[db][4 * g + 2] * inv, o[db][4 * g + 3] * inv);
#undef A_LOAD
#undef A_STORE
}
constexpr int B_KP = 144, B_VP = 520;
constexpr int B_KT = 256 * B_KP, B_VT = 64 * B_VP;
__device__ __forceinline__ void swa_unit(int b, int kvh, int qb, const bf16* QB, const bf16* KB, const bf16* VB, const float* sinks, f8* YB, LAS unsigned char* lds, int tid) {
    const int lane = tid & 63, w = __builtin_amdgcn_readfirstlane(tid >> 6), r32 = lane & 31, hi = lane >> 5;
    const size_t rowb = (size_t)b * SEQ; const int band0 = qb * WIN - WIN, hq = kvh * 8 + w;
    __syncthreads();
    LAS unsigned char* ks_ = lds; LAS unsigned char* vs_ = lds + B_KT;
#pragma unroll
    for (int i = 0; i < 4; ++i) { const int p = tid + 512 * i, key = p >> 3, c = p & 7, pos = band0 + key;
        if (pos >= 0) *(LAS u32x4*)(ks_ + key * B_KP + c * 16) = *(const u32x4*)(KB + (rowb + pos) * BKVW + kvh * BD + 8 * c); }
#pragma unroll
    for (int i = 0; i < 2; ++i) { const int p = tid + 512 * i, kp = p >> 3, c = p & 7, pos = band0 + 2 * kp;
        if (pos >= 0) { const u32x4 v0 = *(const u32x4*)(VB + (rowb + pos) * BKVW + kvh * BD + 8 * c), v1 = *(const u32x4*)(VB + (rowb + pos + 1) * BKVW + kvh * BD + 8 * c);
#pragma unroll
            for (int e = 0; e < 4; ++e) { const unsigned a_ = v0[e], b_ = v1[e];
                *(LAS unsigned*)(vs_ + (8 * c + 2 * e) * B_VP + kp * 4) = (a_ & 0xffffu) | (b_ << 16); *(LAS unsigned*)(vs_ + (8 * c + 2 * e + 1) * B_VP + kp * 4) = (a_ >> 16) | (b_ & 0xffff0000u); } } }
    __syncthreads();
    const float sk = sinks[hq] * LOG2E;
    for (int sub = 0; sub < 4; ++sub) {
        const int qrow = qb * WIN + 32 * sub + r32;
        bf16x8 qf[4];
        { const bf16* qp = QB + (rowb + qrow) * 2048 + hq * BD + 8 * hi;
#pragma unroll
          for (int st = 0; st < 4; ++st) qf[st] = *(const bf16x8*)(qp + 16 * st); }
        f32x16 o[2];
        o[0] = (f32x16){0.f, 0.f, 0.f, 0.f, 0.f, 0.f, 0.f, 0.f, 0.f, 0.f, 0.f, 0.f, 0.f, 0.f, 0.f, 0.f}; o[1] = o[0];
        float m = sk, l = (hi == 0) ? 1.0f : 0.0f;
        const int qi = WIN + 32 * sub + r32;
        for (int tt = 0; tt < 5; ++tt) { const int tile = sub + tt;
            if (band0 + 32 * tile < 0) continue;
            f32x16 s = (f32x16){0.f, 0.f, 0.f, 0.f, 0.f, 0.f, 0.f, 0.f, 0.f, 0.f, 0.f, 0.f, 0.f, 0.f, 0.f, 0.f};
#pragma unroll
            for (int st = 0; st < 4; ++st) s = MFMA32(*(const LAS bf16x8*)(ks_ + (32 * tile + r32) * B_KP + (16 * st + 8 * hi) * 2), qf[st], s);
            if (tt == 0 || tt == 4) {
#pragma unroll
                for (int r = 0; r < 16; ++r) { const int ki = 32 * tile + (r & 3) + 8 * (r >> 2) + 4 * hi; if (!(ki <= qi && qi - ki < WIN)) s[r] = -INFINITY; } }
            float tm = max16(s); tm = fmaxf(tm, __shfl_xor(tm, 32));
            const float mn = fmaxf(m, tm), al = __builtin_amdgcn_exp2f(m - mn); m = mn;
            float ls = 0.f;
#pragma unroll
            for (int r = 0; r < 16; ++r) { s[r] = __builtin_amdgcn_exp2f(s[r] - mn); ls += s[r]; }
            l = l * al + ls; o[0] = o[0] * al; o[1] = o[1] * al;
#pragma unroll
            for (int ks = 0; ks < 2; ++ks) { const bf16x8 pf = pack8(s, 8 * ks);
#pragma unroll
                for (int db = 0; db < 2; ++db) { const LAS unsigned char* vp = vs_ + (32 * db + r32) * B_VP + (32 * tile + 16 * ks + 4 * hi) * 2;
                    o[db] = MFMA32(cat44(*(const LAS s16x4*)vp, *(const LAS s16x4*)(vp + 16)), pf, o[db]); } }
        }
        l += __shfl_xor(l, 32);
        const float inv = F8S_Y / l;
        f8* yp = YB + toff(rowb + qrow, hq * BD + 4 * hi, 2048);
#pragma unroll
        for (int db = 0; db < 2; ++db)
#pragma unroll
            for (int g = 0; g < 4; ++g) *(unsigned*)(yp + 32 * db + 8 * g) = pk4f8(o[db][4 * g] * inv, o[db][4 * g + 1] * inv, o[db][4 * g + 2] * inv, o[db][4 * g + 3] * inv);
    }
}

struct Args { const float* in[16]; float* out; unsigned char* ws; float invf[64]; int ph_lo, ph_hi; };
__global__ void __launch_bounds__(NWAVES * 64, 2) mk_fwd(Args args) {
    extern __shared__ __attribute__((aligned(16))) unsigned char lds[];
    LAS unsigned char* L = (LAS unsigned char*)lds;
    volatile LAS unsigned* MISC = (volatile LAS unsigned*)(L + MISC_OFF);
    const int tid = threadIdx.x, lane = tid & 63, wave = __builtin_amdgcn_readfirstlane(tid >> 6);
    const int G = gridDim.x, bx = blockIdx.x;
    const int gw = bx * NWAVES + wave, NGW = G * NWAVES;
    unsigned char* ws = args.ws;
    const int lo = args.ph_lo, hi = args.ph_hi;
    for (int u = tid; u < (LDS_BYTES - LDSCTL_OFF) / 4; u += NWAVES * 64) ((LAS unsigned*)(L + LDSCTL_OFF))[u] = 0u;
    __syncthreads();
    XcdBarrier bar; bar.bar = (unsigned*)(ws + WS_CTL) + CW_BAR; bar.x = 0; bar.st = nullptr;
    if (hi - lo > 1) bar = xcd_barrier_post((unsigned*)(ws + WS_CTL) + CW_BAR, MISC + 8);
#ifndef MK_PHASE_MASK
#define MK_PHASE_MASK 0x3ff
#endif
#define IN(k) (((MK_PHASE_MASK >> (k)) & 1) && lo <= (k) && (k) < hi)
#define SEAM(k) do { if (IN(k) && IN((k) + 1)) xcd_barrier(bar); } while (0)
    const float* x = args.in[0];
    bf16* XB = (bf16*)(ws + WS_XB); bf16* PB = (bf16*)(ws + WS_PB);

    if (IN(0)) {
        for (int t = bx * (NWAVES * 64) + tid; t < SEQ * 64; t += G * NWAVES * 64) { const int pos = t >> 6, i = t & 63;
            const float ang = (float)pos * args.invf[i]; float s, c; sincos_acc(ang, s, c);
            ((f32x2*)(ws + WS_TABA))[t] = (f32x2){c, s};
            if ((i & 1) == 0) ((f32x2*)(ws + WS_TABB))[pos * 32 + (i >> 1)] = (f32x2){c, s}; }
        constexpr int I_IN = (DM / 64) * (NIN / 32), I_PL0 = (PLE / 64) * (DM / 32);
        auto dec0 = [&](int it) { CvDesc d{}; d.scale = 1.f;
            if (it < I_IN) { const int nblk = NIN / 32, n0 = 32 * (it % nblk); d.W = args.in[2]; d.WT = ws + WS_WIN; d.K = DM; d.N = NIN; d.kb = it / nblk; d.nb = it % nblk; d.kind = 2; d.scale = F8S_WIN;
                if (n0 < 2 * AW || (n0 >= 3 * AW && n0 < 3 * AW + 2048) || n0 >= 8704) { d.kind = 4; d.scale = F4S_WG; d.WT = ws + WS_WG4; }
                d.mode = (n0 < 2 * AW) ? 1 : (n0 < 3 * AW) ? 0 : (n0 < 3 * AW + 2048 + BKVW) ? 2 : 0; }
            else { const int r = it - I_IN; d.W = args.in[14]; d.WT = ws + WS_WPLE; d.K = PLE; d.N = DM; d.kb = r / (DM / 32); d.nb = r % (DM / 32); d.kind = 0; d.mode = 0; }
            return d; };
        CV_RUN(0, I_IN + I_PL0, gw, NGW, dec0);
        { const size_t nthr = (size_t)G * NWAVES * 64, t0 = (size_t)bx * (NWAVES * 64) + tid;
#define CVT_ROWS(SRC, DST, NCH) for (size_t c = t0; c < (size_t)(NCH); c += 4 * nthr) { f32x4 a_[4], b_[4]; \
              _Pragma("unroll") for (int q = 0; q < 4; ++q) { const size_t cc = c + q * nthr; if (cc < (size_t)(NCH)) { a_[q] = __builtin_nontemporal_load((const f32x4*)(SRC) + 2 * cc); b_[q] = __builtin_nontemporal_load((const f32x4*)(SRC) + 2 * cc + 1); } } \
              _Pragma("unroll") for (int q = 0; q < 4; ++q) { const size_t cc = c + q * nthr; if (cc < (size_t)(NCH)) { u32x4 w; w.x = pk2(a_[q][0], a_[q][1]); w.y = pk2(a_[q][2], a_[q][3]); w.z = pk2(b_[q][0], b_[q][1]); w.w = pk2(b_[q][2], b_[q][3]); ((u32x4*)(DST))[cc] = w; } } }
          for (size_t c = t0; c < (size_t)M * DM / 16; c += nthr) { const f32x4* xp = (const f32x4*)x + 4 * c; f32x4 a_[4];
#pragma unroll
              for (int q = 0; q < 4; ++q) a_[q] = __builtin_nontemporal_load(xp + q) * F8S_X;
              u32x4 w; w.x = pk4f8(a_[0][0], a_[0][1], a_[0][2], a_[0][3]); w.y = pk4f8(a_[1][0], a_[1][1], a_[1][2], a_[1][3]); w.z = pk4f8(a_[2][0], a_[2][1], a_[2][2], a_[2][3]); w.w = pk4f8(a_[3][0], a_[3][1], a_[3][2], a_[3][3]);
              ((u32x4*)XB)[c] = w;
              const float r4 = F4S_X / F8S_X; u32x2 w4;
              w4.x = pk8f4(a_[0][0] * r4, a_[0][1] * r4, a_[0][2] * r4, a_[0][3] * r4, a_[1][0] * r4, a_[1][1] * r4, a_[1][2] * r4, a_[1][3] * r4);
              w4.y = pk8f4(a_[2][0] * r4, a_[2][1] * r4, a_[2][2] * r4, a_[2][3] * r4, a_[3][0] * r4, a_[3][1] * r4, a_[3][2] * r4, a_[3][3] * r4);
              ((u32x2*)(ws + WS_XB4))[c] = w4; }
          CVT_ROWS(args.in[1], PB, (size_t)M * PLE / 8);
#undef CVT_ROWS
        }
        VM_WAIT(); __syncthreads();
    }
    SEAM(0);
    if (IN(1)) {
        const bf16* WIN = (const bf16*)(ws + WS_WIN); const float* tabA = (const float*)(ws + WS_TABA); const float* tabB = (const float*)(ws + WS_TABB);
#define P1_CALL(MODE, nrow0, ncols, ...) do { pg8::Gemm g{XB, WIN + (size_t)(nrow0) * (DM / 2), M, (ncols), DM / 2, 1.0f / (F8S_X * F8S_WIN)}; pg8::StaticOrder S; S.init(M, (ncols), G, bx); \
            EpiZ<MODE> E{__VA_ARGS__}; pg8::gemm_phase<EpiZ<MODE>, pg8::StaticOrder, true, true, 1, NST_ALL>(L + RING_OFF, g, S, E); } while (0)
#define P1_CALL4(MODE, CH, nrow0, ncols, nx_nrow0, nx_ncols, ...) do { const char* chA_ = nullptr; const char* chB_ = nullptr; \
            if ((CH) & 2) { pg8::StaticOrder S2; S2.init(M, (nx_ncols), G, bx); pg8::Unit u2{0, 0}; S2.next(0, u2); const size_t ts_ = (size_t)256 * (DM / 4) * 2;        \
                chA_ = (const char*)(ws + WS_XB4) + (size_t)u2.pm * ts_; chB_ = (const char*)(ws + WS_WG4) + (size_t)(nx_nrow0) * (DM / 2) + (size_t)u2.pn * ts_; } \
            pg8::Gemm g{(const bf16*)(ws + WS_XB4), (const bf16*)(ws + WS_WG4) + (size_t)(nrow0) * (DM / 4), M, (ncols), DM / 4, 1.0f / (F4S_X * F4S_WG)}; pg8::StaticOrder S; S.init(M, (ncols), G, bx); \
            EpiZ<MODE> E{__VA_ARGS__}; pg8::gemm_phase<EpiZ<MODE>, pg8::StaticOrder, true, true, 3, NST_ALL, false, false, CH>(L + RING_OFF, g, S, E, chA_, chB_); } while (0)
        P1_CALL(0, 4096, 2048, (bf16*)(ws + WS_VA), nullptr, AW, 1.0f, nullptr, nullptr, nullptr);
#define P1_FP4(C1, C2, C3, C4) do { \
        P1_CALL4(1, C1, 0,    2048, 2048, 2048, (bf16*)(ws + WS_QA), nullptr, AW, QSCALE_A, tabA, nullptr, nullptr);                          \
        P1_CALL4(2, C2, 2048, 2048, 6144, 2048, (bf16*)(ws + WS_KA), nullptr, AW, 1.0f, tabA, nullptr, (float*)(ws + WS_KMP));                \
        P1_CALL4(3, C3, 6144, 2048, 8704, 8192, (bf16*)(ws + WS_QB), nullptr, 2048, QSCALE_B, tabB, nullptr, nullptr);                        \
        P1_CALL4(4, C4, 8704, 8192, 0, 2048, (bf16*)(ws + WS_GA), (bf16*)(ws + WS_GB), DM, 1.0f, nullptr, args.in[3], nullptr); } while (0)
        if (G <= 256) P1_FP4(2, 3, 3, 1); else P1_FP4(0, 0, 0, 0);
#undef P1_FP4
#undef P1_CALL4
        constexpr int TAILW = (M / 256) * (512 / 256);
        if (bx < TAILW || G <= TAILW) { P1_CALL(5, 8192, 512, (bf16*)(ws + WS_KB), (bf16*)(ws + WS_VB), BKVW, 1.0f, tabB, nullptr, nullptr);
            pg8::Gemm g{PB, (const bf16*)(ws + WS_WPLE), M, DM, PLE}; pg8::StaticOrder S; S.init(M, DM, (G <= TAILW) ? G : TAILW, bx);
            EpiPle E{(bf16*)(ws + WS_PLE)};
            pg8::gemm_phase<EpiPle, pg8::StaticOrder, true, true, 0, NST_ALL>(L + RING_OFF, g, S, E); }
#undef P1_CALL
        if (bx >= TAILW || G <= TAILW) {
            constexpr int I_UP = (AW / 64) * (DM / 32), I_O = (DM / 64) * (DM / 32), I_FU = (DM / 64) * (DFF / 32), I_FD = (DFF / 64) * (DM / 32);
            constexpr int NREST = 2 * I_UP + I_O + I_FU + I_FD + I_O;
            const int gw2 = (G <= TAILW) ? gw : (bx - TAILW) * NWAVES + wave, NGW2 = (G <= TAILW) ? NGW : (G - TAILW) * NWAVES;
            auto decr = [&](int it) { CvDesc d{}; d.scale = 1.f; d.mode = 0; int r = it;
                if (r < I_UP) { d.W = args.in[5]; d.WT = ws + WS_WUPA; d.K = AW; d.N = DM; d.kb = r / (DM / 32); d.nb = r % (DM / 32); d.kind = 2; d.scale = F8S_WUP; return d; } r -= I_UP;
                if (r < I_UP) { d.W = args.in[6]; d.WT = ws + WS_WUPB; d.K = AW; d.N = DM; d.kb = r / (DM / 32); d.nb = r % (DM / 32); d.kind = 2; d.scale = F8S_WUP; return d; } r -= I_UP;
                if (r < I_O)  { d.W = args.in[7]; d.WT = ws + WS_WO; d.K = DM; d.N = DM; d.kb = r / (DM / 32); d.nb = r % (DM / 32); d.kind = 2; d.scale = F8S_WO; return d; } r -= I_O;
                if (r < I_FU) { d.W = args.in[10]; d.WT = ws + WS_WFFUP; d.K = DM; d.N = DFF; d.kb = r / (DFF / 32); d.nb = r % (DFF / 32); d.kind = 1; d.gf = args.in[8]; d.bfv = args.in[9]; d.c1 = (long long*)(ws + CB_C1F); d.c2 = (long long*)(ws + CB_C2F); return d; } r -= I_FU;
                if (r < I_FD) { d.W = args.in[11]; d.WT = ws + WS_WFFDN; d.K = DFF; d.N = DM; d.kb = r / (DM / 32); d.nb = r % (DM / 32); d.kind = 0; return d; } r -= I_FD;
                d.W = args.in[15]; d.WT = ws + WS_WPLEG; d.K = DM; d.N = DM; d.kb = r / (DM / 32); d.nb = r % (DM / 32); d.kind = 3; d.scale = I8S_WG; d.gf = args.in[12]; d.bfv = args.in[13]; d.c1 = (long long*)(ws + CB_C1G); d.c2 = (long long*)(ws + CB_C2G); return d; };
            CV_RUN(0, NREST, gw2, NGW2, decr);
            VM_WAIT(); __syncthreads();
        }
    }
    SEAM(1);
    if (IN(2)) {
        { float* cf = (float*)(ws + WS_CF32); const int t = bx * (NWAVES * 64) + tid, T = G * NWAVES * 64;
          for (int i = t; i < 2 * DFF + 2 * DM; i += T) { const long long* srcp = (i < DFF) ? (const long long*)(ws + CB_C1F) + i : (i < 2 * DFF) ? (const long long*)(ws + CB_C2F) + (i - DFF)
                  : (i < 2 * DFF + DM) ? (const long long*)(ws + CB_C1G) + (i - 2 * DFF) : (const long long*)(ws + CB_C2G) + (i - 2 * DFF - DM);
              cf[i] = (float)((double)*srcp * (1.0 / 4294967296.0)); } }
        const int vcu = (G % 8 == 0) ? (bx % 8) * (G / 8) + bx / 8 : bx;
        for (int it = vcu; it < BATCH * AHEADS * 4; it += G) { const int bh = it >> 2, sidx = it & 3;
#pragma unroll 1
            for (int k = 0; k < 2; ++k) moba_unit(bh >> 4, bh & 15, k ? sidx : 7 - sidx, (const bf16*)(ws + WS_QA), (const bf16*)(ws + WS_KA), (const bf16*)(ws + WS_VA), (const float*)(ws + WS_KMP), (f8*)(ws + WS_YA), L + RING_OFF, tid); }
#pragma unroll 1
        for (int it = vcu; it < BATCH * BKVH * (SEQ / WIN); it += G) swa_unit(it >> 6, (it >> 4) & 3, it & 15, (const bf16*)(ws + WS_QB), (const bf16*)(ws + WS_KB), (const bf16*)(ws + WS_VB), args.in[4], (f8*)(ws + WS_YB), L + RING_OFF, tid);
        VM_WAIT(); __syncthreads();
    }
    SEAM(2);
    if (IN(3)) {
        pg8::Gemm g{(const bf16*)(ws + WS_YA), (const bf16*)(ws + WS_WUPA), M, DM, AW / 2, 1.0f / (F8S_Y * F8S_WUP), (const bf16*)(ws + WS_YB), (const bf16*)(ws + WS_WUPB)}; pg8::StaticOrder S; S.init(M, DM, G, bx);
        EpiMG E{(const bf16*)(ws + WS_GA), (const bf16*)(ws + WS_GB), (f8*)(ws + WS_MG)};
        pg8::gemm_phase<EpiMG, pg8::StaticOrder, true, true, 1, NST_ALL, true, true>(L + RING_OFF, g, S, E);
    }
    SEAM(3);
    if (IN(4)) {
        pg8::Gemm g{(const bf16*)(ws + WS_MG), (const bf16*)(ws + WS_WO), M, DM, DM / 2, 1.0f / (F8S_MG * F8S_WO)}; pg8::StaticOrder S; S.init(M, DM, G, bx);
        EpiRes<false> E{x, nullptr, (bf16*)(ws + WS_H1B), nullptr, nullptr, nullptr, (long long*)(ws + CB_ST1)};
        pg8::gemm_phase<EpiRes<false>, pg8::StaticOrder, true, true, 1, NST_ALL, true>(L + RING_OFF, g, S, E);
    }
    do { if (IN(4) && IN(6)) xcd_barrier(bar); } while (0);
    if (IN(6)) {
        pg8::Gemm g{(const bf16*)(ws + WS_H1B), (const bf16*)(ws + WS_WFFUP), M, DFF, DM}; pg8::StaticOrder S; S.init(M, DFF, G, bx);
        EpiU E{(bf16*)(ws + WS_U), (const long long*)(ws + CB_ST1), (const float*)(ws + WS_CF32), (const float*)(ws + WS_CF32) + DFF};
        pg8::gemm_phase<EpiU, pg8::StaticOrder, true, true, 0, NST_ALL, true>(L + RING_OFF, g, S, E);
    }
    SEAM(6);
    if (IN(7)) {
        pg8::Gemm g{(const bf16*)(ws + WS_U), (const bf16*)(ws + WS_WFFDN), M, DM, DFF}; pg8::StaticOrder S; S.init(M, DM, G, bx);
        EpiRes<true> E{(const void*)(ws + WS_H1B), (bf16*)(ws + WS_T12), (bf16*)(ws + WS_H2B), (const long long*)(ws + CB_ST1), args.in[8], args.in[9], (long long*)(ws + CB_ST2)};
        pg8::gemm_phase<EpiRes<true>, pg8::StaticOrder, true, true, 0, NST_ALL, true>(L + RING_OFF, g, S, E);
    }
    do { if (IN(7) && IN(9)) xcd_barrier(bar); } while (0);
    if (IN(9)) {
        { pg8::Gemm g{(const bf16*)(ws + WS_H2B), (const bf16*)(ws + WS_WPLEG), M, DM, DM / 2, 1.0f / (I8S_T2 * I8S_WG)}; pg8::StaticOrder S; S.init(M, DM, G, bx);
          EpiFinal E{(const bf16*)(ws + WS_PLE), (const bf16*)(ws + WS_T12), args.out, (const long long*)(ws + CB_ST2), args.in[12], args.in[13], (const float*)(ws + WS_CF32) + 2 * DFF, (const float*)(ws + WS_CF32) + 2 * DFF + DM};
          pg8::gemm_phase<EpiFinal, pg8::StaticOrder, true, true, 2, NST_ALL, true>(L + RING_OFF, g, S, E); }
    }
#undef IN
#undef SEAM
}

#ifndef MK_PER_PHASE
#define MK_PER_PHASE 0
#endif
extern "C" void kernel_launch(void* const* d_in, const int* in_sizes, int n_in, void* d_out, int out_size, void* d_ws, size_t ws_size, hipStream_t stream) {
    static int grid = 0;
    if (grid == 0) {
        if (n_in != 16 || in_sizes[0] != M * DM || out_size != M * DM || ws_size < WS_END) { fprintf(stderr, "kernel_launch: unexpected shapes (n_in %d, in0 %d, out %d, ws %zu < %zu); nothing launched\n", n_in, n_in > 0 ? in_sizes[0] : -1, out_size, ws_size, (size_t)WS_END); grid = -1; return; }
        int dev = 0, cus = 0, per_cu = 0;
        if (hipGetDevice(&dev) != hipSuccess || hipDeviceGetAttribute(&cus, hipDeviceAttributeMultiprocessorCount, dev) != hipSuccess) { grid = -1; return; }
        if (hipFuncSetAttribute((const void*)mk_fwd, hipFuncAttributeMaxDynamicSharedMemorySize, LDS_BYTES) != hipSuccess) { fprintf(stderr, "kernel_launch: hipFuncSetAttribute failed\n"); grid = -1; return; }
        if (hipOccupancyMaxActiveBlocksPerMultiprocessor(&per_cu, (const void*)mk_fwd, NWAVES * 64, LDS_BYTES) != hipSuccess || per_cu < 1) fprintf(stderr, "kernel_launch: occupancy query reports %d workgroups per CU\n", per_cu);
        (void)hipGetLastError();
        grid = cus;
    }
    if (grid < 0) return;
    if (hipMemsetAsync((char*)d_ws + WS_CTL, 0, CTL_ZERO_BYTES, stream) != hipSuccess) return;
    Args a{};
    for (int i = 0; i < 16; ++i) a.in[i] = (const float*)d_in[i];
    a.out = (float*)d_out; a.ws = (unsigned char*)d_ws;
    for (int i = 0; i < 64; ++i) a.invf[i] = (float)pow(10000.0, -(double)i / 64.0);
#if MK_PER_PHASE
#ifndef MK_DUP_MASK
#define MK_DUP_MASK 0
#endif
#ifndef MK_DUP_REPS
#define MK_DUP_REPS 2
#endif
    for (int ph = 0; ph < NPH; ++ph) { a.ph_lo = ph; a.ph_hi = ph + 1; const int reps = ((MK_DUP_MASK >> ph) & 1) ? MK_DUP_REPS : 1;
        for (int r = 0; r < reps; ++r) hipLaunchKernelGGL(mk_fwd, dim3(grid), dim3(NWAVES * 64), LDS_BYTES, stream, a); }
#else
    a.ph_lo = 0; a.ph_hi = NPH; hipLaunchKernelGGL(mk_fwd, dim3(grid), dim3(NWAVES * 64), LDS_BYTES, stream, a);
#endif
    const hipError_t le = hipPeekAtLastError();
    if (le != hipSuccess) fprintf(stderr, "kernel_launch: launch failed: %s\n", hipGetErrorName(le));
}
```

```cpp
#include <hip/hip_runtime.h>
#ifndef NST_ALL
#define NST_ALL 16
#endif
#include <cstdio>
#include <cstdint>
#include <cmath>
namespace pg8 {
#define PG8_LAS __attribute__((address_space(3)))
typedef unsigned short bf16_t;
typedef short bf16x8 __attribute__((ext_vector_type(8)));
typedef float f32x4 __attribute__((ext_vector_type(4)));
typedef unsigned u32x4 __attribute__((ext_vector_type(4)));
constexpr int BM = 256, BK = 64, HALF = 128, HTB = HALF * BK * 2  , STAGE_BYTES = 8 * HTB, NXCD = 8, WGM = 8;

__host__ __device__ __forceinline__ int lds_byte(int r, int c) { const int st = (r >> 4) * 2 + (c >> 5), rr = r & 15, cc = c & 31, ob = rr * 64 + cc * 2; return st * 1024 + (ob ^ (((ob >> 9) & 1) << 5)); }
__host__ __device__ __forceinline__ void stage_rc(int b, int& R, int& C) { const int st = b / 1024, sb = b % 1024, swz = sb ^ (((sb >> 9) & 1) << 5); R = (st >> 1) * 16 + swz / 64; C = (st & 1) * 32 + (swz % 64) / 2; }
__host__ __device__ __forceinline__ int perm32(int rho) { const int n = rho >> 4, i = rho & 15; return 8 * (i >> 2) + 4 * n + (i & 3); }

struct Unit { int pm, pn; };
struct Gemm { const bf16_t* A; const bf16_t* Bt; int M, N, K; float oscale; const bf16_t* A2; const bf16_t* Bt2; };
typedef int i32x8 __attribute__((ext_vector_type(8)));
typedef int i32x4v __attribute__((ext_vector_type(4)));
__device__ __forceinline__ i32x8 cat16(bf16x8 lo, bf16x8 hi) { const i32x4v a = __builtin_bit_cast(i32x4v, lo), b = __builtin_bit_cast(i32x4v, hi); return __builtin_shufflevector(a, b, 0, 1, 2, 3, 4, 5, 6, 7); }

struct StaticOrder {
    int nM, nN, nwg, G, c;
    __host__ __device__ void init(int M, int N, int G_, int c_) { nM = M / BM; nN = N / BM; nwg = nM * nN; G = G_; c = c_; }
    __host__ __device__ bool next(int i, Unit& u) const {
        const long L = (long)i * G + c; if (L >= nwg) return false;
        int wgid = (int)L; { const int q = nwg / NXCD, r = nwg % NXCD, xcd = wgid % NXCD, off = wgid / NXCD; wgid = (xcd < r ? xcd * (q + 1) : r * (q + 1) + (xcd - r) * q) + off; }
        const int nig = WGM * nN, gid = wgid / nig, fm = gid * WGM, gsz = (nM - fm) < WGM ? (nM - fm) : WGM;
        u.pm = fm + ((wgid % nig) % gsz); u.pn = (wgid % nig) / gsz; return true;
    }
    __device__ __forceinline__ void a_ready(const Unit&) const {}
    __device__ __forceinline__ void done(const Unit&) const {}
};

__device__ __forceinline__ unsigned cvt_pk_bf16(float lo, float hi) { unsigned r; asm volatile("v_cvt_pk_bf16_f32 %0, %1, %2" : "=v"(r) : "v"(lo), "v"(hi)); return r; }
typedef float f32x2 __attribute__((ext_vector_type(2)));
__device__ __forceinline__ f32x2 gelu_pk(f32x2 v) {
    const f32x2 av = __builtin_elementwise_abs(v), d = av * 0.2316418882f + 1.0f;
    f32x2 t; t.x = __builtin_amdgcn_rcpf(d.x); t.y = __builtin_amdgcn_rcpf(d.y);
    f32x2 q = t * 0.5307027145f + (-0.7265760135f); q = q * t + 0.7107068705f; q = q * t + (-0.142248368f); q = q * t + 0.127414796f; q = q * t;
    const f32x2 s = (v * v) * (-0.72134752044f);
    f32x2 e; e.x = __builtin_amdgcn_exp2f(s.x); e.y = __builtin_amdgcn_exp2f(s.y);
    const f32x2 m = v * (q * e), r = v - m;
    f32x2 o; o.x = v.x < 0.f ? m.x : r.x; o.y = v.y < 0.f ? m.y : r.y; return o;
}

template <int ACT  > struct EpiBf16 {
    static constexpr bool PERM = true, AFTER_DRAIN = false, BMAP64 = false; static_assert(ACT == 0 || ACT == 1, "EpiBf16: ACT is 0 (none) or 1 (gelu_pk)");
    bf16_t* O; int ldc; const float* bias; int split_cols; size_t split_stride; float scale0;
    __device__ __forceinline__ void operator()(const f32x4 (&acc)[2][2][4][2], const Unit& u, int wr, int wc, int fr, int fq) const {
        const int row0 = u.pm * BM + wr * 64 + fr; int colt = u.pn * BM; bf16_t* base = O;
        float sc = 1.f; if (split_cols) { const int t = colt / split_cols; base += (size_t)t * split_stride; colt -= t * split_cols; if (t == 0) sc = scale0; }
        const int col0 = colt + wc * 32 + 8 * fq, bcol0 = u.pn * BM + wc * 32 + 8 * fq;
        f32x4 bv[2][2];
#pragma unroll
        for (int bj = 0; bj < 2; ++bj)
#pragma unroll
            for (int n = 0; n < 2; ++n) bv[bj][n] = bias ? *(const f32x4*)(bias + bcol0 + bj * HALF + 4 * n) : (f32x4){0.f, 0.f, 0.f, 0.f};
#pragma unroll
        for (int ai = 0; ai < 2; ++ai)
#pragma unroll
            for (int m = 0; m < 4; ++m) { bf16_t* rowp = base + (size_t)(row0 + ai * HALF + m * 16) * ldc + col0;
#pragma unroll
                for (int bj = 0; bj < 2; ++bj) { f32x4 v0 = acc[ai][bj][m][0] + bv[bj][0], v1 = acc[ai][bj][m][1] + bv[bj][1];
                    if (ACT == 1) { f32x2 a = gelu_pk((f32x2){v0[0], v0[1]}), b = gelu_pk((f32x2){v0[2], v0[3]}), c = gelu_pk((f32x2){v1[0], v1[1]}), d = gelu_pk((f32x2){v1[2], v1[3]});
                        v0 = (f32x4){a.x, a.y, b.x, b.y}; v1 = (f32x4){c.x, c.y, d.x, d.y}; }
                    v0 = v0 * sc; v1 = v1 * sc; u32x4 w; w.x = cvt_pk_bf16(v0[0], v0[1]); w.y = cvt_pk_bf16(v0[2], v0[3]); w.z = cvt_pk_bf16(v1[0], v1[1]); w.w = cvt_pk_bf16(v1[2], v1[3]);
                    *(u32x4*)(rowp + bj * HALF) = w; } }
    }
};
template <class Epi, class Sched, bool ALIGN_EPI = false, bool SP2 = false, int QM = 0, int NST = 0, bool ATILED = false, bool DUAL = false, int CHAIN = 0>
__device__ __forceinline__ void gemm_phase(PG8_LAS unsigned char* lds, const Gemm g, const Sched& S, const Epi& E, const char* chA = nullptr, const char* chB = nullptr) {
    int tid_ = threadIdx.x; asm volatile("" : "+v"(tid_));
    const int tid = tid_, wid = __builtin_amdgcn_readfirstlane(tid >> 6), lane = tid & 63, wr = wid >> 2, wc = wid & 3, fr = lane & 15, fq = lane >> 4;
    constexpr bool F8 = (QM == 1), I8 = (QM == 2), F4 = (QM == 3);
    const int K = g.K, nt = K / BK;
    unsigned voffA[2], voffB[2];
#pragma unroll
    for (int i = 0; i < 2; ++i) { int R, C; stage_rc(tid * 16 + i * 8192, R, C); const int Rb = Epi::BMAP64 ? (64 * (R >> 5) + perm32(R & 31)) : Epi::PERM ? ((R & ~31) + perm32(R & 31)) : R;
        voffA[i] = (unsigned)(R * (ATILED ? BK : K) + C) * 2u; voffB[i] = (unsigned)(Rb * BK + C) * 2u; }
    const size_t kstep = (size_t)(BK * 2);
    const size_t hstep = (size_t)HALF * K * 2;
    const size_t kstepB = (size_t)BM * BK * 2, hstepB = (size_t)(Epi::BMAP64 ? 32 : HALF) * BK * 2;
    const size_t kstepA = ATILED ? (size_t)BM * BK * 2 : kstep, hstepA = ATILED ? (size_t)HALF * BK * 2 : hstep;
    const size_t tstep = 2 * hstep;
    const unsigned ldsw = (unsigned)wid * 1024u;
    const int aoff = lds_byte(wr * 64 + fr, fq * 8), boff = lds_byte(wc * 32 + fr, fq * 8);
#define PG8_SA(b, h) (((b) * 2 + (h)) * HTB)
#define PG8_SB(b, h) ((4 + (b) * 2 + (h)) * HTB)
#define PG8_STAGE(bufoff, gbase, voff) do { _Pragma("unroll") for (int _i = 0; _i < 2; ++_i) \
        __builtin_amdgcn_global_load_lds((const unsigned*)((const char*)(gbase) + (voff)[_i]), (PG8_LAS unsigned*)(lds + (bufoff) + ldsw + _i * 8192), 16, 0, 0); } while (0)
#define PG8_LDA(dst, b, h) do { _Pragma("unroll") for (int m = 0; m < 4; ++m) { if constexpr (F8) dst##8[m] = cat16(*(const PG8_LAS bf16x8*)(lds + PG8_SA(b, h) + aoff + m * 2048), *(const PG8_LAS bf16x8*)(lds + PG8_SA(b, h) + aoff + m * 2048 + 1024)); \
        else { _Pragma("unroll") for (int k = 0; k < 2; ++k) dst[m][k] = *(const PG8_LAS bf16x8*)(lds + PG8_SA(b, h) + aoff + m * 2048 + k * 1024); } } } while (0)
#define PG8_LDB(dst, b, h) do { _Pragma("unroll") for (int n = 0; n < 2; ++n) { if constexpr (F8) dst##8[n] = cat16(*(const PG8_LAS bf16x8*)(lds + PG8_SB(b, h) + boff + n * 2048), *(const PG8_LAS bf16x8*)(lds + PG8_SB(b, h) + boff + n * 2048 + 1024)); \
        else { _Pragma("unroll") for (int k = 0; k < 2; ++k) dst[n][k] = *(const PG8_LAS bf16x8*)(lds + PG8_SB(b, h) + boff + n * 2048 + k * 1024); } } } while (0)
#define PG8_MMA(ai, bj, At, Bt) do { __builtin_amdgcn_s_setprio(1); _Pragma("unroll") for (int m = 0; m < 4; ++m) _Pragma("unroll") for (int n = 0; n < 2; ++n) { \
        if constexpr (F8) asm volatile("v_mfma_f32_16x16x128_f8f6f4 %0, %1, %2, %0" : "+v"(acc[ai][bj][m][n]) : "v"(Bt##8[n]), "v"(At##8[m]));     \
        else if constexpr (I8) { _Pragma("unroll") for (int k = 0; k < 2; ++k) asm volatile("v_mfma_i32_16x16x64_i8 %0, %1, %2, %0" : "+v"(acc[ai][bj][m][n]) : "v"(Bt[n][k]), "v"(At[m][k])); } \
        else if constexpr (F4) { _Pragma("unroll") for (int k = 0; k < 2; ++k) asm volatile("v_mfma_f32_16x16x128_f8f6f4 %0, %1, %2, %0 cbsz:4 blgp:4" : "+v"(acc[ai][bj][m][n]) : "v"(Bt[n][k]), "v"(At[m][k])); } \
        else { _Pragma("unroll") for (int k = 0; k < 2; ++k) acc[ai][bj][m][n] = __builtin_amdgcn_mfma_f32_16x16x32_bf16(Bt[n][k], At[m][k], acc[ai][bj][m][n], 0, 0, 0); } } \
        __builtin_amdgcn_s_setprio(0); } while (0)
#define PG8_WAIT_V(n) asm volatile("s_waitcnt vmcnt(" #n ")" ::: "memory")
#define PG8_WAIT_VF(fresh_) do { if constexpr (NST != 0) asm volatile("s_waitcnt vmcnt(%1)\n\ts_cmp_lg_u32 %0, 0\n\ts_cbranch_scc1 .Lpg8w%=\n\ts_waitcnt vmcnt(8)\n.Lpg8w%=:" :: "s"(fresh_), "n"(10 + NST) : "scc", "memory"); else PG8_WAIT_V(8); } while (0)
#define PG8_WAIT_L(n) asm volatile("s_waitcnt lgkmcnt(" #n ")" ::: "memory")
#define PG8_BAR __builtin_amdgcn_s_barrier()
#define PG8_SCHED __builtin_amdgcn_sched_barrier(0)
    Unit cur, nxt; int ui = 0;
    if (!S.next(0, cur)) return;
    f32x4 acc[2][2][4][2];
#pragma unroll
    for (int a = 0; a < 2; ++a)
#pragma unroll
        for (int b = 0; b < 2; ++b)
#pragma unroll
            for (int m = 0; m < 4; ++m)
#pragma unroll
                for (int n = 0; n < 2; ++n) acc[a][b][m][n] = (f32x4){0.f, 0.f, 0.f, 0.f};
    bf16x8 At[4][2], B0[2][2], B1[2][2];
    i32x8 At8[4], B08[2], B18[2];
    const char* cA = (const char*)g.A + (size_t)cur.pm * tstep; const char* cB = (const char*)g.Bt + (size_t)cur.pn * tstep;
    S.a_ready(cur);
    static_assert(CHAIN == 0 || (NST != 0 && !DUAL), "CHAIN rides on the NST hand-over");
    if constexpr (CHAIN & 1) {   }
    else if constexpr (SP2) {
        PG8_STAGE(PG8_SB(0, 0), cB, voffB); PG8_STAGE(PG8_SB(0, 1), cB + hstepB, voffB); PG8_STAGE(PG8_SA(0, 0), cA, voffA); PG8_STAGE(PG8_SA(0, 1), cA + hstepA, voffA);
        if (wr == 1) PG8_BAR;
        PG8_WAIT_V(2); PG8_BAR;
        PG8_STAGE(PG8_SB(1, 0), cB + kstepB, voffB); PG8_STAGE(PG8_SA(1, 0), cA + kstepA, voffA); PG8_STAGE(PG8_SB(1, 1), cB + hstepB + kstepB, voffB);
        PG8_WAIT_V(6); PG8_BAR;
    } else {
        PG8_STAGE(PG8_SB(0, 0), cB, voffB); PG8_STAGE(PG8_SA(0, 0), cA, voffA); PG8_STAGE(PG8_SB(0, 1), cB + hstepB, voffB); PG8_STAGE(PG8_SA(0, 1), cA + hstepA, voffA);
        if (wr == 1) PG8_BAR;
        PG8_WAIT_V(4); PG8_BAR;
        PG8_STAGE(PG8_SB(1, 0), cB + kstepB, voffB); PG8_STAGE(PG8_SA(1, 0), cA + kstepA, voffA); PG8_STAGE(PG8_SB(1, 1), cB + hstepB + kstepB, voffB);
        PG8_WAIT_V(6); PG8_BAR;
    }
    for (;;) {
        const bool has_next = S.next(ui + 1, nxt);
        const char* uA = has_next ? (const char*)g.A + (size_t)nxt.pm * tstep : ((CHAIN & 2) ? chA : cA); const char* uB = has_next ? (const char*)g.Bt + (size_t)nxt.pn * tstep : ((CHAIN & 2) ? chB : cB);
        const char* nA = uA; const char* nB = uB;
#pragma unroll
        for (int seg = 0; seg < (DUAL ? 2 : 1); ++seg) {
        if (DUAL && seg == 0) { nA = (const char*)g.A2 + (size_t)cur.pm * tstep; nB = (const char*)g.Bt2 + (size_t)cur.pn * tstep; } else { nA = uA; nB = uB; }
        for (int t = 0; t < nt; t += 2) {
            const bool last = (t == nt - 2);
            const char* a1 = cA + (size_t)(t + 1) * kstepA;
            const char* a2 = last ? nA : cA + (size_t)(t + 2) * kstepA; const char* b2 = last ? nB : cB + (size_t)(t + 2) * kstepB;
            const char* a3 = a2 + kstepA; const char* b3 = b2 + kstepB;
            if (last && has_next) S.a_ready(nxt);
            if constexpr (SP2) {
            const int fresh = __builtin_amdgcn_readfirstlane((NST != 0 && t == 0 && (ui > 0 || (CHAIN & 1)) && seg == 0) ? 1 : 0);
            PG8_LDB(B0, 0, 0); PG8_LDB(B1, 0, 1); PG8_SCHED; PG8_LDA(At, 0, 0); PG8_STAGE(PG8_SA(1, 1), a1 + hstepA, voffA);
            PG8_WAIT_VF(fresh); PG8_WAIT_L(0); PG8_BAR; PG8_MMA(0, 0, At, B0); PG8_MMA(0, 1, At, B1); PG8_BAR; PG8_SCHED;
            PG8_LDA(At, 0, 1); PG8_STAGE(PG8_SB(0, 0), b2, voffB); PG8_STAGE(PG8_SB(0, 1), b2 + hstepB, voffB); PG8_STAGE(PG8_SA(0, 0), a2, voffA);
            PG8_WAIT_VF(fresh); PG8_WAIT_L(0); PG8_BAR; PG8_MMA(1, 0, At, B0); PG8_MMA(1, 1, At, B1); PG8_BAR; PG8_SCHED;
            PG8_LDB(B0, 1, 0); PG8_LDB(B1, 1, 1); PG8_SCHED; PG8_LDA(At, 1, 0); PG8_STAGE(PG8_SA(0, 1), a2 + hstepA, voffA);
            PG8_WAIT_VF(fresh); PG8_WAIT_L(0); PG8_BAR; PG8_MMA(0, 0, At, B0); PG8_MMA(0, 1, At, B1); PG8_BAR; PG8_SCHED;
            PG8_LDA(At, 1, 1); PG8_STAGE(PG8_SB(1, 0), b3, voffB); PG8_STAGE(PG8_SB(1, 1), b3 + hstepB, voffB); PG8_STAGE(PG8_SA(1, 0), a3, voffA);
            PG8_WAIT_V(8); PG8_WAIT_L(0); PG8_BAR; PG8_MMA(1, 0, At, B0); PG8_MMA(1, 1, At, B1); PG8_BAR; PG8_SCHED;
            } else {
            PG8_LDB(B0, 0, 0); PG8_SCHED; PG8_LDA(At, 0, 0); PG8_STAGE(PG8_SA(1, 1), a1 + hstepA, voffA);
            PG8_WAIT_L(8); PG8_BAR; PG8_WAIT_L(0); PG8_MMA(0, 0, At, B0); PG8_BAR; PG8_SCHED;
            PG8_LDB(B1, 0, 1); PG8_STAGE(PG8_SB(0, 0), b2, voffB);
            PG8_BAR; PG8_WAIT_L(0); PG8_MMA(0, 1, At, B1); PG8_BAR;
            PG8_LDA(At, 0, 1); PG8_STAGE(PG8_SA(0, 0), a2, voffA);
            PG8_BAR; PG8_WAIT_L(0); PG8_MMA(1, 0, At, B0); PG8_BAR; PG8_SCHED;
            PG8_STAGE(PG8_SB(0, 1), b2 + hstepB, voffB);
            PG8_WAIT_V(6); PG8_BAR; PG8_MMA(1, 1, At, B1); PG8_BAR;
            PG8_LDB(B0, 1, 0); PG8_SCHED; PG8_LDA(At, 1, 0); PG8_STAGE(PG8_SA(0, 1), a2 + hstepA, voffA);
            PG8_WAIT_L(8); PG8_BAR; PG8_WAIT_L(0); PG8_MMA(0, 0, At, B0); PG8_BAR; PG8_SCHED;
            PG8_LDB(B1, 1, 1); PG8_STAGE(PG8_SB(1, 0), b3, voffB);
            PG8_BAR; PG8_WAIT_L(0); PG8_MMA(0, 1, At, B1); PG8_BAR;
            PG8_LDA(At, 1, 1); PG8_STAGE(PG8_SA(1, 0), a3, voffA);
            PG8_BAR; PG8_WAIT_L(0); PG8_MMA(1, 0, At, B0); PG8_BAR; PG8_SCHED;
            PG8_STAGE(PG8_SB(1, 1), b3 + hstepB, voffB);
            PG8_WAIT_V(6); PG8_BAR; PG8_MMA(1, 1, At, B1); PG8_BAR;
            }
        }
        if constexpr (ALIGN_EPI) { if (wr == 0) PG8_BAR; }
        if constexpr (DUAL) { if (seg == 0) {
            asm volatile("s_nop 15\n\ts_nop 15" ::: "memory");
            E.mid(acc, cur, wr, wc, fr, fq);
            cA = nA; cB = nB;
            if constexpr (ALIGN_EPI) { if (wr == 1) PG8_BAR; } } }
        }
        if constexpr (F8 || F4) { asm volatile("s_nop 15\n\ts_nop 15" ::: "memory");
            const float os_ = g.oscale;
#pragma unroll
            for (int a = 0; a < 2; ++a)
#pragma unroll
                for (int b = 0; b < 2; ++b)
#pragma unroll
                    for (int m = 0; m < 4; ++m)
#pragma unroll
                        for (int n = 0; n < 2; ++n) acc[a][b][m][n] = acc[a][b][m][n] * os_; }
        if constexpr (I8) { asm volatile("s_nop 15\n\ts_nop 15" ::: "memory"); const float os_ = g.oscale;
#pragma unroll
            for (int a = 0; a < 2; ++a)
#pragma unroll
                for (int b = 0; b < 2; ++b)
#pragma unroll
                    for (int m = 0; m < 4; ++m)
#pragma unroll
                        for (int n = 0; n < 2; ++n) { const i32x4v iv = __builtin_bit_cast(i32x4v, acc[a][b][m][n]); acc[a][b][m][n] = (f32x4){(float)iv[0], (float)iv[1], (float)iv[2], (float)iv[3]} * os_; } }
        if constexpr (NST != 0) { static_assert(ALIGN_EPI && SP2, "NST needs both halves past the K-loop's last read of As[1][1] (ALIGN_EPI) and the SP2 loop");
            if (has_next || (CHAIN & 2)) PG8_STAGE(PG8_SA(1, 1), nA + kstepA + hstepA, voffA);
            asm volatile("" ::: "memory"); }
        if constexpr (!Epi::AFTER_DRAIN) { E(acc, cur, wr, wc, fr, fq); S.done(cur); }
        if (!has_next) break;
#pragma unroll
        for (int a = 0; a < 2; ++a)
#pragma unroll
            for (int b = 0; b < 2; ++b)
#pragma unroll
                for (int m = 0; m < 4; ++m)
#pragma unroll
                    for (int n = 0; n < 2; ++n) acc[a][b][m][n] = (f32x4){0.f, 0.f, 0.f, 0.f};
        cur = nxt; cA = nA; cB = nB; ++ui;
        if constexpr (ALIGN_EPI) { if (wr == 1) PG8_BAR; }
    }
    if constexpr (CHAIN & 2) { if constexpr (ALIGN_EPI) { if (wr == 1) PG8_BAR; } }
    else {
    PG8_WAIT_V(0);
    if constexpr (!ALIGN_EPI) { if (wr == 0) PG8_BAR; }
    PG8_BAR;
    }
    if constexpr (Epi::AFTER_DRAIN) { E.fused(acc, cur, wr, wc, fr, fq, lds, wid, lane); S.done(cur); }
#undef PG8_SA
#undef PG8_SB
#undef PG8_STAGE
#undef PG8_LDA
#undef PG8_LDB
#undef PG8_MMA
#undef PG8_WAIT_V
#undef PG8_WAIT_L
#undef PG8_BAR
#undef PG8_SCHED
}
}

constexpr int NWAVES = 8;
constexpr int BATCH = 4, SEQ = 2048, DM = 4096, M = BATCH * SEQ;
constexpr int AW = 2048, AHEADS = 16, AD = 128;
constexpr int BQH = 32, BKVH = 4, BD = 64, BKVW = 256, WIN = 128;
constexpr int NIN = 16896, DFF = 16384, PLE = 256;
constexpr int MBLK = 256, NBLK = SEQ / MBLK, TOPK = 3;
constexpr float LN_EPS = 1e-5f;
constexpr float ALPHA = 1.189207115002721f;
constexpr float LOG2E = 1.4426950408889634f;
constexpr float QSCALE_A = 0.08838834764831845f * LOG2E;
constexpr float QSCALE_B = 0.125f * LOG2E;
constexpr int NPH = 10;

constexpr size_t MiB = 1u << 20;
constexpr size_t WS_CTL = 0, CTL_ZERO_BYTES = 832 * 1024;
constexpr size_t WS_TABA = 1 * MiB;
constexpr size_t WS_TABB = 2 * MiB;
constexpr size_t WS_KMP  = 3 * MiB;
constexpr size_t WS_WIN  = 4 * MiB;
constexpr size_t WS_TA   = WS_WIN;
constexpr size_t WS_WUPA = 136 * MiB, WS_WUPB = 152 * MiB, WS_WO = 168 * MiB, WS_WPLE = 200 * MiB, WS_WPLEG = 202 * MiB;
constexpr size_t WS_WFFUP = 234 * MiB;
constexpr size_t WS_PLE  = 72 * MiB;
constexpr size_t WS_WFFDN = 362 * MiB;
constexpr size_t WS_XB   = 490 * MiB;
constexpr size_t WS_H1B  = WS_XB;
constexpr size_t WS_PB   = 554 * MiB;
constexpr size_t WS_QA = 558 * MiB, WS_KA = 590 * MiB, WS_VA = 622 * MiB, WS_QB = 654 * MiB, WS_KB = 686 * MiB, WS_VB = 690 * MiB, WS_GA = 694 * MiB, WS_GB = 758 * MiB;
constexpr size_t WS_MG   = WS_QA;
constexpr size_t WS_U    = WS_QA;
constexpr size_t WS_YA = 822 * MiB, WS_YB = 854 * MiB;
constexpr size_t WS_H2B  = WS_YA;
constexpr size_t WS_XB4  = 888 * MiB;
constexpr size_t WS_WG4  = 904 * MiB;
constexpr size_t WS_T12  = 940 * MiB;
constexpr size_t WS_END  = 1004 * MiB;
constexpr int CW_BAR = 4096;
constexpr size_t CB_ST1 = 256 * 1024, CB_ST2 = 384 * 1024, CB_C1F = 512 * 1024, CB_C2F = 640 * 1024, CB_C1G = 768 * 1024, CB_C2G = 800 * 1024;
constexpr size_t WS_CF32 = 3 * MiB + 512 * 1024;
constexpr float FXS = 4294967296.0f;
__device__ __forceinline__ void fx_add(long long* p, float v) { atomicAdd((unsigned long long*)p, (unsigned long long)(long long)(v * FXS)); }

constexpr int RING_OFF = 0, RING_BYTES = 131072;
constexpr int CV_CH = 1056, CV_SLOT = 8 * CV_CH, CV_WAVE = 2 * CV_SLOT;
constexpr int LDSCTL_OFF = 8 * CV_WAVE, MISC_OFF = LDSCTL_OFF + 320;
static_assert(LDSCTL_OFF >= RING_BYTES && LDSCTL_OFF % 16 == 0, "LDS map");
constexpr int LDS_BYTES = 147456;

#define GAS __attribute__((address_space(1)))
#define LAS __attribute__((address_space(3)))
typedef unsigned short bf16;
typedef float f32x4 __attribute__((ext_vector_type(4)));
typedef float f32x2 __attribute__((ext_vector_type(2)));
typedef unsigned u32x4 __attribute__((ext_vector_type(4)));
typedef unsigned u32x2 __attribute__((ext_vector_type(2)));
typedef unsigned char f8;
constexpr float F8S_X = 4.f, F8S_WIN = 512.f, F8S_Y = 64.f, F8S_WUP = 512.f, F8S_MG = 64.f, F8S_WO = 512.f;
constexpr float F4S_X = 2.f, F4S_WG = 128.f;
__device__ __forceinline__ unsigned pk8f4(float a, float b, float c, float d, float e, float f, float g, float h) {
    unsigned w = 0u; w = __builtin_amdgcn_cvt_scalef32_pk_fp4_f32(w, a, b, 1.0f, 0); w = __builtin_amdgcn_cvt_scalef32_pk_fp4_f32(w, c, d, 1.0f, 1);
    w = __builtin_amdgcn_cvt_scalef32_pk_fp4_f32(w, e, f, 1.0f, 2); w = __builtin_amdgcn_cvt_scalef32_pk_fp4_f32(w, g, h, 1.0f, 3); return w;
}
constexpr float I8S_T2 = 20.f, I8S_WG = 1800.f;
__device__ __forceinline__ unsigned pk4u8(float a, float b, float c, float d) { unsigned r = 0; r = __builtin_amdgcn_cvt_pk_u8_f32(a * 255.f, 0, r); r = __builtin_amdgcn_cvt_pk_u8_f32(b * 255.f, 1, r); r = __builtin_amdgcn_cvt_pk_u8_f32(c * 255.f, 2, r); return __builtin_amdgcn_cvt_pk_u8_f32(d * 255.f, 3, r); }
__device__ __forceinline__ f32x4 un4u8(unsigned w) { return (f32x4){(float)(w & 0xffu), (float)((w >> 8) & 0xffu), (float)((w >> 16) & 0xffu), (float)(w >> 24)} * (1.0f / 255.f); }
__device__ __forceinline__ unsigned pk4i8(float a, float b, float c, float d) {
    const int ia = (int)__builtin_rintf(__builtin_amdgcn_fmed3f(a, -127.f, 127.f)), ib = (int)__builtin_rintf(__builtin_amdgcn_fmed3f(b, -127.f, 127.f)), ic = (int)__builtin_rintf(__builtin_amdgcn_fmed3f(c, -127.f, 127.f)), id = (int)__builtin_rintf(__builtin_amdgcn_fmed3f(d, -127.f, 127.f));
    return ((unsigned)ia & 0xffu) | (((unsigned)ib & 0xffu) << 8) | (((unsigned)ic & 0xffu) << 16) | ((unsigned)id << 24);
}
__device__ __forceinline__ unsigned pk4f8(float a, float b, float c, float d) {
    a = __builtin_amdgcn_fmed3f(a, -448.f, 448.f); b = __builtin_amdgcn_fmed3f(b, -448.f, 448.f); c = __builtin_amdgcn_fmed3f(c, -448.f, 448.f); d = __builtin_amdgcn_fmed3f(d, -448.f, 448.f);
    unsigned w = 0u; w = __builtin_amdgcn_cvt_pk_fp8_f32(a, b, w, false); w = __builtin_amdgcn_cvt_pk_fp8_f32(c, d, w, true); return w;
}
#define LDS_WAIT() asm volatile("s_waitcnt lgkmcnt(0)" ::: "memory")
#define VM_WAIT() asm volatile("s_waitcnt vmcnt(0)" ::: "memory")

typedef __bf16 bf16x2_t __attribute__((ext_vector_type(2)));
__device__ __forceinline__ unsigned pk2(float lo, float hi) { const f32x2 v = {lo, hi}; const bf16x2_t b = __builtin_convertvector(v, bf16x2_t); return __builtin_bit_cast(unsigned, b); }
__device__ __forceinline__ float bflo(unsigned u) { return __uint_as_float(u << 16); }
__device__ __forceinline__ float bfhi(unsigned u) { return __uint_as_float(u & 0xffff0000u); }
__device__ __forceinline__ float sigmoidf_(float x) { return __builtin_amdgcn_rcpf(1.0f + __expf(-x)); }
__device__ __forceinline__ float wave_sum(float v) {
#pragma unroll
    for (int o = 1; o < 64; o <<= 1) v += __shfl_xor(v, o);
    return v;
}
__device__ __forceinline__ float wave_max(float v) {
#pragma unroll
    for (int o = 1; o < 64; o <<= 1) v = fmaxf(v, __shfl_xor(v, o));
    return v;
}

#define XB_TMO      128
#define XB_XCNT(j)  (256  + 64 * (j))
#define XB_XSUB(j)  (1280 + 64 * (j))
#define XB_XGEN(j)  (2304 + 64 * (j))
#define XB_TOP      3328
#define XB_TOPGEN   3392
#define XCD_BAR_WORDS 3456
#define XB_SPIN_CAP (1u << 18)

__device__ __forceinline__ unsigned xb_ld(unsigned* p)              { return __hip_atomic_load(p, __ATOMIC_RELAXED, __HIP_MEMORY_SCOPE_AGENT); }
__device__ __forceinline__ unsigned xb_add(unsigned* p, unsigned v) { return __hip_atomic_fetch_add(p, v, __ATOMIC_RELAXED, __HIP_MEMORY_SCOPE_AGENT); }
__device__ __forceinline__ unsigned xb_xcc_id() { return (unsigned)__builtin_amdgcn_s_getreg((3 << 11) | 20) & 0xFu; }
#define XB_SPIN(cond, bar) do { unsigned _sp = 0; while (cond) { __builtin_amdgcn_s_sleep(1); \
    if ((++_sp & 255u) == 0u) { if (xb_ld(&(bar)[XB_TMO])) break; if (_sp > XB_SPIN_CAP) { atomicAdd(&(bar)[XB_TMO], 1u); break; } } } } while (0)

struct XcdBarrier {
    unsigned* bar; unsigned x;
    volatile LAS unsigned* st;
};

__device__ __forceinline__ XcdBarrier xcd_barrier_post(unsigned* bar, volatile LAS unsigned* st) {
    XcdBarrier b; b.bar = bar; b.x = xb_xcc_id(); b.st = st;
    if (threadIdx.x == 0) (void)xb_add(&bar[XB_XCNT(b.x)], 1u);
    return b;
}
__device__ __forceinline__ void xcd_barrier_complete(unsigned* bar, unsigned x, unsigned& nloc, unsigned& nx) {
    const unsigned G = gridDim.x * gridDim.y * gridDim.z;
    unsigned sum, cnt, mine, sp = 0u;
    for (;;) {
        sum = 0u; cnt = 0u; mine = 0u;
#pragma unroll
        for (unsigned j = 0; j < 16; ++j) { const unsigned c = xb_ld(&bar[XB_XCNT(j)]); sum += c; cnt += (c > 0u) ? 1u : 0u; mine = (j == x) ? c : mine; }
        if (sum == G) break;
        __builtin_amdgcn_s_sleep(1);
        if ((++sp & 255u) == 0u) { if (xb_ld(&bar[XB_TMO])) break; if (sp > XB_SPIN_CAP) { atomicAdd(&bar[XB_TMO], 1u); break; } }
    }
    nloc = mine > 0u ? mine : 1u; nx = cnt > 0u ? cnt : 1u;
}

__device__ __forceinline__ void xcd_barrier(const XcdBarrier& b) {
    asm volatile("s_waitcnt vmcnt(0)" ::: "memory");
    __syncthreads();
    if (threadIdx.x == 0) {
        unsigned* bar = b.bar;
        __builtin_amdgcn_s_waitcnt(0);
        unsigned nloc = b.st[0], nx = b.st[1];
        if (nloc == 0u) { xcd_barrier_complete(bar, b.x, nloc, nx); b.st[0] = nloc; b.st[1] = nx; }
        const unsigned old = xb_add(&bar[XB_XSUB(b.x)], 1u);
        const unsigned gen = old / nloc;
        if (old + 1u == (gen + 1u) * nloc) {
            __builtin_amdgcn_fence(__ATOMIC_RELEASE, "agent");
            asm volatile("s_waitcnt vmcnt(0)" ::: "memory");
            const unsigned og = xb_add(&bar[XB_TOP], 1u);
            const unsigned tg = og / nx;
            if (og + 1u == (tg + 1u) * nx) xb_add(&bar[XB_TOPGEN], 1u);
            else XB_SPIN(xb_ld(&bar[XB_TOPGEN]) == tg, bar);
            __builtin_amdgcn_fence(__ATOMIC_ACQUIRE, "agent");
            xb_add(&bar[XB_XGEN(b.x)], 1u);
            asm volatile("s_waitcnt vmcnt(0)" ::: "memory");
        } else {
            XB_SPIN(xb_ld(&bar[XB_XGEN(b.x)]) == gen, bar);
            __builtin_amdgcn_fence(__ATOMIC_ACQUIRE, "agent");
            asm volatile("s_waitcnt vmcnt(0)" ::: "memory");
        }
    }
    __syncthreads();
}


__device__ __forceinline__ size_t toff(int n, int kbyte, int rowbytes) { return (size_t)(n >> 8) * ((size_t)rowbytes * 256) + ((size_t)(kbyte >> 7) * 256 + (n & 255)) * 128 + (kbyte & 127); }
template <class T> __device__ __forceinline__ T* tp_base(T* p, int pm, int pn, int ntn, int nsteps, int step) { return p + ((size_t)(pm * ntn + pn) * nsteps + step) * 512; }
using pg8::Unit;
template <int MODE> struct EpiZ {
    static constexpr bool PERM = true, AFTER_DRAIN = false, BMAP64 = false;
    bf16* O; bf16* O2; int ldc; float sc; const float* tab; const float* bias; float* kmp;
    __device__ __forceinline__ void plain(const f32x4 (&acc)[2][2][4][2], bf16* Op, int row0, int col0) const {
#pragma unroll
        for (int ai = 0; ai < 2; ++ai)
#pragma unroll
            for (int m = 0; m < 4; ++m) { bf16* rowp = Op + (size_t)(row0 + ai * 128 + m * 16) * ldc + col0;
#pragma unroll
                for (int bj = 0; bj < 2; ++bj) { const f32x4 v0 = acc[ai][bj][m][0], v1 = acc[ai][bj][m][1];
                    u32x4 w; w.x = pk2(v0[0], v0[1]); w.y = pk2(v0[2], v0[3]); w.z = pk2(v1[0], v1[1]); w.w = pk2(v1[2], v1[3]);
                    *(u32x4*)(rowp + bj * 128) = w; } }
    }
    template <bool ISA> __device__ __forceinline__ void rope(const f32x4 (&acc)[2][2][4][2], bf16* Op, int row0, int col0, int wc, int fq) const {
        constexpr int tstride = ISA ? 128 : 64;
        const int i0 = ISA ? (16 * wc + 4 * fq) : (16 * (wc & 1) + 4 * fq);
#pragma unroll
        for (int ai = 0; ai < 2; ++ai)
#pragma unroll
            for (int m = 0; m < 4; ++m) { const int row = row0 + ai * 128 + m * 16, pos = row & (SEQ - 1);
                const f32x4 t0 = *(const f32x4*)(tab + (size_t)pos * tstride + 2 * i0), t1 = *(const f32x4*)(tab + (size_t)pos * tstride + 2 * i0 + 4);
                bf16* rowp = Op + (size_t)row * ldc + col0;
#pragma unroll
                for (int bj = 0; bj < 2; ++bj) { const f32x4 v0 = acc[ai][bj][m][0], v1 = acc[ai][bj][m][1];
                    f32x4 o0, o1;
                    o0[0] = v0[0] * t0[0] - v0[1] * t0[1]; o0[1] = v0[0] * t0[1] + v0[1] * t0[0];
                    o0[2] = v0[2] * t0[2] - v0[3] * t0[3]; o0[3] = v0[2] * t0[3] + v0[3] * t0[2];
                    o1[0] = v1[0] * t1[0] - v1[1] * t1[1]; o1[1] = v1[0] * t1[1] + v1[1] * t1[0];
                    o1[2] = v1[2] * t1[2] - v1[3] * t1[3]; o1[3] = v1[2] * t1[3] + v1[3] * t1[2];
                    o0 = o0 * sc; o1 = o1 * sc;
                    u32x4 w; w.x = pk2(o0[0], o0[1]); w.y = pk2(o0[2], o0[3]); w.z = pk2(o1[0], o1[1]); w.w = pk2(o1[2], o1[3]);
                    *(u32x4*)(rowp + bj * 128) = w; }
                asm volatile("" ::: "memory"); }
    }
    __device__ __forceinline__ void operator()(const f32x4 (&acc)[2][2][4][2], const Unit& u, int wr, int wc, int fr, int fq) const {
        const int row0 = u.pm * 256 + wr * 64 + fr, col0 = u.pn * 256 + wc * 32 + 8 * fq, tidp = ((wr * 4 + wc) * 64 + fq * 16 + fr) & 511;
        if constexpr (MODE == 0) plain(acc, O, row0, col0);
        else if constexpr (MODE == 1) rope<true>(acc, O, row0, col0, wc, fq);
        else if constexpr (MODE == 3) rope<false>(acc, O, row0, col0, wc, fq);
        else if constexpr (MODE == 5) { if (u.pn == 0) rope<false>(acc, O, row0, col0, wc, fq); else plain(acc, O2, row0, col0 - 256); }
        else if constexpr (MODE == 4) {
            f32x4 bv[2][2];
#pragma unroll
            for (int bj = 0; bj < 2; ++bj)
#pragma unroll
                for (int n = 0; n < 2; ++n) bv[bj][n] = *(const f32x4*)(bias + col0 + bj * 128 + 4 * n);
#pragma unroll
            for (int ai = 0; ai < 2; ++ai)
#pragma unroll
                for (int m = 0; m < 4; ++m) {
#pragma unroll
                    for (int bj = 0; bj < 2; ++bj) { const f32x4 v0 = acc[ai][bj][m][0] + bv[bj][0], v1 = acc[ai][bj][m][1] + bv[bj][1];
                        u32x2 w; w.x = pk4u8(sigmoidf_(v0[0]), sigmoidf_(v0[1]), sigmoidf_(v0[2]), sigmoidf_(v0[3])); w.y = pk4u8(sigmoidf_(v1[0]), sigmoidf_(v1[1]), sigmoidf_(v1[2]), sigmoidf_(v1[3]));
                        __builtin_nontemporal_store(w, &tp_base((u32x2*)(u.pn >= 16 ? O2 : O), u.pm, u.pn & 15, 16, 16, (ai * 4 + m) * 2 + bj)[tidp]); } }
        } else {
            rope<true>(acc, O, row0, col0, wc, fq);
            const int i0 = 16 * wc + 4 * fq;
            float* kp = kmp + (size_t)(u.pm * 2 + wr) * AW + col0;
#pragma unroll
            for (int bj = 0; bj < 2; ++bj) { f32x4 c0 = (f32x4){0.f, 0.f, 0.f, 0.f}, c1 = (f32x4){0.f, 0.f, 0.f, 0.f};
#pragma unroll
                for (int ai = 0; ai < 2; ++ai)
#pragma unroll
                    for (int m = 0; m < 4; ++m) { const int pos = (row0 + ai * 128 + m * 16) & (SEQ - 1);
                        const f32x4 t0 = *(const f32x4*)(tab + (size_t)pos * 128 + 2 * i0), t1 = *(const f32x4*)(tab + (size_t)pos * 128 + 2 * i0 + 4);
                        const f32x4 v0 = acc[ai][bj][m][0], v1 = acc[ai][bj][m][1];
                        c0[0] += v0[0] * t0[0] - v0[1] * t0[1]; c0[1] += v0[0] * t0[1] + v0[1] * t0[0];
                        c0[2] += v0[2] * t0[2] - v0[3] * t0[3]; c0[3] += v0[2] * t0[3] + v0[3] * t0[2];
                        c1[0] += v1[0] * t1[0] - v1[1] * t1[1]; c1[1] += v1[0] * t1[1] + v1[1] * t1[0];
                        c1[2] += v1[2] * t1[2] - v1[3] * t1[3]; c1[3] += v1[2] * t1[3] + v1[3] * t1[2]; }
#pragma unroll
                for (int o = 1; o < 16; o <<= 1) {
#pragma unroll
                    for (int j = 0; j < 4; ++j) { c0[j] += __shfl_xor(c0[j], o); c1[j] += __shfl_xor(c1[j], o); } }
                if (fr == 0) { *(f32x4*)(kp + bj * 128) = c0; *(f32x4*)(kp + bj * 128 + 4) = c1; }
                asm volatile("" ::: "memory"); }
        }
    }
};
constexpr float GB_MIN = 9.094947e-13f;
struct EpiMG {
    static constexpr bool PERM = true, AFTER_DRAIN = false, BMAP64 = false;
    const bf16* Ga; const bf16* Gb; f8* MG;
    __device__ __forceinline__ void mid(f32x4 (&acc)[2][2][4][2], const Unit& u, int wr, int wc, int fr, int fq) const {
        asm volatile("" : "+v"(fr));
        const int tidp = ((wr * 4 + wc) * 64 + fq * 16 + fr) & 511;
#pragma unroll
        for (int ai = 0; ai < 2; ++ai)
#pragma unroll
            for (int m = 0; m < 4; ++m) {
#pragma unroll
                for (int bj = 0; bj < 2; ++bj) { const u32x2 ga = tp_base((const u32x2*)Ga, u.pm, u.pn, DM / 256, 16, (ai * 4 + m) * 2 + bj)[tidp], gb = tp_base((const u32x2*)Gb, u.pm, u.pn, DM / 256, 16, (ai * 4 + m) * 2 + bj)[tidp];
                    const f32x4 a0 = un4u8(ga.x), a1 = un4u8(ga.y), b0 = un4u8(gb.x), b1 = un4u8(gb.y);
                    f32x4 r0, r1;
#pragma unroll
                    for (int j = 0; j < 4; ++j) { r0[j] = a0[j] * __builtin_amdgcn_rcpf(fmaxf(b0[j], GB_MIN)); r1[j] = a1[j] * __builtin_amdgcn_rcpf(fmaxf(b1[j], GB_MIN)); }
                    acc[ai][bj][m][0] = acc[ai][bj][m][0] * r0; acc[ai][bj][m][1] = acc[ai][bj][m][1] * r1; }
                asm volatile("" : "+v"(acc[ai][0][m][0]), "+v"(acc[ai][0][m][1]), "+v"(acc[ai][1][m][0]), "+v"(acc[ai][1][m][1]) :: "memory"); }
    }
    __device__ __forceinline__ void operator()(const f32x4 (&acc)[2][2][4][2], const Unit& u, int wr, int wc, int fr, int fq) const {
        asm volatile("" : "+v"(fr));
        const int row0 = u.pm * 256 + wr * 64 + fr, col0 = u.pn * 256 + wc * 32 + 8 * fq, tidp = ((wr * 4 + wc) * 64 + fq * 16 + fr) & 511;
#pragma unroll
        for (int ai = 0; ai < 2; ++ai)
#pragma unroll
            for (int m = 0; m < 4; ++m) {
#pragma unroll
                for (int bj = 0; bj < 2; ++bj) { const u32x2 gb = tp_base((const u32x2*)Gb, u.pm, u.pn, DM / 256, 16, (ai * 4 + m) * 2 + bj)[tidp];
                    f32x4 b0 = un4u8(gb.x), b1 = un4u8(gb.y);
#pragma unroll
                    for (int j = 0; j < 4; ++j) { b0[j] = fmaxf(b0[j], GB_MIN) * F8S_MG; b1[j] = fmaxf(b1[j], GB_MIN) * F8S_MG; }
                    const f32x4 v0 = acc[ai][bj][m][0] * b0, v1 = acc[ai][bj][m][1] * b1;
                    u32x2 w; w.x = pk4f8(v0[0], v0[1], v0[2], v0[3]); w.y = pk4f8(v1[0], v1[1], v1[2], v1[3]);
                    *(u32x2*)((unsigned char*)MG + toff(row0 + ai * 128 + m * 16, col0 + bj * 128, DM)) = w; } }
    }
};
__device__ __forceinline__ f32x2 ln_stats(const long long* st, int row) {
    const double s1 = (double)st[2 * row] * (1.0 / 4294967296.0 / DM), s2 = (double)st[2 * row + 1] * (1.0 / 4294967296.0 / DM);
    const float mean = (float)s1, var = fmaxf((float)(s2 - s1 * s1), 0.f);
    return (f32x2){mean, __builtin_amdgcn_rsqf(var + LN_EPS)};
}
template <bool LN> struct EpiRes {
    static constexpr bool PERM = true, AFTER_DRAIN = false, BMAP64 = false;
    const void* base; bf16* out; bf16* outb; const long long* st; const float* g; const float* b; long long* stn;
    __device__ __forceinline__ void operator()(const f32x4 (&acc)[2][2][4][2], const Unit& u, int wr, int wc, int fr, int fq) const {
        const int row0 = u.pm * 256 + wr * 64 + fr, col0 = u.pn * 256 + wc * 32 + 8 * fq, tidp = ((wr * 4 + wc) * 64 + fq * 16 + fr) & 511;
        f32x4 gg[2][2], bb[2][2];
        if (LN) {
#pragma unroll
            for (int bj = 0; bj < 2; ++bj)
#pragma unroll
                for (int n = 0; n < 2; ++n) { gg[bj][n] = *(const f32x4*)(g + col0 + bj * 128 + 4 * n); bb[bj][n] = *(const f32x4*)(b + col0 + bj * 128 + 4 * n); } }
#pragma unroll
        for (int ai = 0; ai < 2; ++ai)
#pragma unroll
            for (int m = 0; m < 4; ++m) { const int row = row0 + ai * 128 + m * 16; const size_t off = (size_t)row * DM + col0;
                f32x2 sr = {0.f, 0.f}; if (LN) sr = ln_stats(st, row);
                float s1 = 0.f, s2 = 0.f;
#pragma unroll
                for (int bj = 0; bj < 2; ++bj) { f32x4 t[2];
                    if (LN) { const u32x4 tw = *(const u32x4*)((const unsigned char*)base + toff(row, 2 * (col0 + bj * 128), 2 * DM));
                        t[0] = (f32x4){bflo(tw.x), bfhi(tw.x), bflo(tw.y), bfhi(tw.y)}; t[1] = (f32x4){bflo(tw.z), bfhi(tw.z), bflo(tw.w), bfhi(tw.w)}; }
                    else { t[0] = *(const f32x4*)((const float*)base + off + bj * 128); t[1] = *(const f32x4*)((const float*)base + off + bj * 128 + 4); }
#pragma unroll
                    for (int n = 0; n < 2; ++n) { f32x4 x = t[n];
                        if (LN) x = ((x - sr[0]) * sr[1] * gg[bj][n] + bb[bj][n]) * ALPHA + acc[ai][bj][m][n]; else x = x * ALPHA + acc[ai][bj][m][n];
                        t[n] = x; s1 += (x[0] + x[1]) + (x[2] + x[3]); s2 += (x[0] * x[0] + x[1] * x[1]) + (x[2] * x[2] + x[3] * x[3]); }
                    u32x4 w; w.x = pk2(t[0][0], t[0][1]); w.y = pk2(t[0][2], t[0][3]); w.z = pk2(t[1][0], t[1][1]); w.w = pk2(t[1][2], t[1][3]);
                    if (LN) { tp_base((u32x4*)out, u.pm, u.pn, DM / 256, 16, (ai * 4 + m) * 2 + bj)[tidp] = w;
                        u32x2 w8; w8.x = pk4i8(t[0][0] * I8S_T2, t[0][1] * I8S_T2, t[0][2] * I8S_T2, t[0][3] * I8S_T2); w8.y = pk4i8(t[1][0] * I8S_T2, t[1][1] * I8S_T2, t[1][2] * I8S_T2, t[1][3] * I8S_T2);
                        *(u32x2*)((unsigned char*)outb + toff(row, col0 + bj * 128, DM)) = w8; }
                    else *(u32x4*)((unsigned char*)outb + toff(row, 2 * (col0 + bj * 128), 2 * DM)) = w; }
                s1 += __shfl_xor(s1, 16); s2 += __shfl_xor(s2, 16); s1 += __shfl_xor(s1, 32); s2 += __shfl_xor(s2, 32);
                if (fq == 0) { fx_add(stn + 2 * row, s1); fx_add(stn + 2 * row + 1, s2); }
                asm volatile("" ::: "memory"); }
    }
};
struct EpiU {
    static constexpr bool PERM = true, AFTER_DRAIN = false, BMAP64 = true;
    bf16* U; const long long* st; const float* c1; const float* c2;
    __device__ __forceinline__ void operator()(const f32x4 (&acc)[2][2][4][2], const Unit& u, int wr, int wc, int fr, int fq) const {
        const int row0 = u.pm * 256 + wr * 64 + fr, col0 = u.pn * 256 + wc * 64 + 8 * fq, odd = fr & 1;
        bf16* Ut = U + ((size_t)u.pm * (DFF / 64) + 4 * u.pn + wc) * (256 * 64) + (unsigned)(wr * 64) * 64u + 32 * odd + 8 * fq;
        f32x2 sr[2][4];
#pragma unroll
        for (int ai = 0; ai < 2; ++ai)
#pragma unroll
            for (int m = 0; m < 4; ++m) sr[ai][m] = ln_stats(st, row0 + ai * 128 + m * 16);
        f32x4 cc[2][4];
#pragma unroll
        for (int bj = 0; bj < 2; ++bj) { cc[bj][0] = *(const f32x4*)(c1 + col0 + bj * 32); cc[bj][1] = *(const f32x4*)(c1 + col0 + bj * 32 + 4); cc[bj][2] = *(const f32x4*)(c2 + col0 + bj * 32); cc[bj][3] = *(const f32x4*)(c2 + col0 + bj * 32 + 4); }
#pragma unroll
        for (int bj = 0; bj < 2; ++bj)
#pragma unroll
            for (int i = 0; i < 4; ++i) asm volatile("" : "+v"(cc[bj][i]));
#pragma unroll
        for (int ai = 0; ai < 2; ++ai)
#pragma unroll
            for (int m = 0; m < 4; ++m) { u32x4 w[2];
#pragma unroll
                for (int bj = 0; bj < 2; ++bj) {
                    f32x4 v0 = (acc[ai][bj][m][0] - cc[bj][0] * sr[ai][m][0]) * sr[ai][m][1] + cc[bj][2], v1 = (acc[ai][bj][m][1] - cc[bj][1] * sr[ai][m][0]) * sr[ai][m][1] + cc[bj][3];
#pragma unroll
                    for (int j = 0; j < 4; ++j) { const float a = fmaxf(v0[j], 0.f), b = fmaxf(v1[j], 0.f); v0[j] = a * a; v1[j] = b * b; }
                    w[bj].x = pk2(v0[0], v0[1]); w[bj].y = pk2(v0[2], v0[3]); w[bj].z = pk2(v1[0], v1[1]); w[bj].w = pk2(v1[2], v1[3]); }
                const u32x4 snd = odd ? w[0] : w[1]; u32x4 rcv;
                rcv.x = (unsigned)__builtin_amdgcn_mov_dpp((int)snd.x, 0xB1, 0xF, 0xF, true); rcv.y = (unsigned)__builtin_amdgcn_mov_dpp((int)snd.y, 0xB1, 0xF, 0xF, true);
                rcv.z = (unsigned)__builtin_amdgcn_mov_dpp((int)snd.z, 0xB1, 0xF, 0xF, true); rcv.w = (unsigned)__builtin_amdgcn_mov_dpp((int)snd.w, 0xB1, 0xF, 0xF, true);
                const u32x4 s1 = odd ? rcv : w[0], s2 = odd ? w[1] : rcv;
                bf16* rp = Ut + (unsigned)(ai * 128 + m * 16 + (fr & ~1)) * 64u;
                __builtin_nontemporal_store(s1, (u32x4*)rp); __builtin_nontemporal_store(s2, (u32x4*)(rp + 64)); }
    }
};
struct EpiPle {
    static constexpr bool PERM = true, AFTER_DRAIN = false, BMAP64 = false;
    bf16* C;
    __device__ __forceinline__ void operator()(const f32x4 (&acc)[2][2][4][2], const Unit& u, int wr, int wc, int fr, int fq) const {
        const int tidp = ((wr * 4 + wc) * 64 + fq * 16 + fr) & 511;
#pragma unroll
        for (int ai = 0; ai < 2; ++ai)
#pragma unroll
            for (int m = 0; m < 4; ++m)
#pragma unroll
                for (int bj = 0; bj < 2; ++bj) { const f32x4 v0 = acc[ai][bj][m][0], v1 = acc[ai][bj][m][1]; u32x4 w; w.x = pk2(v0[0], v0[1]); w.y = pk2(v0[2], v0[3]); w.z = pk2(v1[0], v1[1]); w.w = pk2(v1[2], v1[3]);
                    __builtin_nontemporal_store(w, &tp_base((u32x4*)C, u.pm, u.pn, DM / 256, 16, (ai * 4 + m) * 2 + bj)[tidp]); }
    }
};
struct EpiFinal {
    static constexpr bool PERM = true, AFTER_DRAIN = false, BMAP64 = false;
    const bf16* PLEp; const bf16* t2p; float* out; const long long* st; const float* g; const float* b; const float* c1; const float* c2;
    __device__ __forceinline__ void operator()(const f32x4 (&acc)[2][2][4][2], const Unit& u, int wr, int wc, int fr, int fq) const {
        const int row0 = u.pm * 256 + wr * 64 + fr, col0 = u.pn * 256 + wc * 32 + 8 * fq, tidp = ((wr * 4 + wc) * 64 + fq * 16 + fr) & 511, odd = fr & 1;
        f32x2 sr[2][4];
#pragma unroll
        for (int ai = 0; ai < 2; ++ai)
#pragma unroll
            for (int m = 0; m < 4; ++m) sr[ai][m] = ln_stats(st, row0 + ai * 128 + m * 16);
#pragma unroll
        for (int bj = 0; bj < 2; ++bj) { const int co = col0 + bj * 128; f32x4 gg[2], bb[2], cc1[2], cc2[2];
#pragma unroll
            for (int n = 0; n < 2; ++n) { gg[n] = *(const f32x4*)(g + co + 4 * n); bb[n] = *(const f32x4*)(b + co + 4 * n); cc1[n] = *(const f32x4*)(c1 + co + 4 * n); cc2[n] = *(const f32x4*)(c2 + co + 4 * n); }
#pragma unroll
            for (int ai = 0; ai < 2; ++ai)
#pragma unroll
                for (int m = 0; m < 4; ++m) { const int row = row0 + ai * 128 + m * 16; const f32x2 s_ = sr[ai][m];
                    const u32x4 pw = tp_base((const u32x4*)PLEp, u.pm, u.pn, DM / 256, 16, (ai * 4 + m) * 2 + bj)[tidp];
                    const f32x4 pl[2] = {{bflo(pw.x), bfhi(pw.x), bflo(pw.y), bfhi(pw.y)}, {bflo(pw.z), bfhi(pw.z), bflo(pw.w), bfhi(pw.w)}};
                    const u32x4 tw = tp_base((const u32x4*)t2p, u.pm, u.pn, DM / 256, 16, (ai * 4 + m) * 2 + bj)[tidp];
                    const f32x4 tv[2] = {{bflo(tw.x), bfhi(tw.x), bflo(tw.y), bfhi(tw.y)}, {bflo(tw.z), bfhi(tw.z), bflo(tw.w), bfhi(tw.w)}};
                    f32x4 o[2];
#pragma unroll
                    for (int n = 0; n < 2; ++n) { const f32x4 t2 = tv[n];
                        const f32x4 h = (t2 - s_[0]) * s_[1] * gg[n] + bb[n], a = (acc[ai][bj][m][n] - cc1[n] * s_[0]) * s_[1] + cc2[n];
                        o[n][0] = h[0] + sigmoidf_(a[0]) * pl[n][0]; o[n][1] = h[1] + sigmoidf_(a[1]) * pl[n][1]; o[n][2] = h[2] + sigmoidf_(a[2]) * pl[n][2]; o[n][3] = h[3] + sigmoidf_(a[3]) * pl[n][3]; }
                    const f32x4 snd = odd ? o[0] : o[1]; f32x4 rcv;
#pragma unroll
                    for (int j = 0; j < 4; ++j) rcv[j] = __int_as_float(__builtin_amdgcn_mov_dpp(__float_as_int(snd[j]), 0xB1, 0xF, 0xF, true));
                    float* op = out + (size_t)(row & ~1) * DM + co + 4 * odd;
                    __builtin_nontemporal_store(odd ? rcv : o[0], (f32x4*)op); __builtin_nontemporal_store(odd ? o[1] : rcv, (f32x4*)(op + DM));
                    asm volatile("" ::: "memory"); } }
    }
};

template <bool FOLD> __device__ __forceinline__ void p0_transpose_item(const float* W, int K, int N, bf16* WT, int kb, int nb, int mode, int lane, const float* gf = nullptr, const float* bfv = nullptr, long long* c1 = nullptr, long long* c2 = nullptr) {
    int lane_ = lane; asm volatile("" : "+v"(lane_));
    const int kg = lane_ & 7, nq = lane_ >> 3, k0 = 64 * kb + 8 * kg, ns = 32 * nb + 4 * nq;
    const float* src = W + (size_t)k0 * N + ns;
    f32x4 v[8];
#pragma unroll
    for (int j = 0; j < 8; ++j) v[j] = __builtin_nontemporal_load((const f32x4*)(src + (size_t)j * N));
    f32x4 a1 = {0.f, 0.f, 0.f, 0.f}, a2 = {0.f, 0.f, 0.f, 0.f};
    if (FOLD) {
#pragma unroll
        for (int j = 0; j < 8; ++j) { const float gk = gf[k0 + j], bk = bfv[k0 + j]; a2 += v[j] * bk; v[j] = v[j] * gk; } }
    int drow = ns, dstep = 1;
    if (mode != 0) { const int HW = (mode == 1) ? 128 : 64, half = HW >> 1, hbase = ns & ~(HW - 1), d = ns & (HW - 1), t = d >= half ? 1 : 0, i = d - half * t; drow = hbase + 2 * i + t; dstep = 2; }
#pragma unroll
    for (int c = 0; c < 4; ++c) { u32x4 o; o.x = pk2(v[0][c], v[1][c]); o.y = pk2(v[2][c], v[3][c]); o.z = pk2(v[4][c], v[5][c]); o.w = pk2(v[6][c], v[7][c]);
        if (FOLD) a1[c] = ((bflo(o.x) + bfhi(o.x)) + (bflo(o.y) + bfhi(o.y))) + ((bflo(o.z) + bfhi(o.z)) + (bflo(o.w) + bfhi(o.w)));
        __builtin_nontemporal_store(o, (u32x4*)(WT + (size_t)(drow + c * dstep) * K + k0)); }
    if (FOLD) {
#pragma unroll
        for (int o = 1; o < 8; o <<= 1) {
#pragma unroll
            for (int c = 0; c < 4; ++c) { a1[c] += __shfl_xor(a1[c], o); a2[c] += __shfl_xor(a2[c], o); } }
        if (kg == 0) {
#pragma unroll
            for (int c = 0; c < 4; ++c) { fx_add(c1 + ns + c, a1[c]); fx_add(c2 + ns + c, a2[c]); } }
    }
}
__device__ __forceinline__ void p0_transpose_item_f8(const float* W, int K, int N, f8* WT, int kb, int nb, int mode, float scale, int lane) {
    const int kg = lane & 7, nq = lane >> 3, k0 = 128 * kb + 16 * kg, ns = 32 * nb + 4 * nq;
    const float* src = W + (size_t)k0 * N + ns;
    f32x4 v[16];
#pragma unroll
    for (int j = 0; j < 16; ++j) v[j] = __builtin_nontemporal_load((const f32x4*)(src + (size_t)j * N)) * scale;
    int drow = ns, dstep = 1;
    if (mode != 0) { const int HW = (mode == 1) ? 128 : 64, half = HW >> 1, hbase = ns & ~(HW - 1), d = ns & (HW - 1), t = d >= half ? 1 : 0, i = d - half * t; drow = hbase + 2 * i + t; dstep = 2; }
#pragma unroll
    for (int c = 0; c < 4; ++c) { u32x4 o; o.x = pk4f8(v[0][c], v[1][c], v[2][c], v[3][c]); o.y = pk4f8(v[4][c], v[5][c], v[6][c], v[7][c]); o.z = pk4f8(v[8][c], v[9][c], v[10][c], v[11][c]); o.w = pk4f8(v[12][c], v[13][c], v[14][c], v[15][c]);
        __builtin_nontemporal_store(o, (u32x4*)(WT + (size_t)(drow + c * dstep) * K + k0)); }
}
struct CvDesc { const float* W; unsigned char* WT; int K, N, kb, nb, kind  , mode; float scale; const float* gf; const float* bfv; long long* c1; long long* c2; };
__device__ __forceinline__ void cv_issue(const CvDesc& d, LAS unsigned char* slot, int lane) {
    const float* src = d.W + (size_t)(64 * d.kb + (lane >> 3)) * d.N + 32 * d.nb + 4 * (lane & 7);
#pragma unroll
    for (int j = 0; j < 8; ++j) __builtin_amdgcn_global_load_lds((const unsigned*)(src + (size_t)(8 * j) * d.N), (LAS unsigned*)(slot + j * CV_CH), 16, 0, 2);
}
__device__ __forceinline__ void cv_finish(const CvDesc& d, const LAS unsigned char* slot, int lane) {
    const int kg = lane & 7, nq = lane >> 3, k0 = 64 * d.kb + 8 * kg, ns = 32 * d.nb + 4 * nq;
    f32x4 v[8];
#pragma unroll
    for (int j = 0; j < 8; ++j) v[j] = *(const LAS f32x4*)(slot + kg * CV_CH + j * 128 + nq * 16);
    int drow = ns, dstep = 1;
    if (d.mode != 0) { const int HW = (d.mode == 1) ? 128 : 64, half = HW >> 1, hbase = ns & ~(HW - 1), dd = ns & (HW - 1), t = dd >= half ? 1 : 0, i = dd - half * t; drow = hbase + 2 * i + t; dstep = 2; }
    if (d.kind == 4) {
        const float sc = d.scale; unsigned char* wt = d.WT;
#pragma unroll
        for (int c = 0; c < 4; ++c) *(unsigned*)(wt + toff(drow + c * dstep, k0 >> 1, d.K >> 1)) = pk8f4(v[0][c] * sc, v[1][c] * sc, v[2][c] * sc, v[3][c] * sc, v[4][c] * sc, v[5][c] * sc, v[6][c] * sc, v[7][c] * sc);
    } else if (d.kind == 3) {
        const float sc = d.scale, isc = 1.0f / d.scale; unsigned char* wt = d.WT; f32x4 a1 = {0.f, 0.f, 0.f, 0.f}, a2 = {0.f, 0.f, 0.f, 0.f};
#pragma unroll
        for (int j = 0; j < 8; ++j) { const float gk = d.gf[k0 + j], bk = d.bfv[k0 + j]; a2 += v[j] * bk; v[j] = v[j] * (gk * sc);
#pragma unroll
            for (int c = 0; c < 4; ++c) { v[j][c] = __builtin_rintf(__builtin_amdgcn_fmed3f(v[j][c], -127.f, 127.f)); a1[c] += v[j][c]; } }
#pragma unroll
        for (int c = 0; c < 4; ++c) { u32x2 o; o.x = pk4i8(v[0][c], v[1][c], v[2][c], v[3][c]); o.y = pk4i8(v[4][c], v[5][c], v[6][c], v[7][c]);
            *(u32x2*)(wt + toff(drow + c * dstep, k0, d.K)) = o; }
#pragma unroll
        for (int o = 1; o < 8; o <<= 1) {
#pragma unroll
            for (int c = 0; c < 4; ++c) { a1[c] += __shfl_xor(a1[c], o); a2[c] += __shfl_xor(a2[c], o); } }
        if (kg == 0) {
#pragma unroll
            for (int c = 0; c < 4; ++c) { fx_add(d.c1 + ns + c, a1[c] * isc); fx_add(d.c2 + ns + c, a2[c]); } }
    } else if (d.kind == 2) {
        const float sc = d.scale; unsigned char* wt = d.WT;
#pragma unroll
        for (int c = 0; c < 4; ++c) { u32x2 o; o.x = pk4f8(v[0][c] * sc, v[1][c] * sc, v[2][c] * sc, v[3][c] * sc); o.y = pk4f8(v[4][c] * sc, v[5][c] * sc, v[6][c] * sc, v[7][c] * sc);
            *(u32x2*)(wt + toff(drow + c * dstep, k0, d.K)) = o; }
    } else {
        unsigned char* wt = d.WT; f32x4 a1 = {0.f, 0.f, 0.f, 0.f}, a2 = {0.f, 0.f, 0.f, 0.f};
        if (d.kind == 1) {
#pragma unroll
            for (int j = 0; j < 8; ++j) { const float gk = d.gf[k0 + j], bk = d.bfv[k0 + j]; a2 += v[j] * bk; v[j] = v[j] * gk; } }
#pragma unroll
        for (int c = 0; c < 4; ++c) { u32x4 o; o.x = pk2(v[0][c], v[1][c]); o.y = pk2(v[2][c], v[3][c]); o.z = pk2(v[4][c], v[5][c]); o.w = pk2(v[6][c], v[7][c]);
            if (d.kind == 1) a1[c] = ((bflo(o.x) + bfhi(o.x)) + (bflo(o.y) + bfhi(o.y))) + ((bflo(o.z) + bfhi(o.z)) + (bflo(o.w) + bfhi(o.w)));
            __builtin_nontemporal_store(o, (u32x4*)(wt + toff(drow + c * dstep, 2 * k0, 2 * d.K))); }
        if (d.kind == 1) {
#pragma unroll
            for (int o = 1; o < 8; o <<= 1) {
#pragma unroll
                for (int c = 0; c < 4; ++c) { a1[c] += __shfl_xor(a1[c], o); a2[c] += __shfl_xor(a2[c], o); } }
            if (kg == 0) {
#pragma unroll
                for (int c = 0; c < 4; ++c) { fx_add(d.c1 + ns + c, a1[c]); fx_add(d.c2 + ns + c, a2[c]); } } }
    }
}
#define CV_RUN(lo_, hi_, cw_, ncw_, DECODE) do { LAS unsigned char* ring_ = L + RING_OFF + wave * CV_WAVE; int it_ = (lo_) + (cw_); \
    if (it_ < (hi_)) { CvDesc dc_ = DECODE(it_); cv_issue(dc_, ring_, lane); int sl_ = 0; \
        for (;;) { const int itn_ = it_ + (ncw_); const bool hn_ = itn_ < (hi_); CvDesc dn_ = dc_; \
            if (hn_) { dn_ = DECODE(itn_); cv_issue(dn_, ring_ + (sl_ ^ 1) * CV_SLOT, lane); asm volatile("s_waitcnt vmcnt(8)" ::: "memory"); } else asm volatile("s_waitcnt vmcnt(0)" ::: "memory"); \
            cv_finish(dc_, ring_ + sl_ * CV_SLOT, lane); asm volatile("s_waitcnt lgkmcnt(0)" ::: "memory"); \
            if (!hn_) break; dc_ = dn_; it_ = itn_; sl_ ^= 1; } } } while (0)
__device__ __forceinline__ void sincos_acc(float a, float& s, float& c) {
    const double x = (double)a, kd = rint(x * 0.63661977236758134308);
    double r = fma(-kd, 1.57079632679489655800e+00, x); r = fma(-kd, 6.12323399573676603587e-17, r);
    const double r2 = r * r;
    const double sp = r * (1.0 + r2 * (-1.0 / 6 + r2 * (1.0 / 120 + r2 * (-1.0 / 5040 + r2 * (1.0 / 362880 + r2 * (-1.0 / 39916800 + r2 * (1.0 / 6227020800.0)))))));
    const double cp = 1.0 + r2 * (-0.5 + r2 * (1.0 / 24 + r2 * (-1.0 / 720 + r2 * (1.0 / 40320 + r2 * (-1.0 / 3628800 + r2 * (1.0 / 479001600 + r2 * (-1.0 / 87178291200.0)))))));
    const int q = (int)kd & 3;
    const double sv = (q == 0) ? sp : (q == 1) ? cp : (q == 2) ? -sp : -cp, cv = (q == 0) ? cp : (q == 1) ? -sp : (q == 2) ? -cp : sp;
    s = (float)sv; c = (float)cv;
}

typedef short bf16x8 __attribute__((ext_vector_type(8)));
typedef short s16x4 __attribute__((ext_vector_type(4)));
typedef float f32x16 __attribute__((ext_vector_type(16)));
#define MFMA32(a, b, c) __builtin_amdgcn_mfma_f32_32x32x16_bf16((a), (b), (c), 0, 0, 0)
__device__ __forceinline__ bf16x8 pack8(const f32x16& p, int o) {
    u32x4 w; w.x = pk2(p[o], p[o + 1]); w.y = pk2(p[o + 2], p[o + 3]); w.z = pk2(p[o + 4], p[o + 5]); w.w = pk2(p[o + 6], p[o + 7]); return __builtin_bit_cast(bf16x8, w);
}
__device__ __forceinline__ bf16x8 cat44(s16x4 lo, s16x4 hi) { return (bf16x8){lo[0], lo[1], lo[2], lo[3], hi[0], hi[1], hi[2], hi[3]}; }
__device__ __forceinline__ float max16(const f32x16& p) {
    float a = fmaxf(fmaxf(p[0], p[1]), fmaxf(p[2], p[3])), b = fmaxf(fmaxf(p[4], p[5]), fmaxf(p[6], p[7])), c = fmaxf(fmaxf(p[8], p[9]), fmaxf(p[10], p[11])), d = fmaxf(fmaxf(p[12], p[13]), fmaxf(p[14], p[15]));
    return fmaxf(fmaxf(a, b), fmaxf(c, d));
}
constexpr int A_KP = 272, A_VP = 136;
constexpr int A_KT = 64 * A_KP, A_VT = 128 * A_VP;
constexpr int A_KM = 2 * (A_KT + A_VT);
__device__ __forceinline__ void moba_unit(int b, int h, int blk, const bf16* QA, const bf16* KA, const bf16* VA, const float* kmp, f8* YA, LAS unsigned char* lds, int tid) {
    const int lane = tid & 63, w = __builtin_amdgcn_readfirstlane(tid >> 6), r32 = lane & 31, hi = lane >> 5;
    const size_t rowb = (size_t)b * SEQ;
    const int qrel = 32 * w + r32;
    __syncthreads();
    LAS float* km = (LAS float*)(lds + A_KM);
    for (int i = tid; i < blk * AD; i += 512) { const int n = i >> 7, d = i & 127; const float* k0p = kmp + (size_t)((b * NBLK + n) * 2) * AW + h * AD + d; km[i] = (k0p[0] + k0p[AW]) * (1.0f / MBLK); }
    bf16x8 qf[8];
    { const bf16* qp = QA + (rowb + blk * MBLK + qrel) * AW + h * AD + 8 * hi;
#pragma unroll
      for (int st = 0; st < 8; ++st) qf[st] = *(const bf16x8*)(qp + 16 * st); }
    const int kkey = tid >> 4, kc = tid & 15;
    const bf16* kgp = KA + (rowb + kkey) * AW + h * AD + 8 * kc;
    const bf16* vgp = VA + (rowb + 2 * kkey) * AW + h * AD + 8 * kc;
    const int kls = kkey * A_KP + kc * 16, vls = (8 * kc) * A_VP + kkey * 4;
    u32x4 kr0, kr1, vr0, vr1;
#define A_LOAD(kbase) do { kr0 = *(const u32x4*)(kgp + (size_t)(kbase) * AW); kr1 = *(const u32x4*)(kgp + (size_t)((kbase) + 32) * AW); \
        vr0 = *(const u32x4*)(vgp + (size_t)(kbase) * AW); vr1 = *(const u32x4*)(vgp + (size_t)((kbase) + 1) * AW); } while (0)
#define A_STORE(buf) do { LAS unsigned char* kb_ = lds + (buf) * (A_KT + A_VT); LAS unsigned char* vb_ = kb_ + A_KT; \
        *(LAS u32x4*)(kb_ + kls) = kr0; *(LAS u32x4*)(kb_ + kls + 32 * A_KP) = kr1; \
        _Pragma("unroll") for (int e_ = 0; e_ < 4; ++e_) { const unsigned a_ = vr0[e_], b_ = vr1[e_]; \
            *(LAS unsigned*)(vb_ + vls + (2 * e_) * A_VP) = (a_ & 0xffffu) | (b_ << 16); *(LAS unsigned*)(vb_ + vls + (2 * e_ + 1) * A_VP) = (a_ >> 16) | (b_ & 0xffff0000u); } } while (0)
    A_LOAD(blk * MBLK); A_STORE(0);
    __syncthreads();
    unsigned sel = (blk <= TOPK) ? ((1u << blk) - 1u) : 0u;
    if (blk > TOPK) {
        float gt[NBLK];
#pragma unroll
        for (int n = 0; n < NBLK; ++n) { float part = 0.f;
            if (n < blk) {
#pragma unroll
                for (int st = 0; st < 8; ++st) { const f32x4 k0 = *(const LAS f32x4*)(km + n * AD + 16 * st + 8 * hi), k1 = *(const LAS f32x4*)(km + n * AD + 16 * st + 8 * hi + 4);
                    const u32x4 qw = __builtin_bit_cast(u32x4, qf[st]);
                    part += bflo(qw.x) * k0[0] + bfhi(qw.x) * k0[1] + bflo(qw.y) * k0[2] + bfhi(qw.y) * k0[3] + bflo(qw.z) * k1[0] + bfhi(qw.z) * k1[1] + bflo(qw.w) * k1[2] + bfhi(qw.w) * k1[3]; } }
            part += __shfl_xor(part, 32);
            gt[n] = (n < blk) ? part : -INFINITY; }
#pragma unroll
        for (int t = 0; t < TOPK; ++t) { float best = -INFINITY; int bi = -1;
#pragma unroll
            for (int n = 0; n < NBLK; ++n) if (gt[n] > best) { best = gt[n]; bi = n; }
            if (bi >= 0) sel |= 1u << bi;
#pragma unroll
            for (int n = 0; n < NBLK; ++n) if (n == bi) gt[n] = -INFINITY; }
    }
    f32x16 o[4];
#pragma unroll
    for (int db = 0; db < 4; ++db) o[db] = (f32x16){0.f, 0.f, 0.f, 0.f, 0.f, 0.f, 0.f, 0.f, 0.f, 0.f, 0.f, 0.f, 0.f, 0.f, 0.f, 0.f};
    float m = -INFINITY, l = 0.f;
    const int NT = 4 * (blk + 1);
    for (int ti = 0; ti < NT; ++ti) {
        const int n = (ti < 4) ? blk : ((ti - 4) >> 2), t = (ti < 4) ? ti : ((ti - 4) & 3);
        const bool more = ti + 1 < NT;
        if (more) { const int n1 = (ti + 1 < 4) ? blk : ((ti - 3) >> 2), t1 = (ti + 1 < 4) ? (ti + 1) : ((ti - 3) & 3); A_LOAD(n1 * MBLK + 64 * t1); }
        const bool own = (n == blk), mine = ((sel >> n) & 1u) != 0u;
        const bool active = own ? (t <= (w >> 1)) : (__any(mine) != 0);
        if (active) {
            const LAS unsigned char* kb = lds + (ti & 1) * (A_KT + A_VT); const LAS unsigned char* vb = kb + A_KT;
            f32x16 s0 = (f32x16){0.f, 0.f, 0.f, 0.f, 0.f, 0.f, 0.f, 0.f, 0.f, 0.f, 0.f, 0.f, 0.f, 0.f, 0.f, 0.f}, s1 = s0;
#pragma unroll
            for (int st = 0; st < 8; ++st) { const bf16x8 a0 = *(const LAS bf16x8*)(kb + r32 * A_KP + (16 * st + 8 * hi) * 2), a1 = *(const LAS bf16x8*)(kb + (32 + r32) * A_KP + (16 * st + 8 * hi) * 2);
                s0 = MFMA32(a0, qf[st], s0); s1 = MFMA32(a1, qf[st], s1); }
            if (own) { if (t == (w >> 1)) {
#pragma unroll
                    for (int r = 0; r < 16; ++r) { const int kr = 64 * t + (r & 3) + 8 * (r >> 2) + 4 * hi; if (kr > qrel) s0[r] = -INFINITY; if (kr + 32 > qrel) s1[r] = -INFINITY; } } }
            else if (!mine) {
#pragma unroll
                for (int r = 0; r < 16; ++r) { s0[r] = -INFINITY; s1[r] = -INFINITY; } }
            float tm = fmaxf(max16(s0), max16(s1)); tm = fmaxf(tm, __shfl_xor(tm, 32));
            const float mn = fmaxf(m, tm), al = __builtin_amdgcn_exp2f(m - mn); m = mn;
            float ls = 0.f;
#pragma unroll
            for (int r = 0; r < 16; ++r) { s0[r] = __builtin_amdgcn_exp2f(s0[r] - mn); s1[r] = __builtin_amdgcn_exp2f(s1[r] - mn); ls += s0[r] + s1[r]; }
            l = l * al + ls;
#pragma unroll
            for (int db = 0; db < 4; ++db) o[db] = o[db] * al;
#pragma unroll
            for (int u = 0; u < 2; ++u)
#pragma unroll
                for (int ks = 0; ks < 2; ++ks) { const bf16x8 pf = pack8(u ? s1 : s0, 8 * ks);
#pragma unroll
                    for (int db = 0; db < 4; ++db) { const LAS unsigned char* vp = vb + (32 * db + r32) * A_VP + (32 * u + 16 * ks + 4 * hi) * 2;
                        o[db] = MFMA32(cat44(*(const LAS s16x4*)vp, *(const LAS s16x4*)(vp + 16)), pf, o[db]); } }
        }
        if (more) A_STORE((ti + 1) & 1);
        __syncthreads();
    }
    l += __shfl_xor(l, 32);
    const float inv = F8S_Y / l;
    f8* yp = YA + toff(rowb + blk * MBLK + qrel, h * AD + 4 * hi, AW);
#pragma unroll
    for (int db = 0; db < 4; ++db)
#pragma unroll
        for (int g = 0; g < 4; ++g) *(unsigned*)(yp + 32 * db + 8 * g) = pk4f8(o[db][4 * g] * inv, o[db][4 * g + 1] * inv, o[db][4 * g + 2] * inv, o[db][4 * g + 3] * inv);
#undef A_LOAD
#undef A_STORE
}
constexpr int B_KP = 144, B_VP = 520;
constexpr int B_KT = 256 * B_KP, B_VT = 64 * B_VP;
__device__ __forceinline__ void swa_unit(int b, int kvh, int qb, const bf16* QB, const bf16* KB, const bf16* VB, const float* sinks, f8* YB, LAS unsigned char* lds, int tid) {
    const int lane = tid & 63, w = __builtin_amdgcn_readfirstlane(tid >> 6), r32 = lane & 31, hi = lane >> 5;
    const size_t rowb = (size_t)b * SEQ; const int band0 = qb * WIN - WIN, hq = kvh * 8 + w;
    __syncthreads();
    LAS unsigned char* ks_ = lds; LAS unsigned char* vs_ = lds + B_KT;
#pragma unroll
    for (int i = 0; i < 4; ++i) { const int p = tid + 512 * i, key = p >> 3, c = p & 7, pos = band0 + key;
        if (pos >= 0) *(LAS u32x4*)(ks_ + key * B_KP + c * 16) = *(const u32x4*)(KB + (rowb + pos) * BKVW + kvh * BD + 8 * c); }
#pragma unroll
    for (int i = 0; i < 2; ++i) { const int p = tid + 512 * i, kp = p >> 3, c = p & 7, pos = band0 + 2 * kp;
        if (pos >= 0) { const u32x4 v0 = *(const u32x4*)(VB + (rowb + pos) * BKVW + kvh * BD + 8 * c), v1 = *(const u32x4*)(VB + (rowb + pos + 1) * BKVW + kvh * BD + 8 * c);
#pragma unroll
            for (int e = 0; e < 4; ++e) { const unsigned a_ = v0[e], b_ = v1[e];
                *(LAS unsigned*)(vs_ + (8 * c + 2 * e) * B_VP + kp * 4) = (a_ & 0xffffu) | (b_ << 16); *(LAS unsigned*)(vs_ + (8 * c + 2 * e + 1) * B_VP + kp * 4) = (a_ >> 16) | (b_ & 0xffff0000u); } } }
    __syncthreads();
    const float sk = sinks[hq] * LOG2E;
    for (int sub = 0; sub < 4; ++sub) {
        const int qrow = qb * WIN + 32 * sub + r32;
        bf16x8 qf[4];
        { const bf16* qp = QB + (rowb + qrow) * 2048 + hq * BD + 8 * hi;
#pragma unroll
          for (int st = 0; st < 4; ++st) qf[st] = *(const bf16x8*)(qp + 16 * st); }
        f32x16 o[2];
        o[0] = (f32x16){0.f, 0.f, 0.f, 0.f, 0.f, 0.f, 0.f, 0.f, 0.f, 0.f, 0.f, 0.f, 0.f, 0.f, 0.f, 0.f}; o[1] = o[0];
        float m = sk, l = (hi == 0) ? 1.0f : 0.0f;
        const int qi = WIN + 32 * sub + r32;
        for (int tt = 0; tt < 5; ++tt) { const int tile = sub + tt;
            if (band0 + 32 * tile < 0) continue;
            f32x16 s = (f32x16){0.f, 0.f, 0.f, 0.f, 0.f, 0.f, 0.f, 0.f, 0.f, 0.f, 0.f, 0.f, 0.f, 0.f, 0.f, 0.f};
#pragma unroll
            for (int st = 0; st < 4; ++st) s = MFMA32(*(const LAS bf16x8*)(ks_ + (32 * tile + r32) * B_KP + (16 * st + 8 * hi) * 2), qf[st], s);
            if (tt == 0 || tt == 4) {
#pragma unroll
                for (int r = 0; r < 16; ++r) { const int ki = 32 * tile + (r & 3) + 8 * (r >> 2) + 4 * hi; if (!(ki <= qi && qi - ki < WIN)) s[r] = -INFINITY; } }
            float tm = max16(s); tm = fmaxf(tm, __shfl_xor(tm, 32));
            const float mn = fmaxf(m, tm), al = __builtin_amdgcn_exp2f(m - mn); m = mn;
            float ls = 0.f;
#pragma unroll
            for (int r = 0; r < 16; ++r) { s[r] = __builtin_amdgcn_exp2f(s[r] - mn); ls += s[r]; }
            l = l * al + ls; o[0] = o[0] * al; o[1] = o[1] * al;
#pragma unroll
            for (int ks = 0; ks < 2; ++ks) { const bf16x8 pf = pack8(s, 8 * ks);
#pragma unroll
                for (int db = 0; db < 2; ++db) { const LAS unsigned char* vp = vs_ + (32 * db + r32) * B_VP + (32 * tile + 16 * ks + 4 * hi) * 2;
                    o[db] = MFMA32(cat44(*(const LAS s16x4*)vp, *(const LAS s16x4*)(vp + 16)), pf, o[db]); } }
        }
        l += __shfl_xor(l, 32);
        const float inv = F8S_Y / l;
        f8* yp = YB + toff(rowb + qrow, hq * BD + 4 * hi, 2048);
#pragma unroll
        for (int db = 0; db < 2; ++db)
#pragma unroll
            for (int g = 0; g < 4; ++g) *(unsigned*)(yp + 32 * db + 8 * g) = pk4f8(o[db][4 * g] * inv, o[db][4 * g + 1] * inv, o[db][4 * g + 2] * inv, o[db][4 * g + 3] * inv);
    }
}

struct Args { const float* in[16]; float* out; unsigned char* ws; float invf[64]; int ph_lo, ph_hi; };
__global__ void __launch_bounds__(NWAVES * 64, 2) mk_fwd(Args args) {
    extern __shared__ __attribute__((aligned(16))) unsigned char lds[];
    LAS unsigned char* L = (LAS unsigned char*)lds;
    volatile LAS unsigned* MISC = (volatile LAS unsigned*)(L + MISC_OFF);
    const int tid = threadIdx.x, lane = tid & 63, wave = __builtin_amdgcn_readfirstlane(tid >> 6);
    const int G = gridDim.x, bx = blockIdx.x;
    const int gw = bx * NWAVES + wave, NGW = G * NWAVES;
    unsigned char* ws = args.ws;
    const int lo = args.ph_lo, hi = args.ph_hi;
    for (int u = tid; u < (LDS_BYTES - LDSCTL_OFF) / 4; u += NWAVES * 64) ((LAS unsigned*)(L + LDSCTL_OFF))[u] = 0u;
    __syncthreads();
    XcdBarrier bar; bar.bar = (unsigned*)(ws + WS_CTL) + CW_BAR; bar.x = 0; bar.st = nullptr;
    if (hi - lo > 1) bar = xcd_barrier_post((unsigned*)(ws + WS_CTL) + CW_BAR, MISC + 8);
#ifndef MK_PHASE_MASK
#define MK_PHASE_MASK 0x3ff
#endif
#define IN(k) (((MK_PHASE_MASK >> (k)) & 1) && lo <= (k) && (k) < hi)
#define SEAM(k) do { if (IN(k) && IN((k) + 1)) xcd_barrier(bar); } while (0)
    const float* x = args.in[0];
    bf16* XB = (bf16*)(ws + WS_XB); bf16* PB = (bf16*)(ws + WS_PB);

    if (IN(0)) {
        for (int t = bx * (NWAVES * 64) + tid; t < SEQ * 64; t += G * NWAVES * 64) { const int pos = t >> 6, i = t & 63;
            const float ang = (float)pos * args.invf[i]; float s, c; sincos_acc(ang, s, c);
            ((f32x2*)(ws + WS_TABA))[t] = (f32x2){c, s};
            if ((i & 1) == 0) ((f32x2*)(ws + WS_TABB))[pos * 32 + (i >> 1)] = (f32x2){c, s}; }
        constexpr int I_IN = (DM / 64) * (NIN / 32), I_PL0 = (PLE / 64) * (DM / 32);
        auto dec0 = [&](int it) { CvDesc d{}; d.scale = 1.f;
            if (it < I_IN) { const int nblk = NIN / 32, n0 = 32 * (it % nblk); d.W = args.in[2]; d.WT = ws + WS_WIN; d.K = DM; d.N = NIN; d.kb = it / nblk; d.nb = it % nblk; d.kind = 2; d.scale = F8S_WIN;
                if (n0 < 2 * AW || (n0 >= 3 * AW && n0 < 3 * AW + 2048) || n0 >= 8704) { d.kind = 4; d.scale = F4S_WG; d.WT = ws + WS_WG4; }
                d.mode = (n0 < 2 * AW) ? 1 : (n0 < 3 * AW) ? 0 : (n0 < 3 * AW + 2048 + BKVW) ? 2 : 0; }
            else { const int r = it - I_IN; d.W = args.in[14]; d.WT = ws + WS_WPLE; d.K = PLE; d.N = DM; d.kb = r / (DM / 32); d.nb = r % (DM / 32); d.kind = 0; d.mode = 0; }
            return d; };
        CV_RUN(0, I_IN + I_PL0, gw, NGW, dec0);
        { const size_t nthr = (size_t)G * NWAVES * 64, t0 = (size_t)bx * (NWAVES * 64) + tid;
#define CVT_ROWS(SRC, DST, NCH) for (size_t c = t0; c < (size_t)(NCH); c += 4 * nthr) { f32x4 a_[4], b_[4]; \
              _Pragma("unroll") for (int q = 0; q < 4; ++q) { const size_t cc = c + q * nthr; if (cc < (size_t)(NCH)) { a_[q] = ((const f32x4*)(SRC))[2 * cc]; b_[q] = ((const f32x4*)(SRC))[2 * cc + 1]; } } \
              _Pragma("unroll") for (int q = 0; q < 4; ++q) { const size_t cc = c + q * nthr; if (cc < (size_t)(NCH)) { u32x4 w; w.x = pk2(a_[q][0], a_[q][1]); w.y = pk2(a_[q][2], a_[q][3]); w.z = pk2(b_[q][0], b_[q][1]); w.w = pk2(b_[q][2], b_[q][3]); ((u32x4*)(DST))[cc] = w; } } }
          for (size_t c0 = t0; c0 < (size_t)M * DM / 16; c0 += 2 * nthr) { f32x4 a2_[2][4];
#pragma unroll
              for (int u_ = 0; u_ < 2; ++u_) { const size_t c = c0 + u_ * nthr; if (c < (size_t)M * DM / 16) { const f32x4* xp = (const f32x4*)x + 4 * c;
#pragma unroll
                  for (int q = 0; q < 4; ++q) a2_[u_][q] = xp[q]; } }
#pragma unroll
              for (int u_ = 0; u_ < 2; ++u_) { const size_t c = c0 + u_ * nthr; if (c < (size_t)M * DM / 16) { f32x4 a_[4];
#pragma unroll
                  for (int q = 0; q < 4; ++q) a_[q] = a2_[u_][q] * F8S_X;
                  u32x4 w; w.x = pk4f8(a_[0][0], a_[0][1], a_[0][2], a_[0][3]); w.y = pk4f8(a_[1][0], a_[1][1], a_[1][2], a_[1][3]); w.z = pk4f8(a_[2][0], a_[2][1], a_[2][2], a_[2][3]); w.w = pk4f8(a_[3][0], a_[3][1], a_[3][2], a_[3][3]);
                  ((u32x4*)XB)[c] = w;
                  const float r4 = F4S_X / F8S_X; u32x2 w4;
                  w4.x = pk8f4(a_[0][0] * r4, a_[0][1] * r4, a_[0][2] * r4, a_[0][3] * r4, a_[1][0] * r4, a_[1][1] * r4, a_[1][2] * r4, a_[1][3] * r4);
                  w4.y = pk8f4(a_[2][0] * r4, a_[2][1] * r4, a_[2][2] * r4, a_[2][3] * r4, a_[3][0] * r4, a_[3][1] * r4, a_[3][2] * r4, a_[3][3] * r4);
                  ((u32x2*)(ws + WS_XB4))[c] = w4; } } }
          CVT_ROWS(args.in[1], PB, (size_t)M * PLE / 8);
#undef CVT_ROWS
        }
        VM_WAIT(); __syncthreads();
    }
    SEAM(0);
    if (IN(1)) {
        const bf16* WIN = (const bf16*)(ws + WS_WIN); const float* tabA = (const float*)(ws + WS_TABA); const float* tabB = (const float*)(ws + WS_TABB);
#define P1_CALL(MODE, nrow0, ncols, ...) do { pg8::Gemm g{XB, WIN + (size_t)(nrow0) * (DM / 2), M, (ncols), DM / 2, 1.0f / (F8S_X * F8S_WIN)}; pg8::StaticOrder S; S.init(M, (ncols), G, bx); \
            EpiZ<MODE> E{__VA_ARGS__}; pg8::gemm_phase<EpiZ<MODE>, pg8::StaticOrder, true, true, 1, NST_ALL>(L + RING_OFF, g, S, E); } while (0)
#define P1_CALL4(MODE, CH, nrow0, ncols, nx_nrow0, nx_ncols, ...) do { const char* chA_ = nullptr; const char* chB_ = nullptr; \
            if ((CH) & 2) { pg8::StaticOrder S2; S2.init(M, (nx_ncols), G, bx); pg8::Unit u2{0, 0}; S2.next(0, u2); const size_t ts_ = (size_t)256 * (DM / 4) * 2;        \
                chA_ = (const char*)(ws + WS_XB4) + (size_t)u2.pm * ts_; chB_ = (const char*)(ws + WS_WG4) + (size_t)(nx_nrow0) * (DM / 2) + (size_t)u2.pn * ts_; } \
            pg8::Gemm g{(const bf16*)(ws + WS_XB4), (const bf16*)(ws + WS_WG4) + (size_t)(nrow0) * (DM / 4), M, (ncols), DM / 4, 1.0f / (F4S_X * F4S_WG)}; pg8::StaticOrder S; S.init(M, (ncols), G, bx); \
            EpiZ<MODE> E{__VA_ARGS__}; pg8::gemm_phase<EpiZ<MODE>, pg8::StaticOrder, true, true, 3, NST_ALL, false, false, CH>(L + RING_OFF, g, S, E, chA_, chB_); } while (0)
        P1_CALL(0, 4096, 2048, (bf16*)(ws + WS_VA), nullptr, AW, 1.0f, nullptr, nullptr, nullptr);
#define P1_FP4(C1, C2, C3, C4) do { \
        P1_CALL4(1, C1, 0,    2048, 2048, 2048, (bf16*)(ws + WS_QA), nullptr, AW, QSCALE_A, tabA, nullptr, nullptr);                          \
        P1_CALL4(2, C2, 2048, 2048, 6144, 2048, (bf16*)(ws + WS_KA), nullptr, AW, 1.0f, tabA, nullptr, (float*)(ws + WS_KMP));                \
        P1_CALL4(3, C3, 6144, 2048, 8704, 8192, (bf16*)(ws + WS_QB), nullptr, 2048, QSCALE_B, tabB, nullptr, nullptr);                        \
        P1_CALL4(4, C4, 8704, 8192, 0, 2048, (bf16*)(ws + WS_GA), (bf16*)(ws + WS_GB), DM, 1.0f, nullptr, args.in[3], nullptr); } while (0)
        if (G <= 256) P1_FP4(2, 3, 3, 1); else P1_FP4(0, 0, 0, 0);
#undef P1_FP4
#undef P1_CALL4
        constexpr int TAILW = (M / 256) * (512 / 256);
        if (bx < TAILW || G <= TAILW) { P1_CALL(5, 8192, 512, (bf16*)(ws + WS_KB), (bf16*)(ws + WS_VB), BKVW, 1.0f, tabB, nullptr, nullptr);
            pg8::Gemm g{PB, (const bf16*)(ws + WS_WPLE), M, DM, PLE}; pg8::StaticOrder S; S.init(M, DM, (G <= TAILW) ? G : TAILW, bx);
            EpiPle E{(bf16*)(ws + WS_PLE)};
            pg8::gemm_phase<EpiPle, pg8::StaticOrder, true, true, 0, NST_ALL>(L + RING_OFF, g, S, E); }
#undef P1_CALL
        if (bx >= TAILW || G <= TAILW) {
            constexpr int I_UP = (AW / 64) * (DM / 32), I_O = (DM / 64) * (DM / 32), I_FU = (DM / 64) * (DFF / 32), I_FD = (DFF / 64) * (DM / 32);
            constexpr int NREST = 2 * I_UP + I_O + I_FU + I_FD + I_O;
            const int gw2 = (G <= TAILW) ? gw : (bx - TAILW) * NWAVES + wave, NGW2 = (G <= TAILW) ? NGW : (G - TAILW) * NWAVES;
            auto decr = [&](int it) { CvDesc d{}; d.scale = 1.f; d.mode = 0; int r = it;
                if (r < I_UP) { d.W = args.in[5]; d.WT = ws + WS_WUPA; d.K = AW; d.N = DM; d.kb = r / (DM / 32); d.nb = r % (DM / 32); d.kind = 2; d.scale = F8S_WUP; return d; } r -= I_UP;
                if (r < I_UP) { d.W = args.in[6]; d.WT = ws + WS_WUPB; d.K = AW; d.N = DM; d.kb = r / (DM / 32); d.nb = r % (DM / 32); d.kind = 2; d.scale = F8S_WUP; return d; } r -= I_UP;
                if (r < I_O)  { d.W = args.in[7]; d.WT = ws + WS_WO; d.K = DM; d.N = DM; d.kb = r / (DM / 32); d.nb = r % (DM / 32); d.kind = 2; d.scale = F8S_WO; return d; } r -= I_O;
                if (r < I_FU) { d.W = args.in[10]; d.WT = ws + WS_WFFUP; d.K = DM; d.N = DFF; d.kb = r / (DFF / 32); d.nb = r % (DFF / 32); d.kind = 1; d.gf = args.in[8]; d.bfv = args.in[9]; d.c1 = (long long*)(ws + CB_C1F); d.c2 = (long long*)(ws + CB_C2F); return d; } r -= I_FU;
                if (r < I_FD) { d.W = args.in[11]; d.WT = ws + WS_WFFDN; d.K = DFF; d.N = DM; d.kb = r / (DM / 32); d.nb = r % (DM / 32); d.kind = 0; return d; } r -= I_FD;
                d.W = args.in[15]; d.WT = ws + WS_WPLEG; d.K = DM; d.N = DM; d.kb = r / (DM / 32); d.nb = r % (DM / 32); d.kind = 3; d.scale = I8S_WG; d.gf = args.in[12]; d.bfv = args.in[13]; d.c1 = (long long*)(ws + CB_C1G); d.c2 = (long long*)(ws + CB_C2G); return d; };
            CV_RUN(0, NREST, gw2, NGW2, decr);
            VM_WAIT(); __syncthreads();
        }
    }
    SEAM(1);
    if (IN(2)) {
        { float* cf = (float*)(ws + WS_CF32); const int t = bx * (NWAVES * 64) + tid, T = G * NWAVES * 64;
          for (int i = t; i < 2 * DFF + 2 * DM; i += T) { const long long* srcp = (i < DFF) ? (const long long*)(ws + CB_C1F) + i : (i < 2 * DFF) ? (const long long*)(ws + CB_C2F) + (i - DFF)
                  : (i < 2 * DFF + DM) ? (const long long*)(ws + CB_C1G) + (i - 2 * DFF) : (const long long*)(ws + CB_C2G) + (i - 2 * DFF - DM);
              cf[i] = (float)((double)*srcp * (1.0 / 4294967296.0)); } }
        const int vcu = (G % 8 == 0) ? (bx % 8) * (G / 8) + bx / 8 : bx;
        for (int it = vcu; it < BATCH * AHEADS * 4; it += G) { const int bh = it >> 2, sidx = it & 3;
#pragma unroll 1
            for (int k = 0; k < 2; ++k) moba_unit(bh >> 4, bh & 15, k ? sidx : 7 - sidx, (const bf16*)(ws + WS_QA), (const bf16*)(ws + WS_KA), (const bf16*)(ws + WS_VA), (const float*)(ws + WS_KMP), (f8*)(ws + WS_YA), L + RING_OFF, tid); }
#pragma unroll 1
        for (int it = vcu; it < BATCH * BKVH * (SEQ / WIN); it += G) swa_unit(it >> 6, (it >> 4) & 3, it & 15, (const bf16*)(ws + WS_QB), (const bf16*)(ws + WS_KB), (const bf16*)(ws + WS_VB), args.in[4], (f8*)(ws + WS_YB), L + RING_OFF, tid);
        VM_WAIT(); __syncthreads();
    }
    SEAM(2);
    if (IN(3)) {
        pg8::Gemm g{(const bf16*)(ws + WS_YA), (const bf16*)(ws + WS_WUPA), M, DM, AW / 2, 1.0f / (F8S_Y * F8S_WUP), (const bf16*)(ws + WS_YB), (const bf16*)(ws + WS_WUPB)}; pg8::StaticOrder S; S.init(M, DM, G, bx);
        EpiMG E{(const bf16*)(ws + WS_GA), (const bf16*)(ws + WS_GB), (f8*)(ws + WS_MG)};
        pg8::gemm_phase<EpiMG, pg8::StaticOrder, true, true, 1, NST_ALL, true, true>(L + RING_OFF, g, S, E);
    }
    SEAM(3);
    if (IN(4)) {
        pg8::Gemm g{(const bf16*)(ws + WS_MG), (const bf16*)(ws + WS_WO), M, DM, DM / 2, 1.0f / (F8S_MG * F8S_WO)}; pg8::StaticOrder S; S.init(M, DM, G, bx);
        EpiRes<false> E{x, nullptr, (bf16*)(ws + WS_H1B), nullptr, nullptr, nullptr, (long long*)(ws + CB_ST1)};
        pg8::gemm_phase<EpiRes<false>, pg8::StaticOrder, true, true, 1, NST_ALL, true>(L + RING_OFF, g, S, E);
    }
    do { if (IN(4) && IN(6)) xcd_barrier(bar); } while (0);
    if (IN(6)) {
        pg8::Gemm g{(const bf16*)(ws + WS_H1B), (const bf16*)(ws + WS_WFFUP), M, DFF, DM}; pg8::StaticOrder S; S.init(M, DFF, G, bx);
        EpiU E{(bf16*)(ws + WS_U), (const long long*)(ws + CB_ST1), (const float*)(ws + WS_CF32), (const float*)(ws + WS_CF32) + DFF};
        pg8::gemm_phase<EpiU, pg8::StaticOrder, true, true, 0, NST_ALL, true>(L + RING_OFF, g, S, E);
    }
    SEAM(6);
    if (IN(7)) {
        pg8::Gemm g{(const bf16*)(ws + WS_U), (const bf16*)(ws + WS_WFFDN), M, DM, DFF}; pg8::StaticOrder S; S.init(M, DM, G, bx);
        EpiRes<true> E{(const void*)(ws + WS_H1B), (bf16*)(ws + WS_T12), (bf16*)(ws + WS_H2B), (const long long*)(ws + CB_ST1), args.in[8], args.in[9], (long long*)(ws + CB_ST2)};
        pg8::gemm_phase<EpiRes<true>, pg8::StaticOrder, true, true, 0, NST_ALL, true>(L + RING_OFF, g, S, E);
    }
    do { if (IN(7) && IN(9)) xcd_barrier(bar); } while (0);
    if (IN(9)) {
        { pg8::Gemm g{(const bf16*)(ws + WS_H2B), (const bf16*)(ws + WS_WPLEG), M, DM, DM / 2, 1.0f / (I8S_T2 * I8S_WG)}; pg8::StaticOrder S; S.init(M, DM, G, bx);
          EpiFinal E{(const bf16*)(ws + WS_PLE), (const bf16*)(ws + WS_T12), args.out, (const long long*)(ws + CB_ST2), args.in[12], args.in[13], (const float*)(ws + WS_CF32) + 2 * DFF, (const float*)(ws + WS_CF32) + 2 * DFF + DM};
          pg8::gemm_phase<EpiFinal, pg8::StaticOrder, true, true, 2, NST_ALL, true>(L + RING_OFF, g, S, E); }
    }
#undef IN
#undef SEAM
}

#ifndef MK_PER_PHASE
#define MK_PER_PHASE 0
#endif
extern "C" void kernel_launch(void* const* d_in, const int* in_sizes, int n_in, void* d_out, int out_size, void* d_ws, size_t ws_size, hipStream_t stream) {
    static int grid = 0;
    if (grid == 0) {
        if (n_in != 16 || in_sizes[0] != M * DM || out_size != M * DM || ws_size < WS_END) { fprintf(stderr, "kernel_launch: unexpected shapes (n_in %d, in0 %d, out %d, ws %zu < %zu); nothing launched\n", n_in, n_in > 0 ? in_sizes[0] : -1, out_size, ws_size, (size_t)WS_END); grid = -1; return; }
        int dev = 0, cus = 0, per_cu = 0;
        if (hipGetDevice(&dev) != hipSuccess || hipDeviceGetAttribute(&cus, hipDeviceAttributeMultiprocessorCount, dev) != hipSuccess) { grid = -1; return; }
        if (hipFuncSetAttribute((const void*)mk_fwd, hipFuncAttributeMaxDynamicSharedMemorySize, LDS_BYTES) != hipSuccess) { fprintf(stderr, "kernel_launch: hipFuncSetAttribute failed\n"); grid = -1; return; }
        if (hipOccupancyMaxActiveBlocksPerMultiprocessor(&per_cu, (const void*)mk_fwd, NWAVES * 64, LDS_BYTES) != hipSuccess || per_cu < 1) fprintf(stderr, "kernel_launch: occupancy query reports %d workgroups per CU\n", per_cu);
        (void)hipGetLastError();
        grid = cus;
    }
    if (grid < 0) return;
    if (hipMemsetAsync((char*)d_ws + WS_CTL, 0, CTL_ZERO_BYTES, stream) != hipSuccess) return;
    Args a{};
    for (int i = 0; i < 16; ++i) a.in[i] = (const float*)d_in[i];
    a.out = (float*)d_out; a.ws = (unsigned char*)d_ws;
    for (int i = 0; i < 64; ++i) a.invf[i] = (float)pow(10000.0, -(double)i / 64.0);
#if MK_PER_PHASE
#ifndef MK_DUP_MASK
#define MK_DUP_MASK 0
#endif
#ifndef MK_DUP_REPS
#define MK_DUP_REPS 2
#endif
    for (int ph = 0; ph < NPH; ++ph) { a.ph_lo = ph; a.ph_hi = ph + 1; const int reps = ((MK_DUP_MASK >> ph) & 1) ? MK_DUP_REPS : 1;
        for (int r = 0; r < reps; ++r) hipLaunchKernelGGL(mk_fwd, dim3(grid), dim3(NWAVES * 64), LDS_BYTES, stream, a); }
#else
    a.ph_lo = 0; a.ph_hi = NPH; hipLaunchKernelGGL(mk_fwd, dim3(grid), dim3(NWAVES * 64), LDS_BYTES, stream, a);
#endif
    const hipError_t le = hipPeekAtLastError();
    if (le != hipSuccess) fprintf(stderr, "kernel_launch: launch failed: %s\n", hipGetErrorName(le));
}
```
